# Optimizing an MI355X kernel written in HIP

```python
import jax, jax.numpy as jnp
from jax import lax
import numpy as np

D_MODEL = 1024
BATCH = 2
SEQ = 8192
DEPTH = 2

GRID_W = 64
CTX_LEN = 256
N_MIXERS = 2
N_MOD = 6
LN_EPS = 1e-5
ALPHA = (2 * DEPTH) ** 0.25
BETA = (8 * DEPTH) ** -0.25
RW_HEAD = 64
RW_HEADS = D_MODEL // RW_HEAD
RW_DECAY_LORA = 64
RW_A_LORA = 64
RW_GATE_LORA = 128
RW_LNX_EPS = 64e-5
RW_DECAY_SCALE = 0.606531
ATT_HEAD = 64
ATT_Q_HEADS = D_MODEL // ATT_HEAD
ATT_KV_HEADS = 4
ATT_GROUP = ATT_Q_HEADS // ATT_KV_HEADS
WINDOW = 128
BLOCK = 128
ROPE_BASE = 10000.0
NEG = -1e30
N_EXPERTS = 16
EC_CAPACITY = 2
D_EXPERT = 2 * D_MODEL
N_RWKV = (DEPTH + 1) // 2
N_ATTN = DEPTH // 2

kernel_name = "hybrid_rwkv7_swa_sink_ecmoe_deepnorm_dit"


def layer_norm(x, g, b):
    xf = x.astype(jnp.float32)
    mu = xf.mean(-1, keepdims=True)
    var = jnp.square(xf - mu).mean(-1, keepdims=True)
    return ((xf - mu) * lax.rsqrt(var + LN_EPS)).astype(x.dtype) * g + b


def modulate(x, shift, scale):
    return x * (1 + scale) + shift


def centred_shift(x):
    zero = jnp.zeros_like(x[:, :1])
    prev = jnp.concatenate([zero, x[:, :-1]], axis=1)
    nxt = jnp.concatenate([x[:, 1:], zero], axis=1)
    return 0.5 * (prev + nxt) - x


def rwkv_inputs(h, mu, wr, wk, wv, w0, w1, w2, a0, a1, a2, g1, g2, k_k, k_a):
    B, T, D = h.shape
    heads = lambda t: t.reshape(B, T, RW_HEADS, RW_HEAD).astype(jnp.float32)
    xx = centred_shift(h)
    xr, xw, xk, xv, xa, xg = [h + xx * mu[m] for m in range(6)]
    r = xr @ wr
    k = xk @ wk
    v = xv @ wv
    g = jax.nn.sigmoid(xg @ g1) @ g2
    kk = heads(k * k_k)
    kk = kk / jnp.maximum(jnp.linalg.norm(kk, axis=-1, keepdims=True), 1e-12)
    dirs = []
    for d in range(2):
        w_d = jnp.exp(-RW_DECAY_SCALE * jax.nn.sigmoid(w0[d] + jnp.tanh(xw @ w1[d]) @ w2[d]))
        a_d = jax.nn.sigmoid(a0[d] + (xa @ a1[d]) @ a2[d])
        k_d = k * (1 + (a_d - 1) * k_a)
        a_h = heads(a_d)
        dirs.append((heads(w_d), heads(k_d), -kk, kk * a_h))
    return heads(r), heads(k), heads(v), g, dirs


def rwkv_scan(state, r, w, k, v, a, b, reverse):
    xs = tuple(jnp.swapaxes(t, 0, 1) for t in (r, w, k, v, a, b))

    def step(S, inp):
        r_t, w_t, k_t, v_t, a_t, b_t = inp
        sa = jnp.einsum('bhvk,bhk->bhv', S, a_t)
        S = (S * w_t[:, :, None, :] + sa[..., :, None] * b_t[..., None, :]
             + v_t[..., :, None] * k_t[..., None, :])
        return S, jnp.einsum('bhvk,bhk->bhv', S, r_t)

    S, ys = lax.scan(step, state, xs, reverse=reverse)
    return S, jnp.swapaxes(ys, 0, 1)


def rwkv_output(y, r, k, v, g, r_k, lnx_g, lnx_b, wo):
    B, T = y.shape[:2]
    mu = y.mean(-1, keepdims=True)
    var = jnp.square(y - mu).mean(-1, keepdims=True)
    yn = ((y - mu) * lax.rsqrt(var + RW_LNX_EPS)).reshape(B, T, D_MODEL) * lnx_g + lnx_b
    bonus = (jnp.sum(r * k * r_k, axis=-1, keepdims=True) * v).reshape(B, T, D_MODEL)
    return ((yn + bonus).astype(g.dtype) * g) @ wo


def rwkv_mixer(h, hc, mu, wr, wk, wv, w0, w1, w2, a0, a1, a2, g1, g2, k_k, k_a,
               r_k, lnx_g, lnx_b, wo, need_ctx_out):
    prm = (mu, wr, wk, wv, w0, w1, w2, a0, a1, a2, g1, g2, k_k, k_a)
    r, k, v, g, dirs = rwkv_inputs(h, *prm)
    rc, kc, vc, gc, dirs_c = rwkv_inputs(hc, *prm)
    S0 = jnp.zeros((h.shape[0], RW_HEADS, RW_HEAD, RW_HEAD), jnp.float32)
    y_lat, y_ctx = 0.0, 0.0
    for d, rev in enumerate((False, True)):
        wc_d, kc_d, ac_d, bc_d = dirs_c[d]
        Sc, yc = rwkv_scan(S0, rc, wc_d, kc_d, vc, ac_d, bc_d, rev)
        w_d, k_d, a_d, b_d = dirs[d]
        _, yl = rwkv_scan(Sc, r, w_d, k_d, v, a_d, b_d, rev)
        y_lat = y_lat + yl
        y_ctx = y_ctx + yc
    out = rwkv_output(y_lat, r, k, v, g, r_k, lnx_g, lnx_b, wo)
    out_c = rwkv_output(y_ctx, rc, kc, vc, gc, r_k, lnx_g, lnx_b, wo) if need_ctx_out else None
    return out, out_c


def rotate(xs, ang):
    x1, x2 = jnp.split(xs, 2, axis=-1)
    c, s = jnp.cos(ang).astype(xs.dtype), jnp.sin(ang).astype(xs.dtype)
    return jnp.concatenate([x1 * c - x2 * s, x2 * c + x1 * s], axis=-1)


def axial_rope(x, rows, cols):
    half = x.shape[-1] // 2
    inv = 1.0 / (ROPE_BASE ** (jnp.arange(0, half, 2, dtype=jnp.float32) / half))
    shp = (1, x.shape[1]) + (1,) * (x.ndim - 3) + (half // 2,)
    ang_r = (rows.astype(jnp.float32)[:, None] * inv).reshape(shp)
    ang_c = (cols.astype(jnp.float32)[:, None] * inv).reshape(shp)
    return jnp.concatenate([rotate(x[..., :half], ang_r), rotate(x[..., half:], ang_c)], axis=-1)


def qkv_split(h, wqkv):
    B, T, _ = h.shape
    qkv = h @ wqkv
    nq, nk = ATT_Q_HEADS * ATT_HEAD, ATT_KV_HEADS * ATT_HEAD
    q = qkv[..., :nq].reshape(B, T, ATT_KV_HEADS, ATT_GROUP, ATT_HEAD)
    k = qkv[..., nq:nq + nk].reshape(B, T, ATT_KV_HEADS, ATT_HEAD)
    v = qkv[..., nq + nk:].reshape(B, T, ATT_KV_HEADS, ATT_HEAD)
    return q, k, v


def attn_mixer(h, hc, wqkv, wo, sink, need_ctx_out):
    B, T, _ = h.shape
    L = hc.shape[1]
    ROWS = T // GRID_W
    rows = jnp.repeat(jnp.arange(ROWS), GRID_W)
    cols = jnp.tile(jnp.arange(GRID_W), ROWS)
    scale = ATT_HEAD ** -0.5
    sink_l = sink.reshape(ATT_KV_HEADS, ATT_GROUP).astype(jnp.float32)

    q, k, v = qkv_split(h, wqkv)
    q = axial_rope(q, rows, cols) * scale
    k = axial_rope(k, rows, cols)
    qc, kc, vc = qkv_split(hc, wqkv)

    nb = T // BLOCK
    span = BLOCK + 2 * WINDOW
    qb = q.reshape(B, nb, BLOCK, ATT_KV_HEADS, ATT_GROUP, ATT_HEAD)
    pad = ((0, 0), (WINDOW, WINDOW), (0, 0), (0, 0))
    idx = jnp.arange(nb)[:, None] * BLOCK + jnp.arange(span)[None, :]
    kw = jnp.pad(k, pad)[:, idx]
    vw = jnp.pad(v, pad)[:, idx]
    kpos = idx - WINDOW
    qpos = jnp.arange(nb)[:, None] * BLOCK + jnp.arange(BLOCK)[None, :]
    valid = ((kpos[:, None, :] >= 0) & (kpos[:, None, :] < T)
             & (jnp.abs(qpos[:, :, None] - kpos[:, None, :]) <= WINDOW))

    s_loc = jnp.einsum('bnqhgd,bnkhd->bnhgqk', qb, kw).astype(jnp.float32)
    s_loc = jnp.where(valid[None, :, None, None], s_loc, NEG)
    s_ctx = jnp.einsum('bnqhgd,bchd->bnhgqc', qb, kc).astype(jnp.float32)
    s_sink = jnp.broadcast_to(sink_l[None, None, :, :, None, None], s_ctx.shape[:-1] + (1,))
    p = jax.nn.softmax(jnp.concatenate([s_sink, s_ctx, s_loc], axis=-1), axis=-1).astype(v.dtype)
    o = (jnp.einsum('bnhgqc,bchd->bnqhgd', p[..., 1:1 + L], vc)
         + jnp.einsum('bnhgqk,bnkhd->bnqhgd', p[..., 1 + L:], vw))
    out = o.reshape(B, T, ATT_Q_HEADS * ATT_HEAD) @ wo

    out_c = None
    if need_ctx_out:
        sc = jnp.einsum('bqhgd,bchd->bhgqc', qc * scale, kc).astype(jnp.float32)
        sc_sink = jnp.broadcast_to(sink_l[None, :, :, None, None], sc.shape[:-1] + (1,))
        pc = jax.nn.softmax(jnp.concatenate([sc_sink, sc], axis=-1), axis=-1)[..., 1:].astype(vc.dtype)
        oc = jnp.einsum('bhgqc,bchd->bqhgd', pc, vc)
        out_c = oc.reshape(B, L, ATT_Q_HEADS * ATT_HEAD) @ wo
    return out, out_c


def ec_moe(h, router_w, w_gate, w_up, w_down):
    B, T, D = h.shape
    cap = EC_CAPACITY * T // N_EXPERTS
    aff = jax.nn.softmax((h @ router_w).astype(jnp.float32), axis=-1)
    gates, idx = lax.top_k(jnp.swapaxes(aff, 1, 2), cap)
    xin = jax.vmap(lambda hb, ib: hb[ib])(h, idx)
    a = jnp.einsum('becd,edf->becf', xin, w_gate)
    u = jnp.einsum('becd,edf->becf', xin, w_up)
    y = jnp.einsum('becf,efd->becd', jax.nn.silu(a) * u, w_down)
    y = y * gates[..., None].astype(y.dtype)
    return jax.vmap(lambda yb, ib: jnp.zeros((T, D), yb.dtype).at[ib.reshape(-1)].add(
        yb.reshape(-1, D)))(y, idx)


def setup_inputs(seed: int = 0) -> dict:
    key = jax.random.key(seed)
    ks = iter(jax.random.split(key, 48))
    nrm = lambda shape, s: jax.random.normal(next(ks), shape, jnp.float32) * s
    D, E, F = D_MODEL, N_EXPERTS, D_EXPERT
    H, N = RW_HEADS, RW_HEAD
    NR, NA = N_RWKV, N_ATTN
    qkv_w = (ATT_Q_HEADS + 2 * ATT_KV_HEADS) * ATT_HEAD
    return {
        "x": nrm((BATCH, SEQ, D), 1.0),
        "c": nrm((BATCH, D), 1.0),
        "ctx": nrm((BATCH, CTX_LEN, D), 1.0),
        "c_ctx": nrm((D,), 1.0),
        "ada_w": nrm((DEPTH, D, N_MOD * D), D ** -0.5),
        "ada_b": nrm((DEPTH, N_MOD * D), 0.01),
        "ln1_g": 1.0 + nrm((DEPTH, D), 0.02),
        "ln1_b": nrm((DEPTH, D), 0.02),
        "ln2_g": 1.0 + nrm((DEPTH, D), 0.02),
        "ln2_b": nrm((DEPTH, D), 0.02),
        "rw_mu": jax.random.uniform(next(ks), (NR, 6, D), jnp.float32),
        "rw_wr": nrm((NR, D, D), D ** -0.5),
        "rw_wk": nrm((NR, D, D), D ** -0.5),
        "rw_wv": nrm((NR, D, D), D ** -0.5),
        "rw_w0": nrm((NR, 2, D), 1.0),
        "rw_w1": nrm((NR, 2, D, RW_DECAY_LORA), D ** -0.5),
        "rw_w2": nrm((NR, 2, RW_DECAY_LORA, D), 0.1 * RW_DECAY_LORA ** -0.5),
        "rw_a0": nrm((NR, 2, D), 0.5),
        "rw_a1": nrm((NR, 2, D, RW_A_LORA), D ** -0.5),
        "rw_a2": nrm((NR, 2, RW_A_LORA, D), 0.1 * RW_A_LORA ** -0.5),
        "rw_g1": nrm((NR, D, RW_GATE_LORA), D ** -0.5),
        "rw_g2": nrm((NR, RW_GATE_LORA, D), RW_GATE_LORA ** -0.5),
        "rw_kk": 0.85 + nrm((NR, D), 0.1),
        "rw_ka": 1.0 + nrm((NR, D), 0.1),
        "rw_rk": nrm((NR, H, N), 0.1),
        "rw_lnx_g": 1.0 + nrm((NR, D), 0.02),
        "rw_lnx_b": nrm((NR, D), 0.02),
        "rw_wo": nrm((NR, D, D), BETA * D ** -0.5),
        "at_wqkv": nrm((NA, D, qkv_w), D ** -0.5),
        "at_wo": nrm((NA, ATT_Q_HEADS * ATT_HEAD, D), BETA * (ATT_Q_HEADS * ATT_HEAD) ** -0.5),
        "at_sink": nrm((NA, ATT_Q_HEADS), 0.5),
        "router_w": nrm((DEPTH, D, E), D ** -0.5),
        "moe_w_gate": nrm((DEPTH, E, D, F), D ** -0.5),
        "moe_w_up": nrm((DEPTH, E, D, F), D ** -0.5),
        "moe_w_down": nrm((DEPTH, E, F, D), BETA * F ** -0.5),
    }


def reference(x, c, ctx, c_ctx, ada_w, ada_b, ln1_g, ln1_b, ln2_g, ln2_b,
              rw_mu, rw_wr, rw_wk, rw_wv, rw_w0, rw_w1, rw_w2, rw_a0, rw_a1, rw_a2,
              rw_g1, rw_g2, rw_kk, rw_ka, rw_rk, rw_lnx_g, rw_lnx_b, rw_wo,
              at_wqkv, at_wo, at_sink, router_w, moe_w_gate, moe_w_up, moe_w_down):
    B = x.shape[0]
    for i in range(DEPTH):
        last = i == DEPTH - 1
        j = i // N_MIXERS
        mod = (jax.nn.silu(c) @ ada_w[i] + ada_b[i]).reshape(B, N_MOD, 1, D_MODEL)
        mod_c = (jax.nn.silu(c_ctx) @ ada_w[i] + ada_b[i]).reshape(N_MOD, D_MODEL)
        h = modulate(x, mod[:, 0], mod[:, 1])
        hc = modulate(ctx, mod_c[0], mod_c[1])
        if i % N_MIXERS == 0:
            o, oc = rwkv_mixer(h, hc, rw_mu[j], rw_wr[j], rw_wk[j], rw_wv[j],
                               rw_w0[j], rw_w1[j], rw_w2[j], rw_a0[j], rw_a1[j], rw_a2[j],
                               rw_g1[j], rw_g2[j], rw_kk[j], rw_ka[j], rw_rk[j],
                               rw_lnx_g[j], rw_lnx_b[j], rw_wo[j], not last)
        else:
            o, oc = attn_mixer(h, hc, at_wqkv[j], at_wo[j], at_sink[j], not last)
        x = layer_norm(ALPHA * x + mod[:, 2] * o, ln1_g[i], ln1_b[i])
        h = modulate(x, mod[:, 3], mod[:, 4])
        x = layer_norm(ALPHA * x + mod[:, 5] * ec_moe(h, router_w[i], moe_w_gate[i], moe_w_up[i],
                                                      moe_w_down[i]), ln2_g[i], ln2_b[i])
        if not last:
            ctx = layer_norm(ALPHA * ctx + mod_c[2] * oc, ln1_g[i], ln1_b[i])
            hc = modulate(ctx, mod_c[3], mod_c[4])
            ctx = layer_norm(ALPHA * ctx + mod_c[5] * ec_moe(hc, router_w[i], moe_w_gate[i], moe_w_up[i],
                                                             moe_w_down[i]), ln2_g[i], ln2_b[i])
    return x
```

```cpp
#include <hip/hip_runtime.h>
#include <hip/hip_cooperative_groups.h>
#include <cstdio>
#include <cstdint>
namespace cg = cooperative_groups;

#ifndef MK_SINGLE
#define MK_SINGLE 1
#endif

typedef short bf16x8 __attribute__((ext_vector_type(8)));
typedef float f32x4 __attribute__((ext_vector_type(4)));
typedef unsigned short bf16_t;

#define DM 1024
#define TLAT 8192
#define LCTX 256
#define ROWS_LAT 16384
#define ROWS_CTX 512
#define ROWS 16896
#define NTHR 256
#define ALPHA_F 1.41421356237f
#define MPAD0 2176
#define MPAD1 2048

struct Params {
    const float *x, *c, *ctx, *c_ctx, *ada_w, *ada_b, *ln1_g, *ln1_b, *ln2_g, *ln2_b;
    const float *rw_mu, *rw_wr, *rw_wk, *rw_wv, *rw_w0, *rw_w1, *rw_w2, *rw_a0, *rw_a1, *rw_a2, *rw_g1, *rw_g2;
    const float *rw_kk, *rw_ka, *rw_rk, *rw_lnx_g, *rw_lnx_b, *rw_wo;
    const float *at_wqkv, *at_wo, *at_sink, *router_w, *moe_w_gate, *moe_w_up, *moe_w_down;
    float* out;
    unsigned* bar;
    float* modv;
    float* modp;
    float* rope;
    float* afft;
    int* inv;
    int* idx;
    float* gate;
    float* X1;
    float* PRE;
    bf16_t* HB;
    bf16_t* XXB;
    bf16_t* H2;
    bf16_t *R, *K, *V;
    bf16_t *KK, *W0, *W1;
    bf16_t *AD0, *AD1;
    bf16_t *CM, *CN, *CR, *CY, *CS;
    bf16_t* G;
    bf16_t* LH;
    float *Y0, *Y1;
    bf16_t* HMID;
    bf16_t* YE;
    bf16_t *Q, *KA, *VTL, *VTC, *O;
    bf16_t* XM;
    bf16_t *wrT, *wkT, *wvT, *woT, *l1T, *g2T, *w2T, *a2T, *wqkvT, *atwoT;
    bf16_t* CW;
    int ph_lo, ph_hi;
};

struct Ctx { int tid, bid, nb; };
typedef const __attribute__((address_space(4))) Params& PRef;
typedef const __attribute__((address_space(4))) Params* PPtr;
__device__ __forceinline__ unsigned short f2bf(float f) {
    unsigned u = __float_as_uint(f);
    u += 0x7fffu + ((u >> 16) & 1u);
    return (unsigned short)(u >> 16);
}
__device__ __forceinline__ unsigned pack2(float lo, float hi) { return (unsigned)f2bf(lo) | ((unsigned)f2bf(hi) << 16); }
__device__ __forceinline__ float bflo(unsigned u) { return __uint_as_float(u << 16); }
__device__ __forceinline__ float bfhi(unsigned u) { return __uint_as_float(u & 0xffff0000u); }
__device__ __forceinline__ float sigmoidf_(float v) { return 1.f / (1.f + __expf(-v)); }
__device__ __forceinline__ float shx(float v, int o, int lane) { return __int_as_float(__builtin_amdgcn_ds_bpermute((lane ^ o) << 2, __float_as_int(v))); }
__device__ __forceinline__ int shxi(int v, int o, int lane) { return __builtin_amdgcn_ds_bpermute((lane ^ o) << 2, v); }
__device__ __forceinline__ int shidx(int v, int src) { return __builtin_amdgcn_ds_bpermute(src << 2, v); }
__device__ __forceinline__ float wsum_l(float v, int lane) {
#pragma unroll
    for (int o = 32; o > 0; o >>= 1) v += shx(v, o, lane);
    return v;
}
#define wsum(v) wsum_l((v), lane)
__device__ __forceinline__ int mod_of_row(int row) { return row < ROWS_LAT ? (row >> 13) : 2; }
__device__ __forceinline__ const float* xin_row(PRef p, int row) {
    return row < ROWS_LAT ? p.x + (size_t)row * DM : p.ctx + (size_t)(row - ROWS_LAT) * DM;
}

#define XB_TMO      128
#define XB_XCNT(j)  (256  + 64 * (j))
#define XB_XSUB(j)  (1280 + 64 * (j))
#define XB_XGEN(j)  (2304 + 64 * (j))
#define XB_TOP      3328
#define XB_TOPGEN   3392
#define XCD_BAR_WORDS 3456
#define XB_SPIN_CAP (1u << 22)
#define LAS __attribute__((address_space(3)))
__device__ __forceinline__ unsigned xb_ld(unsigned* p)              { return __hip_atomic_load(p, __ATOMIC_RELAXED, __HIP_MEMORY_SCOPE_AGENT); }
__device__ __forceinline__ unsigned xb_add(unsigned* p, unsigned v) { return __hip_atomic_fetch_add(p, v, __ATOMIC_RELAXED, __HIP_MEMORY_SCOPE_AGENT); }
__device__ __forceinline__ unsigned xb_xcc_id() { return (unsigned)__builtin_amdgcn_s_getreg((3 << 11) | 20) & 0xFu; }
#define XB_SPIN(cond, bar) do { unsigned _sp = 0; while (cond) { __builtin_amdgcn_s_sleep(1); \
    if ((++_sp & 255u) == 0u) { if (xb_ld(&(bar)[XB_TMO])) break; if (_sp > XB_SPIN_CAP) { atomicAdd(&(bar)[XB_TMO], 1u); break; } } } } while (0)
struct XcdBarrier { unsigned* bar; unsigned x; volatile unsigned* st; };
__device__ __forceinline__ XcdBarrier xcd_barrier_post(unsigned* bar, volatile unsigned* st) {
    XcdBarrier b; b.bar = bar; b.x = xb_xcc_id(); b.st = st;
    if (threadIdx.x == 0) (void)xb_add(&bar[XB_XCNT(b.x)], 1u);
    return b;
}
__device__ __forceinline__ void xcd_barrier_complete(unsigned* bar, unsigned x, unsigned& nloc, unsigned& nx) {
    const unsigned G = gridDim.x * gridDim.y * gridDim.z;
    unsigned sum, cnt, mine, sp = 0u;
    for (;;) {
        sum = 0u; cnt = 0u; mine = 0u;
#pragma unroll
        for (unsigned j = 0; j < 16; ++j) { const unsigned c = xb_ld(&bar[XB_XCNT(j)]); sum += c; cnt += (c > 0u) ? 1u : 0u; }
        mine = xb_ld(&bar[XB_XCNT(x)]);
        if (sum == G) break;
        __builtin_amdgcn_s_sleep(1);
        if ((++sp & 255u) == 0u) { if (xb_ld(&bar[XB_TMO])) break; if (sp > XB_SPIN_CAP) { atomicAdd(&bar[XB_TMO], 1u); break; } }
    }
    nloc = mine > 0u ? mine : 1u; nx = cnt > 0u ? cnt : 1u;
}
__device__ __forceinline__ void xcd_barrier(const XcdBarrier& b) {
    asm volatile("s_waitcnt vmcnt(0)" ::: "memory");
    __syncthreads();
    if (threadIdx.x == 0) {
        unsigned* bar = b.bar;
        __builtin_amdgcn_s_waitcnt(0);
        unsigned nloc = b.st[0], nx = b.st[1];
        if (nloc == 0u) { xcd_barrier_complete(bar, b.x, nloc, nx); b.st[0] = nloc; b.st[1] = nx; }
        const unsigned old = xb_add(&bar[XB_XSUB(b.x)], 1u);
        const unsigned gen = old / nloc;
        if (old + 1u == (gen + 1u) * nloc) {
            __builtin_amdgcn_fence(__ATOMIC_RELEASE, "agent");
            asm volatile("s_waitcnt vmcnt(0)" ::: "memory");
            const unsigned og = xb_add(&bar[XB_TOP], 1u);
            const unsigned tg = og / nx;
            if (og + 1u == (tg + 1u) * nx) xb_add(&bar[XB_TOPGEN], 1u);
            else XB_SPIN(xb_ld(&bar[XB_TOPGEN]) == tg, bar);
            __builtin_amdgcn_fence(__ATOMIC_ACQUIRE, "agent");
            xb_add(&bar[XB_XGEN(b.x)], 1u);
            asm volatile("s_waitcnt vmcnt(0)" ::: "memory");
        } else {
            XB_SPIN(xb_ld(&bar[XB_XGEN(b.x)]) == gen, bar);
            __builtin_amdgcn_fence(__ATOMIC_ACQUIRE, "agent");
            asm volatile("s_waitcnt vmcnt(0)" ::: "memory");
        }
    }
    __syncthreads();
}

#define G_BK 32
#define G_LDSROW 40
#define G_BUFB (128 * G_LDSROW * 2)
#define G_LDS_BYTES (4 * G_BUFB)

struct ALBf16 {
    struct Raw { uint4 a, b; };
    const bf16_t* rowp;
    __device__ __forceinline__ Raw ld(int k) const { Raw r; r.a = *(const uint4*)(rowp + k); r.b = *(const uint4*)(rowp + k + 8); return r; }
    __device__ __forceinline__ void cvt(const Raw& r, int k, uint4& lo, uint4& hi) const { lo = r.a; hi = r.b; }
};
struct ALMix {
    struct Raw { uint4 h0, h1, x0, x1; };
    const bf16_t *hp, *xp; const float* mu;
    __device__ __forceinline__ Raw ld(int k) const { Raw r; r.h0 = *(const uint4*)(hp + k); r.h1 = *(const uint4*)(hp + k + 8); r.x0 = *(const uint4*)(xp + k); r.x1 = *(const uint4*)(xp + k + 8); return r; }
    __device__ __forceinline__ unsigned mix2(unsigned h, unsigned x, float m0, float m1) const { return pack2(bflo(h) + bflo(x) * m0, bfhi(h) + bfhi(x) * m1); }
    __device__ __forceinline__ void cvt(const Raw& r, int k, uint4& lo, uint4& hi) const {
        const float4 m0 = *(const float4*)(mu + k), m1 = *(const float4*)(mu + k + 4), m2 = *(const float4*)(mu + k + 8), m3 = *(const float4*)(mu + k + 12);
        lo.x = mix2(r.h0.x, r.x0.x, m0.x, m0.y); lo.y = mix2(r.h0.y, r.x0.y, m0.z, m0.w); lo.z = mix2(r.h0.z, r.x0.z, m1.x, m1.y); lo.w = mix2(r.h0.w, r.x0.w, m1.z, m1.w);
        hi.x = mix2(r.h1.x, r.x1.x, m2.x, m2.y); hi.y = mix2(r.h1.y, r.x1.y, m2.z, m2.w); hi.z = mix2(r.h1.z, r.x1.z, m3.x, m3.y); hi.w = mix2(r.h1.w, r.x1.w, m3.z, m3.w);
    }
};

template <class AL, class EPI>
__device__ __forceinline__ void gemm_tile(const Ctx cx, const AL& al, const float* bp  , int ldb, int K, const EPI& epi, char* lds) {
    const int tid = cx.tid, lane = tid & 63, wid = tid >> 6, wr = wid >> 1, wc = wid & 1, fr = lane & 15, fq = lane >> 4;
    const int arow = tid >> 1, akq = (tid & 1) * 16;
    const int bn4 = (tid & 31) * 4, bk4 = (tid >> 5) * 4;
    f32x4 acc[4][4];
#pragma unroll
    for (int i = 0; i < 4; ++i)
#pragma unroll
        for (int j = 0; j < 4; ++j) acc[i][j] = (f32x4){0.f, 0.f, 0.f, 0.f};
    const int nk = K / G_BK;
    typename AL::Raw ra; float4 rb0, rb1, rb2, rb3;
    auto ldB = [&](int k0) {
        const float* q = bp + (size_t)(k0 + bk4) * ldb;
        rb0 = *(const float4*)(q); rb1 = *(const float4*)(q + ldb); rb2 = *(const float4*)(q + 2 * (size_t)ldb); rb3 = *(const float4*)(q + 3 * (size_t)ldb);
    };
    auto stage = [&](int buf, int k0) {
        char* As = lds + buf * 2 * G_BUFB; char* Bs = As + G_BUFB;
        uint4 lo, hi; al.cvt(ra, k0 + akq, lo, hi);
        *(uint4*)(As + arow * (G_LDSROW * 2) + akq * 2) = lo;
        *(uint4*)(As + arow * (G_LDSROW * 2) + akq * 2 + 16) = hi;
        uint2 w;
        w.x = pack2(rb0.x, rb1.x); w.y = pack2(rb2.x, rb3.x); *(uint2*)(Bs + (bn4 + 0) * (G_LDSROW * 2) + bk4 * 2) = w;
        w.x = pack2(rb0.y, rb1.y); w.y = pack2(rb2.y, rb3.y); *(uint2*)(Bs + (bn4 + 1) * (G_LDSROW * 2) + bk4 * 2) = w;
        w.x = pack2(rb0.z, rb1.z); w.y = pack2(rb2.z, rb3.z); *(uint2*)(Bs + (bn4 + 2) * (G_LDSROW * 2) + bk4 * 2) = w;
        w.x = pack2(rb0.w, rb1.w); w.y = pack2(rb2.w, rb3.w); *(uint2*)(Bs + (bn4 + 3) * (G_LDSROW * 2) + bk4 * 2) = w;
    };
    ra = al.ld(akq); ldB(0);
    stage(0, 0);
    __syncthreads();
    for (int kt = 0; kt < nk; ++kt) {
        const bool more = (kt + 1 < nk);
        if (more) { ra = al.ld((kt + 1) * G_BK + akq); ldB((kt + 1) * G_BK); }
        const char* As = lds + (kt & 1) * 2 * G_BUFB; const char* Bs = As + G_BUFB;
        bf16x8 af[4], bfr[4];
#pragma unroll
        for (int i = 0; i < 4; ++i) {
            af[i] = *(const bf16x8*)(As + (wr * 64 + i * 16 + fr) * (G_LDSROW * 2) + fq * 16);
            bfr[i] = *(const bf16x8*)(Bs + (wc * 64 + i * 16 + fr) * (G_LDSROW * 2) + fq * 16);
        }
#pragma unroll
        for (int i = 0; i < 4; ++i)
#pragma unroll
            for (int j = 0; j < 4; ++j) acc[i][j] = __builtin_amdgcn_mfma_f32_16x16x32_bf16(bfr[j], af[i], acc[i][j], 0, 0, 0);
        if (more) stage((kt + 1) & 1, (kt + 1) * G_BK);
        __syncthreads();
    }
    epi(acc, wr, wc, fr, fq);
}

#define G2_STAGE 32768
__device__ __forceinline__ void glds16(const bf16_t* g, char* l) {
    __builtin_amdgcn_global_load_lds((const unsigned*)g, (__attribute__((address_space(3))) unsigned*)l, 16, 0, 0);
}
template <class EPI>
__device__ __forceinline__ void gemm2_tile(const Ctx cx, const bf16_t* a0, const bf16_t* a1, const bf16_t* a2, const bf16_t* a3,
                                           const bf16_t* b0, const bf16_t* b1, const bf16_t* b2, const bf16_t* b3, int K, const EPI& epi, char* lds) {
    const int tid = cx.tid, lane = tid & 63, wid = __builtin_amdgcn_readfirstlane(tid >> 6), wr = wid >> 1, wc = wid & 1, fr = lane & 15, fq = lane >> 4;
    f32x4 acc[4][4];
#pragma unroll
    for (int i = 0; i < 4; ++i)
#pragma unroll
        for (int j = 0; j < 4; ++j) acc[i][j] = (f32x4){0.f, 0.f, 0.f, 0.f};
    const int nk = K >> 6;
    auto issue = [&](int kt, int st) {
        char* sa = lds + st * G2_STAGE + wid * 1024;
        const int ko = kt * 64;
        glds16(a0 + ko, sa); glds16(a1 + ko, sa + 4096); glds16(a2 + ko, sa + 8192); glds16(a3 + ko, sa + 12288);
        glds16(b0 + ko, sa + 16384); glds16(b1 + ko, sa + 20480); glds16(b2 + ko, sa + 24576); glds16(b3 + ko, sa + 28672);
    };
    issue(0, 0);
    asm volatile("s_waitcnt vmcnt(0)" ::: "memory");
    __builtin_amdgcn_s_barrier();
    for (int kt = 0; kt < nk; ++kt) {
        if (kt + 1 < nk) issue(kt + 1, (kt + 1) & 1);
        const char* As = lds + (kt & 1) * G2_STAGE; const char* Bs = As + 16384;
#pragma unroll
        for (int ks = 0; ks < 2; ++ks) {
            const int co = ((ks * 4 + fq) ^ (fr & 7)) << 4;
            bf16x8 af[4], bfr[4];
#pragma unroll
            for (int i = 0; i < 4; ++i) {
                af[i] = *(const bf16x8*)(As + (wr * 64 + i * 16 + fr) * 128 + co);
                bfr[i] = *(const bf16x8*)(Bs + (wc * 64 + i * 16 + fr) * 128 + co);
            }
#pragma unroll
            for (int i = 0; i < 4; ++i)
#pragma unroll
                for (int j = 0; j < 4; ++j) acc[i][j] = __builtin_amdgcn_mfma_f32_16x16x32_bf16(bfr[j], af[i], acc[i][j], 0, 0, 0);
        }
        asm volatile("s_waitcnt vmcnt(0) lgkmcnt(0)" ::: "memory");
        __builtin_amdgcn_s_barrier();
    }
    epi(acc, wr, wc, fr, fq);
}
#define G3_STAGE 16384
#define G3_H(q) ((0x1320 >> (4 * (q))) & 3)
#define G3_ROW(i) ((i) * 64 + (cx.tid >> 2))
#define G3_CH8 ((((cx.tid) & 3) ^ G3_H(((cx.tid) >> 4) & 3)) * 8)
struct G3Next { bool has; const bf16_t *a0, *a1, *b0, *b1; int K; };
template <class EPI>
__device__ __forceinline__ void gemm3_tile(const Ctx cx, const bf16_t* a0, const bf16_t* a1, const bf16_t* b0, const bf16_t* b1, int K, const EPI& epi, char* lds, bool pre = false, G3Next nx = G3Next{false, nullptr, nullptr, nullptr, nullptr, 0}) {
    const int tid = cx.tid, lane = tid & 63, wid = __builtin_amdgcn_readfirstlane(tid >> 6), wr = wid >> 1, wc = wid & 1, fr = lane & 15, fq = lane >> 4;
    f32x4 acc[4][4];
#pragma unroll
    for (int i = 0; i < 4; ++i)
#pragma unroll
        for (int j = 0; j < 4; ++j) acc[i][j] = (f32x4){0.f, 0.f, 0.f, 0.f};
    const int nk = K >> 5;
    auto issue = [&](int kt) {
        char* sa = lds + (kt & 3) * G3_STAGE + wid * 1024;
        const int ko = kt * 32;
        glds16(a0 + ko, sa); glds16(a1 + ko, sa + 4096); glds16(b0 + ko, sa + 8192); glds16(b1 + ko, sa + 12288);
    };
    if (!pre) { issue(0); if (nk > 1) issue(1); if (nk > 2) issue(2); }
    else asm volatile("s_waitcnt vmcnt(0)" ::: "memory");
    const int co = (fq ^ G3_H((fr >> 2) & 3)) << 4;
    for (int kt = 0; kt < nk; ++kt) {
        if (kt + 2 < nk) asm volatile("s_waitcnt vmcnt(8)" ::: "memory");
        else if (kt + 1 < nk) asm volatile("s_waitcnt vmcnt(4)" ::: "memory");
        else asm volatile("s_waitcnt vmcnt(0)" ::: "memory");
        asm volatile("s_waitcnt lgkmcnt(0)" ::: "memory");
        __builtin_amdgcn_s_barrier();
        if (kt + 3 < nk) issue(kt + 3);
        const char* As = lds + (kt & 3) * G3_STAGE; const char* Bs = As + 8192;
        bf16x8 af[4], bfr[4];
#pragma unroll
        for (int i = 0; i < 4; ++i) {
            af[i] = *(const bf16x8*)(As + (wr * 64 + i * 16 + fr) * 64 + co);
            bfr[i] = *(const bf16x8*)(Bs + (wc * 64 + i * 16 + fr) * 64 + co);
        }
#pragma unroll
        for (int i = 0; i < 4; ++i)
#pragma unroll
            for (int j = 0; j < 4; ++j) acc[i][j] = __builtin_amdgcn_mfma_f32_16x16x32_bf16(bfr[j], af[i], acc[i][j], 0, 0, 0);
    }
    asm volatile("s_waitcnt lgkmcnt(0)" ::: "memory");
    __builtin_amdgcn_s_barrier();
    if (nx.has) {
        const int nkn = nx.K >> 5;
#pragma unroll
        for (int st = 0; st < 3; ++st) if (st < nkn) {
            char* sa = lds + st * G3_STAGE + wid * 1024; const int ko = st * 32;
            glds16(nx.a0 + ko, sa); glds16(nx.a1 + ko, sa + 4096); glds16(nx.b0 + ko, sa + 8192); glds16(nx.b1 + ko, sa + 12288);
        }
    }
    epi(acc, wr, wc, fr, fq);
}
#define G8_HTB 16384
typedef __attribute__((address_space(3))) unsigned char* G8LP;
__device__ __forceinline__ int g8_lds_byte(int r, int c) { const int st = (r >> 4) * 2 + (c >> 5), rr = r & 15, cc = c & 31, ob = rr * 64 + cc * 2; return st * 1024 + (ob ^ (((ob >> 9) & 1) << 5)); }
__device__ __forceinline__ void g8_stage_rc(int b, int& R, int& C) { const int st = b / 1024, sb = b % 1024, swz = sb ^ (((sb >> 9) & 1) << 5); R = (st >> 1) * 16 + swz / 64; C = (st & 1) * 32 + (swz % 64) / 2; }
struct Unit8 { int pm, pn, e; };
__device__ __forceinline__ int fresh_zero() { int z = 0; asm volatile("" : "+v"(z)); return z; }
__device__ __forceinline__ int fresh_lane() { int l; asm volatile("v_mbcnt_lo_u32_b32 %0, -1, 0\n\tv_mbcnt_hi_u32_b32 %0, -1, %0" : "=v"(l)); return l; }
template <class P>
__device__ __forceinline__ void gemm8(const Ctx px, char* ldsg, const P& prob) {
    G8LP lds = (G8LP)ldsg;
    const int tid = px.tid, wid = __builtin_amdgcn_readfirstlane(tid >> 6), lane = tid & 63, wr = wid >> 2, wc = wid & 3, fr = lane & 15, fq = lane >> 4;
    const int nt = prob.K / 64;
    int R0, C0, R1, C1; g8_stage_rc(tid * 16, R0, C0); g8_stage_rc(tid * 16 + 8192, R1, C1);
    Unit8 cur, nxt; int ui = 0;
    if (!prob.next(0, cur)) return;
    unsigned cA[2][2], cB[2][2], nA[2][2], nB[2][2];
#define G8_OFFS(u, oa, ob) do { _Pragma("unroll") for (int h_ = 0; h_ < 2; ++h_) { \
        oa[h_][0] = prob.offA(u, h_ * 128 + R0) + (unsigned)C0 * 2u; oa[h_][1] = prob.offA(u, h_ * 128 + R1) + (unsigned)C1 * 2u; \
        ob[h_][0] = prob.offB(u, h_ * 128 + R0) + (unsigned)C0 * 2u; ob[h_][1] = prob.offB(u, h_ * 128 + R1) + (unsigned)C1 * 2u; } } while (0)
    G8_OFFS(cur, cA, cB);
    const char* bAc = prob.baseA(cur); const char* bBc = prob.baseB(cur);
    const unsigned ldsw = (unsigned)wid * 1024u;
    const int aoff = g8_lds_byte(wr * 64 + fr, fq * 8), boff = g8_lds_byte(wc * 32 + fr, fq * 8);
#define G8_SA(b, h) (((b) * 2 + (h)) * G8_HTB)
#define G8_SB(b, h) ((4 + (b) * 2 + (h)) * G8_HTB)
#define G8_STAGE(bufoff, gbase, voff, kb) do { _Pragma("unroll") for (int _i = 0; _i < 2; ++_i) \
        __builtin_amdgcn_global_load_lds((const unsigned*)((gbase) + (size_t)((voff)[_i] + (unsigned)(kb))), (__attribute__((address_space(3))) unsigned*)(lds + (bufoff) + ldsw + _i * 8192), 16, 0, 0); } while (0)
#define G8_LDA(dst, b, h) do { _Pragma("unroll") for (int m = 0; m < 4; ++m) _Pragma("unroll") for (int k = 0; k < 2; ++k) dst[m][k] = *(const __attribute__((address_space(3))) bf16x8*)(lds + G8_SA(b, h) + aoff + m * 2048 + k * 1024); } while (0)
#define G8_LDB(dst, b, h) do { _Pragma("unroll") for (int n = 0; n < 2; ++n) _Pragma("unroll") for (int k = 0; k < 2; ++k) dst[n][k] = *(const __attribute__((address_space(3))) bf16x8*)(lds + G8_SB(b, h) + boff + n * 2048 + k * 1024); } while (0)
#define G8_MMA(ai, bj, At, Bt) do { __builtin_amdgcn_s_setprio(1); _Pragma("unroll") for (int m = 0; m < 4; ++m) _Pragma("unroll") for (int n = 0; n < 2; ++n) _Pragma("unroll") for (int k = 0; k < 2; ++k) \
        acc[ai][bj][m][n] = __builtin_amdgcn_mfma_f32_16x16x32_bf16(Bt[n][k], At[m][k], acc[ai][bj][m][n], 0, 0, 0); __builtin_amdgcn_s_setprio(0); } while (0)
#define G8_WAIT_V(n) asm volatile("s_waitcnt vmcnt(" #n ")" ::: "memory")
#define G8_WAIT_L(n) asm volatile("s_waitcnt lgkmcnt(" #n ")" ::: "memory")
#define G8_BAR __builtin_amdgcn_s_barrier()
#define G8_SCHED __builtin_amdgcn_sched_barrier(0)
    f32x4 acc[2][2][4][2];
#pragma unroll
    for (int a = 0; a < 2; ++a)
#pragma unroll
        for (int b = 0; b < 2; ++b)
#pragma unroll
            for (int m = 0; m < 4; ++m)
#pragma unroll
                for (int n = 0; n < 2; ++n) acc[a][b][m][n] = (f32x4){0.f, 0.f, 0.f, 0.f};
    bf16x8 At[4][2], B0[2][2], B1[2][2];
    G8_STAGE(G8_SB(0, 0), bBc, cB[0], 0); G8_STAGE(G8_SA(0, 0), bAc, cA[0], 0); G8_STAGE(G8_SB(0, 1), bBc, cB[1], 0); G8_STAGE(G8_SA(0, 1), bAc, cA[1], 0);
    if (wr == 1) G8_BAR;
    G8_WAIT_V(4); G8_BAR;
    G8_STAGE(G8_SB(1, 0), bBc, cB[0], 128); G8_STAGE(G8_SA(1, 0), bAc, cA[0], 128); G8_STAGE(G8_SB(1, 1), bBc, cB[1], 128);
    G8_WAIT_V(6); G8_BAR;
    for (;;) {
        const bool has_next = prob.next(ui + 1, nxt);
        const char* bAn = bAc; const char* bBn = bBc;
        if (has_next) { G8_OFFS(nxt, nA, nB); bAn = prob.baseA(nxt); bBn = prob.baseB(nxt); }
        else {
#pragma unroll
            for (int h_ = 0; h_ < 2; ++h_) { nA[h_][0] = cA[h_][0]; nA[h_][1] = cA[h_][1]; nB[h_][0] = cB[h_][0]; nB[h_][1] = cB[h_][1]; }
        }
        for (int t = 0; t < nt; t += 2) {
            const bool last = (t == nt - 2);
            const unsigned k1 = (unsigned)(t + 1) * 128u;
            const char* a2b = last ? bAn : bAc; const char* b2b = last ? bBn : bBc;
            const unsigned k2 = last ? 0u : (unsigned)(t + 2) * 128u, k3 = k2 + 128u;
            unsigned a2o0[2], a2o1[2], b2o0[2], b2o1[2];
            a2o0[0] = last ? nA[0][0] : cA[0][0]; a2o0[1] = last ? nA[0][1] : cA[0][1]; a2o1[0] = last ? nA[1][0] : cA[1][0]; a2o1[1] = last ? nA[1][1] : cA[1][1];
            b2o0[0] = last ? nB[0][0] : cB[0][0]; b2o0[1] = last ? nB[0][1] : cB[0][1]; b2o1[0] = last ? nB[1][0] : cB[1][0]; b2o1[1] = last ? nB[1][1] : cB[1][1];
            G8_LDB(B0, 0, 0); G8_SCHED; G8_LDA(At, 0, 0); G8_STAGE(G8_SA(1, 1), bAc, cA[1], k1);
            G8_WAIT_L(8); G8_BAR; G8_WAIT_L(0); G8_MMA(0, 0, At, B0); G8_BAR; G8_SCHED;
            G8_LDB(B1, 0, 1); G8_STAGE(G8_SB(0, 0), b2b, b2o0, k2);
            G8_BAR; G8_WAIT_L(0); G8_MMA(0, 1, At, B1); G8_BAR;
            G8_LDA(At, 0, 1); G8_STAGE(G8_SA(0, 0), a2b, a2o0, k2);
            G8_BAR; G8_WAIT_L(0); G8_MMA(1, 0, At, B0); G8_BAR; G8_SCHED;
            G8_STAGE(G8_SB(0, 1), b2b, b2o1, k2);
            G8_WAIT_V(6); G8_BAR; G8_MMA(1, 1, At, B1); G8_BAR;
            G8_LDB(B0, 1, 0); G8_SCHED; G8_LDA(At, 1, 0); G8_STAGE(G8_SA(0, 1), a2b, a2o1, k2);
            G8_WAIT_L(8); G8_BAR; G8_WAIT_L(0); G8_MMA(0, 0, At, B0); G8_BAR; G8_SCHED;
            G8_LDB(B1, 1, 1); G8_STAGE(G8_SB(1, 0), b2b, b2o0, k3);
            G8_BAR; G8_WAIT_L(0); G8_MMA(0, 1, At, B1); G8_BAR;
            G8_LDA(At, 1, 1); G8_STAGE(G8_SA(1, 0), a2b, a2o0, k3);
            G8_BAR; G8_WAIT_L(0); G8_MMA(1, 0, At, B0); G8_BAR; G8_SCHED;
            G8_STAGE(G8_SB(1, 1), b2b, b2o1, k3);
            G8_WAIT_V(6); G8_BAR; G8_MMA(1, 1, At, B1); G8_BAR;
        }
        { const int le = fresh_lane(); prob.epi(acc, cur, wr, wc, le & 15, le >> 4); }
        if (!has_next) break;
#pragma unroll
        for (int a = 0; a < 2; ++a)
#pragma unroll
            for (int b = 0; b < 2; ++b)
#pragma unroll
                for (int m = 0; m < 4; ++m)
#pragma unroll
                    for (int n = 0; n < 2; ++n) acc[a][b][m][n] = (f32x4){0.f, 0.f, 0.f, 0.f};
        cur = nxt; bAc = bAn; bBc = bBn; ++ui;
#pragma unroll
        for (int h_ = 0; h_ < 2; ++h_) { cA[h_][0] = nA[h_][0]; cA[h_][1] = nA[h_][1]; cB[h_][0] = nB[h_][0]; cB[h_][1] = nB[h_][1]; }
    }
    G8_WAIT_V(0);
    if (wr == 0) G8_BAR;
    G8_BAR;
#undef G8_OFFS
#undef G8_SA
#undef G8_SB
#undef G8_STAGE
#undef G8_LDA
#undef G8_LDB
#undef G8_MMA
#undef G8_WAIT_V
#undef G8_WAIT_L
#undef G8_BAR
#undef G8_SCHED
}
struct ProbOproj {
    const bf16_t* A; const bf16_t* Wt; float* out; const float* xl; const float* modl; int K; int c, G;
    __device__ __forceinline__ bool next(int i, Unit8& u) const { const int L = i * G + c; if (L >= 256) return false; const int x = L & 7, j = L >> 3; u.pn = j >> 3; u.pm = 8 * x + (j & 7); u.e = 0; return true; }
    __device__ __forceinline__ const char* baseA(const Unit8& u) const { return (const char*)(A + (size_t)u.pm * 256 * DM); }
    __device__ __forceinline__ const char* baseB(const Unit8& u) const { return (const char*)(Wt + (size_t)u.pn * 256 * 1024); }
    __device__ __forceinline__ unsigned offA(const Unit8&, int row) const { return (unsigned)row * (DM * 2); }
    __device__ __forceinline__ unsigned offB(const Unit8&, int rho) const { return (unsigned)rho * 2048u; }
    __device__ __forceinline__ void epi(const f32x4 (&acc)[2][2][4][2], const Unit8& u, int wr, int wc, int fr, int fq) const {
#pragma unroll
        for (int ai = 0; ai < 2; ++ai)
#pragma unroll
            for (int m = 0; m < 4; ++m) {
                const int row = u.pm * 256 + ai * 128 + wr * 64 + m * 16 + fr;
                const float* xr = xl + (size_t)row * DM;
                const float* gt = modl + (size_t)(row >> 13) * 6144 + 2 * 1024;
#pragma unroll
                for (int bj = 0; bj < 2; ++bj)
#pragma unroll
                    for (int n = 0; n < 2; ++n) {
                        const int col = u.pn * 256 + bj * 128 + wc * 32 + n * 16 + 4 * fq;
                        const f32x4 xv = *(const f32x4*)(xr + col), gv = *(const f32x4*)(gt + col);
                        f32x4 o;
#pragma unroll
                        for (int r = 0; r < 4; ++r) o[r] = ALPHA_F * xv[r] + gv[r] * acc[ai][bj][m][n][r];
                        *(f32x4*)(out + (size_t)row * DM + col) = o;
                    }
            }
    }
};
struct ProbRKV {
    PPtr p; int K; int c, G;
    __device__ __forceinline__ bool next(int i, Unit8& u) const { const int L = i * G + c; if (L >= 768) return false; const int cc = L & 255, x = cc & 7, j = cc >> 3; u.pn = (L >> 8) * 4 + (j >> 3); u.pm = 8 * x + (j & 7); u.e = 0; return true; }
    __device__ __forceinline__ const char* baseA(const Unit8& u) const { const int g = u.pn >> 2; const int msel = g == 0 ? 0 : (g == 1 ? 2 : 3); return (const char*)(p->XM + ((size_t)msel * ROWS + (size_t)u.pm * 256) * DM); }
    __device__ __forceinline__ const char* baseB(const Unit8& u) const { const int g = u.pn >> 2; const bf16_t* w = g == 0 ? p->wrT : (g == 1 ? p->wkT : p->wvT); return (const char*)(w + (size_t)(u.pn & 3) * 256 * 1024); }
    __device__ __forceinline__ unsigned offA(const Unit8&, int row) const { return (unsigned)row * 2048u; }
    __device__ __forceinline__ unsigned offB(const Unit8&, int rho) const { const int bj = rho >> 7, wc = (rho >> 5) & 3, w = rho & 31; return (unsigned)(64 * wc + 32 * bj + w) * 2048u; }
    __device__ __forceinline__ void epi(const f32x4 (&acc)[2][2][4][2], const Unit8& u, int wr, int wc, int fr, int fq) const {
        const int g = u.pn >> 2, lane = fr + 16 * fq;
        const int cb = (u.pn & 3) * 256 + 64 * wc + 4 * fq;
        bf16_t* out = g == 0 ? p->R : (g == 1 ? p->K : p->V);
#pragma unroll
        for (int ai = 0; ai < 2; ++ai)
#pragma unroll
            for (int m = 0; m < 4; ++m) {
                const int row = u.pm * 256 + ai * 128 + wr * 64 + m * 16 + fr;
                if (g != 1) {
#pragma unroll
                    for (int bj = 0; bj < 2; ++bj)
#pragma unroll
                        for (int n = 0; n < 2; ++n) {
                            uint2 o; o.x = pack2(acc[ai][bj][m][n][0], acc[ai][bj][m][n][1]); o.y = pack2(acc[ai][bj][m][n][2], acc[ai][bj][m][n][3]);
                            *(uint2*)(out + (size_t)row * DM + cb + 32 * bj + 16 * n) = o;
                        }
                } else {
                    f32x4 kv[2][2]; float ss = 0.f;
#pragma unroll
                    for (int bj = 0; bj < 2; ++bj)
#pragma unroll
                        for (int n = 0; n < 2; ++n) {
                            const int col = cb + 32 * bj + 16 * n;
                            const f32x4 kw = *(const f32x4*)(p->rw_kk + col);
                            uint2 o; o.x = pack2(acc[ai][bj][m][n][0], acc[ai][bj][m][n][1]); o.y = pack2(acc[ai][bj][m][n][2], acc[ai][bj][m][n][3]);
                            *(uint2*)(out + (size_t)row * DM + col) = o;
                            f32x4 t; t[0] = bflo(o.x) * kw[0]; t[1] = bfhi(o.x) * kw[1]; t[2] = bflo(o.y) * kw[2]; t[3] = bfhi(o.y) * kw[3];
                            kv[bj][n] = t; ss += (t[0] * t[0] + t[1] * t[1]) + (t[2] * t[2] + t[3] * t[3]);
                        }
                    ss += shx(ss, 16, lane); ss += shx(ss, 32, lane);
                    const float inv = fminf(__builtin_amdgcn_rsqf(ss), 1e12f);
#pragma unroll
                    for (int bj = 0; bj < 2; ++bj)
#pragma unroll
                        for (int n = 0; n < 2; ++n) { const f32x4 kq_ = kv[bj][n] * inv; uint2 o; o.x = pack2(kq_[0], kq_[1]); o.y = pack2(kq_[2], kq_[3]); *(uint2*)(p->KK + (size_t)row * DM + cb + 32 * bj + 16 * n) = o; }
                }
            }
    }
};
struct ProbQKV {
    PPtr p; int K; int c, G;
    __device__ __forceinline__ bool next(int i, Unit8& u) const { const int L = i * G + c; if (L >= 384) return false; const int cc = L & 255, x = cc & 7, j = cc >> 3; u.pn = (L >> 8) * 4 + (j >> 3); u.pm = 8 * x + (j & 7); u.e = 0; return true; }
    __device__ __forceinline__ const char* baseA(const Unit8& u) const { return (const char*)(p->HB + (size_t)u.pm * 256 * DM); }
    __device__ __forceinline__ const char* baseB(const Unit8& u) const { return (const char*)(p->wqkvT + (size_t)u.pn * 256 * 1024); }
    __device__ __forceinline__ unsigned offA(const Unit8&, int row) const { return (unsigned)row * 2048u; }
    __device__ __forceinline__ unsigned offB(const Unit8&, int rho) const { const int bj = rho >> 7, wc = (rho >> 5) & 3, w = rho & 31; return (unsigned)(64 * wc + 32 * bj + w) * 2048u; }
    __device__ __forceinline__ void epi(const f32x4 (&acc)[2][2][4][2], const Unit8& u, int wr, int wc, int fr, int fq) const {
        const int hs = u.pn * 4 + wc;
#pragma unroll
        for (int ai = 0; ai < 2; ++ai)
#pragma unroll
            for (int m = 0; m < 4; ++m) {
                const int row = u.pm * 256 + ai * 128 + wr * 64 + m * 16 + fr;
                const int t = row & (TLAT - 1), b = row >> 13;
                if (hs < 20) {
                    f32x4 v0 = acc[ai][0][m][0], v1 = acc[ai][0][m][1], v2 = acc[ai][1][m][0], v3 = acc[ai][1][m][1];
                    const int rp = t >> 6, cp = t & 63;
#pragma unroll
                    for (int r = 0; r < 4; ++r) {
                        const int fi = 4 * fq + r;
                        const float2 cr = *(const float2*)(p->rope + 2 * (rp * 16 + fi)), cc = *(const float2*)(p->rope + 2 * (cp * 16 + fi));
                        const float a = v0[r], bb = v1[r]; v0[r] = a * cr.x - bb * cr.y; v1[r] = bb * cr.x + a * cr.y;
                        const float c2 = v2[r], d2 = v3[r]; v2[r] = c2 * cc.x - d2 * cc.y; v3[r] = d2 * cc.x + c2 * cc.y;
                    }
                    const float sc = hs < 16 ? 0.125f : 1.f;
                    bf16_t* dst = hs < 16 ? p->Q + (size_t)row * DM + hs * 64 + 4 * fq : p->KA + (size_t)row * 256 + (hs - 16) * 64 + 4 * fq;
                    uint2 o;
                    o.x = pack2(v0[0] * sc, v0[1] * sc); o.y = pack2(v0[2] * sc, v0[3] * sc); *(uint2*)(dst) = o;
                    o.x = pack2(v1[0] * sc, v1[1] * sc); o.y = pack2(v1[2] * sc, v1[3] * sc); *(uint2*)(dst + 16) = o;
                    o.x = pack2(v2[0] * sc, v2[1] * sc); o.y = pack2(v2[2] * sc, v2[3] * sc); *(uint2*)(dst + 32) = o;
                    o.x = pack2(v3[0] * sc, v3[1] * sc); o.y = pack2(v3[2] * sc, v3[3] * sc); *(uint2*)(dst + 48) = o;
                } else {
                    bf16_t* vt = p->VTL + (size_t)(b * 4 + (hs - 20)) * 64 * TLAT + t;
#pragma unroll
                    for (int bj = 0; bj < 2; ++bj)
#pragma unroll
                        for (int n = 0; n < 2; ++n)
#pragma unroll
                            for (int r = 0; r < 4; ++r) vt[(size_t)(32 * bj + 16 * n + 4 * fq + r) * TLAT] = f2bf(acc[ai][bj][m][n][r]);
                }
            }
    }
};
struct ProbUp {
    PPtr p; int K; int c, G; int layer;
    __device__ __forceinline__ bool next(int i, Unit8& u) const { const int L = i * G + c; if (L >= 2048) return false; const int cc = L & 255, x = cc & 7, j = cc >> 3; u.e = (L >> 8) * 2 + (x >> 2); u.pn = 4 * (x & 3) + (j & 3); u.pm = j >> 2; return true; }
    __device__ __forceinline__ const char* baseA(const Unit8&) const { return (const char*)p->H2; }
    __device__ __forceinline__ const char* baseB(const Unit8& u) const { return (const char*)(p->CW + (size_t)(layer * 16 + u.e) * 3 * 2097152); }
    __device__ __forceinline__ unsigned offA(const Unit8& u, int row) const { const int src = p->idx[u.e * MPAD0 + u.pm * 256 + row]; return (unsigned)src * 2048u; }
    __device__ __forceinline__ unsigned offB(const Unit8& u, int rho) const { const int bj = rho >> 7, wc = (rho >> 5) & 3, n = (rho >> 4) & 1, cc = rho & 15; return (unsigned)n * 4194304u + (unsigned)(128 * u.pn + 64 * bj + 16 * wc + cc) * 2048u; }
    __device__ __forceinline__ void epi(const f32x4 (&acc)[2][2][4][2], const Unit8& u, int wr, int wc, int fr, int fq) const {
        bf16_t* out = p->HMID + (size_t)u.e * MPAD0 * 2048;
#pragma unroll
        for (int ai = 0; ai < 2; ++ai)
#pragma unroll
            for (int m = 0; m < 4; ++m) {
                const int slot = u.pm * 256 + ai * 128 + wr * 64 + m * 16 + fr;
#pragma unroll
                for (int bj = 0; bj < 2; ++bj) {
                    float v[4];
#pragma unroll
                    for (int r = 0; r < 4; ++r) { const float a = acc[ai][bj][m][0][r], uu = acc[ai][bj][m][1][r]; v[r] = a * sigmoidf_(a) * uu; }
                    uint2 o; o.x = pack2(v[0], v[1]); o.y = pack2(v[2], v[3]);
                    *(uint2*)(out + (size_t)slot * 2048 + 128 * u.pn + 64 * bj + 16 * wc + 4 * fq) = o;
                }
            }
    }
};
struct ProbDown {
    PPtr p; int K; int c, G; int layer;
    __device__ __forceinline__ bool next(int i, Unit8& u) const { const int L = i * G + c; if (L >= 512) return false; const int cc = L & 255, x = cc & 7, j = cc >> 3; u.e = (L >> 8) * 8 + x; u.pn = j & 3; u.pm = j >> 2; return true; }
    __device__ __forceinline__ const char* baseA(const Unit8& u) const { return (const char*)(p->HMID + ((size_t)u.e * MPAD0 + (size_t)u.pm * 256) * 2048); }
    __device__ __forceinline__ const char* baseB(const Unit8& u) const { return (const char*)(p->CW + ((size_t)(layer * 16 + u.e) * 3 + 2) * 2097152 + (size_t)u.pn * 256 * 2048); }
    __device__ __forceinline__ unsigned offA(const Unit8&, int row) const { return (unsigned)row * 4096u; }
    __device__ __forceinline__ unsigned offB(const Unit8&, int rho) const { return (unsigned)rho * 4096u; }
    __device__ __forceinline__ void epi(const f32x4 (&acc)[2][2][4][2], const Unit8& u, int wr, int wc, int fr, int fq) const {
        bf16_t* out = p->YE + (size_t)u.e * MPAD0 * DM;
#pragma unroll
        for (int ai = 0; ai < 2; ++ai)
#pragma unroll
            for (int m = 0; m < 4; ++m) {
                const int slot = u.pm * 256 + ai * 128 + wr * 64 + m * 16 + fr;
                const float g = p->gate[u.e * MPAD0 + slot];
#pragma unroll
                for (int bj = 0; bj < 2; ++bj)
#pragma unroll
                    for (int n = 0; n < 2; ++n) {
                        uint2 o; o.x = pack2(acc[ai][bj][m][n][0] * g, acc[ai][bj][m][n][1] * g); o.y = pack2(acc[ai][bj][m][n][2] * g, acc[ai][bj][m][n][3] * g);
                        *(uint2*)(out + (size_t)slot * DM + u.pn * 256 + bj * 128 + wc * 32 + n * 16 + 4 * fq) = o;
                    }
            }
    }
};
__device__ __forceinline__ void conv_tile(const Ctx cx, const float* src, int ldn, bf16_t* dst, int ldk, int k0, int n0, char* lds, bool valid) {
    bf16_t* T = (bf16_t*)lds;
    const int tid = cx.tid;
    {
        const int k4 = (tid >> 4) * 4, n4 = (tid & 15) * 4;
        const float* q = src + (size_t)(k0 + k4) * ldn + n0 + n4;
        float4 r0 = make_float4(0.f, 0.f, 0.f, 0.f), r1 = r0, r2 = r0, r3 = r0;
        if (valid) { r0 = *(const float4*)q; r1 = *(const float4*)(q + ldn); r2 = *(const float4*)(q + 2 * (size_t)ldn); r3 = *(const float4*)(q + 3 * (size_t)ldn); }
        uint2 w;
        w.x = pack2(r0.x, r1.x); w.y = pack2(r2.x, r3.x); *(uint2*)(T + (n4 + 0) * 72 + k4) = w;
        w.x = pack2(r0.y, r1.y); w.y = pack2(r2.y, r3.y); *(uint2*)(T + (n4 + 1) * 72 + k4) = w;
        w.x = pack2(r0.z, r1.z); w.y = pack2(r2.z, r3.z); *(uint2*)(T + (n4 + 2) * 72 + k4) = w;
        w.x = pack2(r0.w, r1.w); w.y = pack2(r2.w, r3.w); *(uint2*)(T + (n4 + 3) * 72 + k4) = w;
    }
    __syncthreads();
    {
        const int n = tid >> 2, kc = (tid & 3) * 16;
        const uint4 u0 = *(const uint4*)(T + n * 72 + kc), u1 = *(const uint4*)(T + n * 72 + kc + 8);
        bf16_t* d = dst + (size_t)(n0 + n) * ldk + k0 + kc;
        if (valid) { *(uint4*)d = u0; *(uint4*)(d + 8) = u1; }
    }
    __syncthreads();
}
struct Conv4Regs { float4 r[4][4]; };
__device__ __forceinline__ void conv4_load(const Ctx cx, Conv4Regs& R, const float* src, int ldn, int k0, int n0, bool valid) {
    const int tid = cx.tid, k4 = (tid >> 4) * 4, n4 = (tid & 15) * 4;
#pragma unroll
    for (int s4 = 0; s4 < 4; ++s4) {
        const float* q = src + (size_t)(k0 + k4) * ldn + n0 + 64 * s4 + n4;
        if (valid) { R.r[s4][0] = *(const float4*)q; R.r[s4][1] = *(const float4*)(q + ldn); R.r[s4][2] = *(const float4*)(q + 2 * (size_t)ldn); R.r[s4][3] = *(const float4*)(q + 3 * (size_t)ldn); }
        else { R.r[s4][0] = R.r[s4][1] = R.r[s4][2] = R.r[s4][3] = make_float4(0.f, 0.f, 0.f, 0.f); }
    }
}
__device__ __forceinline__ void conv4_finish(const Ctx cx, const Conv4Regs& R, bf16_t* dst, int ldk, int k0, int n0, char* lds, bool valid) {
    const int tid = cx.tid, k4 = (tid >> 4) * 4, n4 = (tid & 15) * 4;
#pragma unroll
    for (int s4 = 0; s4 < 4; ++s4) {
        bf16_t* T = (bf16_t*)lds + s4 * (64 * 72);
        uint2 w;
        w.x = pack2(R.r[s4][0].x, R.r[s4][1].x); w.y = pack2(R.r[s4][2].x, R.r[s4][3].x); *(uint2*)(T + (n4 + 0) * 72 + k4) = w;
        w.x = pack2(R.r[s4][0].y, R.r[s4][1].y); w.y = pack2(R.r[s4][2].y, R.r[s4][3].y); *(uint2*)(T + (n4 + 1) * 72 + k4) = w;
        w.x = pack2(R.r[s4][0].z, R.r[s4][1].z); w.y = pack2(R.r[s4][2].z, R.r[s4][3].z); *(uint2*)(T + (n4 + 2) * 72 + k4) = w;
        w.x = pack2(R.r[s4][0].w, R.r[s4][1].w); w.y = pack2(R.r[s4][2].w, R.r[s4][3].w); *(uint2*)(T + (n4 + 3) * 72 + k4) = w;
    }
    __syncthreads();
    {
        const int n = tid >> 2, kc = (tid & 3) * 16;
#pragma unroll
        for (int s4 = 0; s4 < 4; ++s4) {
            const bf16_t* T = (const bf16_t*)lds + s4 * (64 * 72);
            const uint4 u0 = *(const uint4*)(T + n * 72 + kc), u1 = *(const uint4*)(T + n * 72 + kc + 8);
            bf16_t* d = dst + (size_t)(n0 + 64 * s4 + n) * ldk + k0 + kc;
            if (valid) { *(uint4*)d = u0; *(uint4*)(d + 8) = u1; }
        }
    }
    __syncthreads();
}
__device__ __forceinline__ void conv_tile_w(int lane, const float* src, int ldn, bf16_t* dst, int ldk, int k0, int n0, bf16_t* T) {
    const int n4 = (lane & 15) * 4, kq = lane >> 4;
    float4 r[4][4];
#pragma unroll
    for (int i = 0; i < 4; ++i) {
        const float* q = src + (size_t)(k0 + (kq + 4 * i) * 4) * ldn + n0 + n4;
        r[i][0] = *(const float4*)q; r[i][1] = *(const float4*)(q + ldn); r[i][2] = *(const float4*)(q + 2 * (size_t)ldn); r[i][3] = *(const float4*)(q + 3 * (size_t)ldn);
    }
#pragma unroll
    for (int i = 0; i < 4; ++i) {
        const int k4 = (kq + 4 * i) * 4;
        uint2 w;
        w.x = pack2(r[i][0].x, r[i][1].x); w.y = pack2(r[i][2].x, r[i][3].x); *(uint2*)(T + (n4 + 0) * 72 + k4) = w;
        w.x = pack2(r[i][0].y, r[i][1].y); w.y = pack2(r[i][2].y, r[i][3].y); *(uint2*)(T + (n4 + 1) * 72 + k4) = w;
        w.x = pack2(r[i][0].z, r[i][1].z); w.y = pack2(r[i][2].z, r[i][3].z); *(uint2*)(T + (n4 + 2) * 72 + k4) = w;
        w.x = pack2(r[i][0].w, r[i][1].w); w.y = pack2(r[i][2].w, r[i][3].w); *(uint2*)(T + (n4 + 3) * 72 + k4) = w;
    }
    asm volatile("s_waitcnt lgkmcnt(0)" ::: "memory");
    bf16_t* d = dst + (size_t)(n0 + lane) * ldk + k0;
#pragma unroll
    for (int j = 0; j < 8; ++j) { const uint4 u = *(const uint4*)(T + lane * 72 + 8 * j); *(uint4*)(d + 8 * j) = u; }
    asm volatile("s_waitcnt lgkmcnt(0)" ::: "memory");
}
__device__ __forceinline__ void conv_moe_w(PRef p, int lane, int cw, int ncw, bf16_t* T) {
    for (int t = cw; t < 2 * 16 * 3 * 512; t += ncw) {
        const int le = t / 1536, rem = t % 1536, mat = rem >> 9, tl = rem & 511;
        const float* src = (mat == 0 ? p.moe_w_gate : (mat == 1 ? p.moe_w_up : p.moe_w_down)) + (size_t)le * 2097152;
        bf16_t* dst = p.CW + ((size_t)le * 3 + mat) * 2097152;
        const int K = mat == 2 ? 2048 : 1024, N = mat == 2 ? 1024 : 2048;
        const int nn = N >> 6, nt = tl % nn, kt = tl / nn;
        conv_tile_w(lane, src, N, dst, K, kt * 64, nt * 64, T);
    }
}
__device__ __forceinline__ void conv_small(const Ctx cx, PRef p, char* lds, int t_lo, int t_hi, int cid, int cnb) {
    const int ntl = t_hi - t_lo;
    const int trips = (ntl - (cid & ~1) + cnb - 1) / cnb;
    for (int it = 0; it < trips; ++it) {
        const int t0 = cid + it * cnb; const bool valid = t0 < ntl; const int t = t_lo + (valid ? t0 : 0);
        const float* src; bf16_t* dst; int K, N, tl;
        if (t < 768) { const int w = t >> 8; tl = t & 255; src = w == 0 ? p.rw_wr : (w == 1 ? p.rw_wk : p.rw_wv); dst = w == 0 ? p.wrT : (w == 1 ? p.wkT : p.wvT); K = 1024; N = 1024; }
        else if (t < 800) { tl = t - 768; src = p.rw_g1; dst = p.l1T; K = 1024; N = 128; }
        else if (t < 832) { const int d = (t - 800) >> 4; tl = (t - 800) & 15; src = p.rw_w1 + (size_t)d * 65536; dst = p.l1T + (size_t)(128 + 64 * d) * 1024; K = 1024; N = 64; }
        else if (t < 864) { const int d = (t - 832) >> 4; tl = (t - 832) & 15; src = p.rw_a1 + (size_t)d * 65536; dst = p.l1T + (size_t)(256 + 64 * d) * 1024; K = 1024; N = 64; }
        else if (t < 896) { tl = t - 864; src = p.rw_g2; dst = p.g2T; K = 128; N = 1024; }
        else if (t < 928) { const int d = (t - 896) >> 4; tl = (t - 896) & 15; src = p.rw_w2 + (size_t)d * 65536; dst = p.w2T + (size_t)d * 65536; K = 64; N = 1024; }
        else if (t < 960) { const int d = (t - 928) >> 4; tl = (t - 928) & 15; src = p.rw_a2 + (size_t)d * 65536; dst = p.a2T + (size_t)d * 65536; K = 64; N = 1024; }
        else if (t < 1216) { tl = t - 960; src = p.rw_wo; dst = p.woT; K = 1024; N = 1024; }
        else if (t < 1600) { tl = t - 1216; src = p.at_wqkv; dst = p.wqkvT; K = 1024; N = 1536; }
        else { tl = t - 1600; src = p.at_wo; dst = p.atwoT; K = 1024; N = 1024; }
        const int nn = N >> 6, nt = tl % nn, kt = tl / nn;
        conv_tile(cx, src, N, dst, K, kt * 64, nt * 64, lds, valid);
    }
}
__device__ __forceinline__ void conv_moe(const Ctx cx, PRef p, char* lds, int cid, int cnb) {
    const int NTL = 2 * 16 * 3 * 128;
    const int trips = (NTL - (cid & ~1) + cnb - 1) / cnb;
#define CONV_DESC(t0_, valid_, src_, dst_, K_, N_, k0_, n0_) \
        const bool valid_ = (t0_) < NTL; const int tq_##valid_ = valid_ ? (t0_) : 0; \
        const int le_##valid_ = tq_##valid_ / 384, rem_##valid_ = tq_##valid_ % 384, mat_##valid_ = rem_##valid_ >> 7, tl_##valid_ = rem_##valid_ & 127; \
        const float* src_ = (mat_##valid_ == 0 ? p.moe_w_gate : (mat_##valid_ == 1 ? p.moe_w_up : p.moe_w_down)) + (size_t)le_##valid_ * 2097152; \
        bf16_t* dst_ = p.CW + ((size_t)le_##valid_ * 3 + mat_##valid_) * 2097152; \
        const int K_ = mat_##valid_ == 2 ? 2048 : 1024, N_ = mat_##valid_ == 2 ? 1024 : 2048; \
        const int k0_ = (tl_##valid_ / (N_ >> 8)) * 64, n0_ = (tl_##valid_ % (N_ >> 8)) * 256
    Conv4Regs Ra, Rb;
    { CONV_DESC(cid, v0, s0, d0, K0, N0, k00, n00); (void)d0; (void)K0; conv4_load(cx, Ra, s0, N0, k00, n00, v0); }
    for (int it = 0; it < trips; it += 2) {
        { CONV_DESC(cid + (it + 1) * cnb, v1, s1, d1, K1, N1, k01, n01); (void)d1; (void)K1; conv4_load(cx, Rb, s1, N1, k01, n01, v1 && (it + 1 < trips)); }
        { CONV_DESC(cid + it * cnb, v2, s2, d2, K2, N2, k02, n02); (void)s2; (void)N2; conv4_finish(cx, Ra, d2, K2, k02, n02, lds, v2); }
        if (it + 1 < trips) {
            { CONV_DESC(cid + (it + 2) * cnb, v3, s3, d3, K3, N3, k03, n03); (void)d3; (void)K3; conv4_load(cx, Ra, s3, N3, k03, n03, v3 && (it + 2 < trips)); }
            { CONV_DESC(cid + (it + 1) * cnb, v4, s4, d4, K4, N4, k04, n04); (void)s4; (void)N4; conv4_finish(cx, Rb, d4, K4, k04, n04, lds, v4); }
        }
    }
#undef CONV_DESC
}
__device__ __forceinline__ void ph_ada(const Ctx cx, PRef p, char* ldsc) {
    float* sv = (float*)ldsc;
    for (int i = cx.tid; i < 3072; i += NTHR) {
        const int s = i >> 10, k = i & 1023;
        const float v = (s < 2) ? p.c[s * 1024 + k] : p.c_ctx[k];
        sv[i] = v / (1.f + __expf(-v));
    }
    __syncthreads();
    const int lane = cx.tid & 63, gw = (cx.bid * NTHR + cx.tid) >> 6, nw = (cx.nb * NTHR) >> 6;
    for (int item = gw; item < 3072; item += nw) {
        const int ks = item & 15, ch = (item >> 4) % 96, l = item / (16 * 96), n0 = ch * 64, kb = ks * 64;
        const float* w = p.ada_w + (size_t)l * 1024 * 6144 + n0 + lane;
        float a0 = 0.f, a1 = 0.f, a2 = 0.f;
#pragma unroll 32
        for (int k = 0; k < 64; ++k) {
            const float wv = w[(size_t)(kb + k) * 6144];
            a0 += wv * sv[kb + k]; a1 += wv * sv[1024 + kb + k]; a2 += wv * sv[2048 + kb + k];
        }
        float* mo = p.modp + ((size_t)ks * 6 + l * 3) * 6144 + n0 + lane;
        mo[0] = a0; mo[6144] = a1; mo[2 * 6144] = a2;
    }
    for (int i = cx.bid * NTHR + cx.tid; i < 128 * 16; i += cx.nb * NTHR) {
        const int pos = i >> 4, fi = i & 15;
        const float th = __builtin_amdgcn_exp2f(-(float)fi * (13.287712379549449f / 16.0f));
        const float t2 = th * th;
        float cs = 1.f - t2 * (0.5f - t2 * (1.f / 24.f - t2 * (1.f / 720.f - t2 * (1.f / 40320.f - t2 * (1.f / 3628800.f)))));
        float sn = th * (1.f - t2 * (1.f / 6.f - t2 * (1.f / 120.f - t2 * (1.f / 5040.f - t2 * (1.f / 362880.f - t2 * (1.f / 39916800.f))))));
        float rc = 1.f, rs = 0.f;
#pragma unroll
        for (int bb = 0; bb < 7; ++bb) {
            if ((pos >> bb) & 1) { const float nc = rc * cs - rs * sn, ns = rc * sn + rs * cs; rc = nc; rs = ns; }
            const float c2 = cs * cs - sn * sn, s2 = 2.f * cs * sn; cs = c2; sn = s2;
        }
        p.rope[2 * i] = rc; p.rope[2 * i + 1] = rs;
    }
    __syncthreads();
    conv_small(cx, p, ldsc, 0, 960, cx.bid, cx.nb);
}
__device__ __forceinline__ void ph_pre0(const Ctx cx, PRef p) {
    const int col = cx.tid * 4;
    for (int i = cx.bid * NTHR + cx.tid; i < 2 * 3 * 6144; i += cx.nb * NTHR) {
        float v = p.ada_b[(i / (3 * 6144)) * 6144 + i % 6144];
#pragma unroll
        for (int ks = 0; ks < 16; ++ks) v += p.modp[(size_t)ks * 36864 + i];
        p.modv[i] = v;
    }
    float4 sh0, sh1, sh2, sc0, sc1, sc2;
#define PRE0_RED(S3, SH, SC) do { float4 a = *(const float4*)(p.ada_b + col), b = *(const float4*)(p.ada_b + 1024 + col); \
        _Pragma("unroll") for (int ks = 0; ks < 16; ++ks) { \
            const float4 pa = *(const float4*)(p.modp + (size_t)ks * 36864 + (S3) * 6144 + col), pb = *(const float4*)(p.modp + (size_t)ks * 36864 + (S3) * 6144 + 1024 + col); \
            a.x += pa.x; a.y += pa.y; a.z += pa.z; a.w += pa.w; b.x += pb.x; b.y += pb.y; b.z += pb.z; b.w += pb.w; } \
        SH = a; SC = b; } while (0)
    PRE0_RED(0, sh0, sc0); PRE0_RED(1, sh1, sc1); PRE0_RED(2, sh2, sc2);
#undef PRE0_RED
    for (int r0 = cx.bid * 4; r0 < ROWS; r0 += cx.nb * 4) {
        const int s = mod_of_row(r0);
        const int t0 = r0 < ROWS_LAT ? (r0 & (TLAT - 1)) : ((r0 - ROWS_LAT) & (LCTX - 1));
        const int len = r0 < ROWS_LAT ? TLAT : LCTX;
        const float4 sh = s == 0 ? sh0 : (s == 1 ? sh1 : sh2), sc = s == 0 ? sc0 : (s == 1 ? sc1 : sc2);
        const float* xr = xin_row(p, r0);
        float4 xv[6];
#pragma unroll
        for (int j = 0; j < 6; ++j) {
            const int t = t0 - 1 + j;
            xv[j] = make_float4(0.f, 0.f, 0.f, 0.f);
            if (t >= 0 && t < len) xv[j] = *(const float4*)(xr + (ptrdiff_t)(j - 1) * DM + col);
        }
        float4 mu[6];
#pragma unroll
        for (int m = 0; m < 6; ++m) mu[m] = *(const float4*)(p.rw_mu + m * 1024 + col);
        float hv[6][4];
#pragma unroll
        for (int j = 0; j < 6; ++j) {
            const int t = t0 - 1 + j; const bool in = (t >= 0 && t < len);
            hv[j][0] = in ? xv[j].x * (1.f + sc.x) + sh.x : 0.f; hv[j][1] = in ? xv[j].y * (1.f + sc.y) + sh.y : 0.f;
            hv[j][2] = in ? xv[j].z * (1.f + sc.z) + sh.z : 0.f; hv[j][3] = in ? xv[j].w * (1.f + sc.w) + sh.w : 0.f;
        }
#pragma unroll
        for (int rr = 0; rr < 4; ++rr) {
            float h[4], xx[4];
#pragma unroll
            for (int i = 0; i < 4; ++i) { h[i] = hv[rr + 1][i]; xx[i] = 0.5f * (hv[rr][i] + hv[rr + 2][i]) - h[i]; }
#pragma unroll
            for (int m = 0; m < 6; ++m) {
                uint2 o; o.x = pack2(h[0] + xx[0] * mu[m].x, h[1] + xx[1] * mu[m].y); o.y = pack2(h[2] + xx[2] * mu[m].z, h[3] + xx[3] * mu[m].w);
                *(uint2*)(p.XM + ((size_t)m * ROWS + r0 + rr) * DM + col) = o;
            }
        }
    }
}

struct EpiF32 {
    float* out; int ld, m0, n0;
    __device__ __forceinline__ void operator()(const f32x4 (&acc)[4][4], int wr, int wc, int fr, int fq) const {
#pragma unroll
        for (int i = 0; i < 4; ++i)
#pragma unroll
            for (int j = 0; j < 4; ++j) {
                const int row = m0 + wr * 64 + i * 16 + fr, col = n0 + wc * 64 + j * 16 + 4 * fq;
                *(f32x4*)(out + (size_t)row * ld + col) = acc[i][j];
            }
    }
};
struct EpiBf {
    bf16_t* out; int ld, m0, n0;
    __device__ __forceinline__ void operator()(const f32x4 (&acc)[4][4], int wr, int wc, int fr, int fq) const {
#pragma unroll
        for (int i = 0; i < 4; ++i)
#pragma unroll
            for (int j = 0; j < 4; ++j) {
                const int row = m0 + wr * 64 + i * 16 + fr, col = n0 + wc * 64 + j * 16 + 4 * fq;
                uint2 o; o.x = pack2(acc[i][j][0], acc[i][j][1]); o.y = pack2(acc[i][j][2], acc[i][j][3]);
                *(uint2*)(out + (size_t)row * ld + col) = o;
            }
    }
};
struct EpiK {
    bf16_t* out; bf16_t* kk; const float* k_k; int m0, n0;
    __device__ __forceinline__ void operator()(const f32x4 (&acc)[4][4], int wr, int wc, int fr, int fq) const {
        const int lane = fr + 16 * fq;
#pragma unroll
        for (int i = 0; i < 4; ++i) {
            const int row = m0 + wr * 64 + i * 16 + fr;
            f32x4 kv[4]; float ss = 0.f;
#pragma unroll
            for (int j = 0; j < 4; ++j) {
                const int col = n0 + wc * 64 + j * 16 + 4 * fq;
                const f32x4 kw = *(const f32x4*)(k_k + col);
                uint2 o; o.x = pack2(acc[i][j][0], acc[i][j][1]); o.y = pack2(acc[i][j][2], acc[i][j][3]);
                *(uint2*)(out + (size_t)row * DM + col) = o;
                kv[j][0] = bflo(o.x) * kw[0]; kv[j][1] = bfhi(o.x) * kw[1]; kv[j][2] = bflo(o.y) * kw[2]; kv[j][3] = bfhi(o.y) * kw[3];
                ss += (kv[j][0] * kv[j][0] + kv[j][1] * kv[j][1]) + (kv[j][2] * kv[j][2] + kv[j][3] * kv[j][3]);
            }
            ss += shx(ss, 16, lane); ss += shx(ss, 32, lane);
            const float inv = fminf(__builtin_amdgcn_rsqf(ss), 1e12f);
#pragma unroll
            for (int j = 0; j < 4; ++j) {
                const int col = n0 + wc * 64 + j * 16 + 4 * fq;
                const f32x4 kq_ = kv[j] * inv; uint2 o2; o2.x = pack2(kq_[0], kq_[1]); o2.y = pack2(kq_[2], kq_[3]); *(uint2*)(kk + (size_t)row * DM + col) = o2;
            }
        }
    }
};
struct EpiLH {
    bf16_t* out; int m0, coff, act;
    __device__ __forceinline__ void operator()(const f32x4 (&acc)[4][4], int wr, int wc, int fr, int fq) const {
#pragma unroll
        for (int i = 0; i < 4; ++i)
#pragma unroll
            for (int j = 0; j < 4; ++j) {
                const int row = m0 + wr * 64 + i * 16 + fr, col = wc * 64 + j * 16 + 4 * fq;
                float v[4];
#pragma unroll
                for (int r = 0; r < 4; ++r) { const float a = acc[i][j][r]; v[r] = act == 0 ? sigmoidf_(a) : (act == 1 ? (1.f - 2.f / (1.f + __expf(2.f * a))) : a); }
                uint2 o; o.x = pack2(v[0], v[1]); o.y = pack2(v[2], v[3]);
                *(uint2*)(out + (size_t)row * 384 + coff + col) = o;
            }
    }
};
struct EpiG2 {
    bf16_t* outb; float* outf; const float* bias; int m0, n0, kind;
    __device__ __forceinline__ void operator()(const f32x4 (&acc)[4][4], int wr, int wc, int fr, int fq) const {
#pragma unroll
        for (int i = 0; i < 4; ++i)
#pragma unroll
            for (int j = 0; j < 4; ++j) {
                const int row = m0 + wr * 64 + i * 16 + fr, col = n0 + wc * 64 + j * 16 + 4 * fq;
                if (kind == 0) {
                    uint2 o; o.x = pack2(acc[i][j][0], acc[i][j][1]); o.y = pack2(acc[i][j][2], acc[i][j][3]);
                    *(uint2*)(outb + (size_t)row * DM + col) = o;
                } else if (kind == 2) {
                    const float4 b = *(const float4*)(bias + col);
                    uint2 o; o.x = pack2(sigmoidf_(b.x + acc[i][j][0]), sigmoidf_(b.y + acc[i][j][1])); o.y = pack2(sigmoidf_(b.z + acc[i][j][2]), sigmoidf_(b.w + acc[i][j][3]));
                    *(uint2*)(outb + (size_t)row * DM + col) = o;
                } else {
                    const float4 b = *(const float4*)(bias + col);
                    uint2 o; o.x = pack2(b.x + acc[i][j][0], b.y + acc[i][j][1]); o.y = pack2(b.z + acc[i][j][2], b.w + acc[i][j][3]);
                    *(uint2*)(outb + (size_t)row * DM + col) = o;
                }
            }
    }
};
struct EpiResid {
    float* out; const float* xl; const float* xc; const float* modl; int m0, n0;
    __device__ __forceinline__ void operator()(const f32x4 (&acc)[4][4], int wr, int wc, int fr, int fq) const {
#pragma unroll
        for (int i = 0; i < 4; ++i) {
            const int row = m0 + wr * 64 + i * 16 + fr;
            const float* xr = row < ROWS_LAT ? xl + (size_t)row * DM : xc + (size_t)(row - ROWS_LAT) * DM;
            const float* gt = modl + (size_t)mod_of_row(row) * 6144 + 2 * 1024;
#pragma unroll
            for (int j = 0; j < 4; ++j) {
                const int col = n0 + wc * 64 + j * 16 + 4 * fq;
                const f32x4 xv = *(const f32x4*)(xr + col), gv = *(const f32x4*)(gt + col);
                f32x4 o;
#pragma unroll
                for (int r = 0; r < 4; ++r) o[r] = ALPHA_F * xv[r] + gv[r] * acc[i][j][r];
                *(f32x4*)(out + (size_t)row * DM + col) = o;
            }
        }
    }
};
struct EpiSwiGLU {
    bf16_t* out; int m0, j0;
    __device__ __forceinline__ void operator()(const f32x4 (&acc)[4][4], int wr, int wc, int fr, int fq) const {
#pragma unroll
        for (int i = 0; i < 4; ++i) {
            const int row = m0 + wr * 64 + i * 16 + fr;
#pragma unroll
            for (int j = 0; j < 2; ++j) {
                const int col = j0 + wc * 32 + j * 16 + 4 * fq;
                float v[4];
#pragma unroll
                for (int r = 0; r < 4; ++r) { const float a = acc[i][j][r], u = acc[i][j + 2][r]; v[r] = a * sigmoidf_(a) * u; }
                uint2 o; o.x = pack2(v[0], v[1]); o.y = pack2(v[2], v[3]);
                *(uint2*)(out + (size_t)row * 2048 + col) = o;
            }
        }
    }
};
struct EpiDown {
    bf16_t* out; const float* gate; int m0, n0;
    __device__ __forceinline__ void operator()(const f32x4 (&acc)[4][4], int wr, int wc, int fr, int fq) const {
#pragma unroll
        for (int i = 0; i < 4; ++i) {
            const int row = m0 + wr * 64 + i * 16 + fr;
            const float g = gate[row];
#pragma unroll
            for (int j = 0; j < 4; ++j) {
                const int col = n0 + wc * 64 + j * 16 + 4 * fq;
                uint2 o; o.x = pack2(acc[i][j][0] * g, acc[i][j][1] * g); o.y = pack2(acc[i][j][2] * g, acc[i][j][3] * g);
                *(uint2*)(out + (size_t)row * DM + col) = o;
            }
        }
    }
};
struct EpiQKV {
    PPtr p; int m0, n0;
    __device__ __forceinline__ void operator()(const f32x4 (&acc)[4][4], int wr, int wc, int fr, int fq) const {
        const int hs = (n0 + wc * 64) >> 6;
#pragma unroll
        for (int i = 0; i < 4; ++i) {
            const int row = m0 + wr * 64 + i * 16 + fr;
            const bool lat = row < ROWS_LAT;
            if (hs < 20) {
                f32x4 v0 = acc[i][0], v1 = acc[i][1], v2 = acc[i][2], v3 = acc[i][3];
                if (lat) {
                    const int t = row & (TLAT - 1), rp = t >> 6, cp = t & 63;
#pragma unroll
                    for (int r = 0; r < 4; ++r) {
                        const int fi = 4 * fq + r;
                        const float2 cr = *(const float2*)(p->rope + 2 * (rp * 16 + fi)), cc = *(const float2*)(p->rope + 2 * (cp * 16 + fi));
                        const float a = v0[r], b = v1[r]; v0[r] = a * cr.x - b * cr.y; v1[r] = b * cr.x + a * cr.y;
                        const float c2 = v2[r], d2 = v3[r]; v2[r] = c2 * cc.x - d2 * cc.y; v3[r] = d2 * cc.x + c2 * cc.y;
                    }
                }
                if (hs < 16) {
                    if (lat) {
                        bf16_t* q = p->Q + (size_t)row * DM + hs * 64 + 4 * fq;
                        uint2 o;
                        o.x = pack2(v0[0] * 0.125f, v0[1] * 0.125f); o.y = pack2(v0[2] * 0.125f, v0[3] * 0.125f); *(uint2*)(q) = o;
                        o.x = pack2(v1[0] * 0.125f, v1[1] * 0.125f); o.y = pack2(v1[2] * 0.125f, v1[3] * 0.125f); *(uint2*)(q + 16) = o;
                        o.x = pack2(v2[0] * 0.125f, v2[1] * 0.125f); o.y = pack2(v2[2] * 0.125f, v2[3] * 0.125f); *(uint2*)(q + 32) = o;
                        o.x = pack2(v3[0] * 0.125f, v3[1] * 0.125f); o.y = pack2(v3[2] * 0.125f, v3[3] * 0.125f); *(uint2*)(q + 48) = o;
                    }
                } else {
                    bf16_t* k = p->KA + (size_t)row * 256 + (hs - 16) * 64 + 4 * fq;
                    uint2 o;
                    o.x = pack2(v0[0], v0[1]); o.y = pack2(v0[2], v0[3]); *(uint2*)(k) = o;
                    o.x = pack2(v1[0], v1[1]); o.y = pack2(v1[2], v1[3]); *(uint2*)(k + 16) = o;
                    o.x = pack2(v2[0], v2[1]); o.y = pack2(v2[2], v2[3]); *(uint2*)(k + 32) = o;
                    o.x = pack2(v3[0], v3[1]); o.y = pack2(v3[2], v3[3]); *(uint2*)(k + 48) = o;
                }
            } else {
                const int hk = hs - 20;
                bf16_t* vt; int ldt, t;
                if (lat) { const int b = row >> 13; t = row & (TLAT - 1); vt = p->VTL + (size_t)(b * 4 + hk) * 64 * TLAT; ldt = TLAT; }
                else { const int rr = row - ROWS_LAT, b = rr >> 8; t = rr & (LCTX - 1); vt = p->VTC + (size_t)(b * 4 + hk) * 64 * LCTX; ldt = LCTX; }
#pragma unroll
                for (int j = 0; j < 4; ++j)
#pragma unroll
                    for (int r = 0; r < 4; ++r) vt[(size_t)(j * 16 + 4 * fq + r) * ldt + t] = f2bf(acc[i][j][r]);
            }
        }
    }
};

__device__ __forceinline__ void ph_g1(const Ctx cx, PRef p, char* lds) {
    for (int tile = cx.bid; tile < 96 + 396; tile += cx.nb) {
        int mt, nt;
        if (tile < 96) { mt = 128 + tile / 24; nt = tile % 24; } else { const int t2 = tile - 96; mt = t2 / 3; nt = 24 + t2 % 3; }
        const int m0 = mt * 128;
        int msel, n0; const bf16_t* Bt;
        if (nt < 24) { const int gsel = nt >> 3; n0 = (nt & 7) * 128; msel = gsel == 0 ? 0 : (gsel == 1 ? 2 : 3); Bt = (gsel == 0 ? p.wrT : (gsel == 1 ? p.wkT : p.wvT)) + (size_t)n0 * 1024; }
        else { const int q = nt - 24; n0 = 0; msel = q == 0 ? 5 : (q == 1 ? 1 : 4); Bt = p.l1T + (size_t)q * 128 * 1024; }
        const bf16_t* A = p.XM + ((size_t)msel * ROWS + m0) * DM + G3_CH8;
        const bf16_t* B = Bt + G3_CH8;
        if (nt < 24) {
            const int gsel = nt >> 3;
            if (gsel == 1) {
                EpiK epi; epi.out = p.K; epi.kk = p.KK; epi.k_k = p.rw_kk; epi.m0 = m0; epi.n0 = n0;
                gemm3_tile(cx, A + (size_t)G3_ROW(0) * DM, A + (size_t)G3_ROW(1) * DM,
                           B + (size_t)G3_ROW(0) * 1024, B + (size_t)G3_ROW(1) * 1024, 1024, epi, lds);
            } else {
                EpiBf epi; epi.out = gsel == 0 ? p.R : p.V; epi.ld = DM; epi.m0 = m0; epi.n0 = n0;
                gemm3_tile(cx, A + (size_t)G3_ROW(0) * DM, A + (size_t)G3_ROW(1) * DM,
                           B + (size_t)G3_ROW(0) * 1024, B + (size_t)G3_ROW(1) * 1024, 1024, epi, lds);
            }
        } else {
            const int q = nt - 24;
            EpiLH epi; epi.out = p.LH; epi.m0 = m0; epi.coff = q * 128; epi.act = q;
            gemm3_tile(cx, A + (size_t)G3_ROW(0) * DM, A + (size_t)G3_ROW(1) * DM,
                       B + (size_t)G3_ROW(0) * 1024, B + (size_t)G3_ROW(1) * 1024, 1024, epi, lds);
        }
    }
}
__device__ __forceinline__ void ph_g2(const Ctx cx, PRef p, char* lds) {
#define G2_DESC(tile_, A_, B_, K_, epi_) \
        const int mt_##A_ = (tile_) / 40, rem_##A_ = (tile_) % 40, gsel_##A_ = rem_##A_ >> 3, n0_##A_ = (rem_##A_ & 7) * 128, m0_##A_ = mt_##A_ * 128; \
        const bf16_t* A_; const bf16_t* B_; int K_; EpiG2 epi_; epi_.m0 = m0_##A_; epi_.n0 = n0_##A_; epi_.outb = nullptr; epi_.outf = nullptr; epi_.bias = nullptr; \
        if (gsel_##A_ == 0) { A_ = p.LH; B_ = p.g2T + (size_t)n0_##A_ * 128; K_ = 128; epi_.kind = 0; epi_.outb = p.G; } \
        else if (gsel_##A_ <= 2) { const int d = gsel_##A_ - 1; A_ = p.LH + 128 + 64 * d; B_ = p.w2T + (size_t)d * 65536 + (size_t)n0_##A_ * 64; K_ = 64; epi_.kind = 1; epi_.outb = d ? p.W1 : p.W0; epi_.bias = p.rw_w0 + d * 1024; } \
        else { const int d = gsel_##A_ - 3; A_ = p.LH + 256 + 64 * d; B_ = p.a2T + (size_t)d * 65536 + (size_t)n0_##A_ * 64; K_ = 64; epi_.kind = 2; epi_.outb = d ? p.AD1 : p.AD0; epi_.bias = p.rw_a0 + d * 1024; } \
        A_ += (size_t)m0_##A_ * 384 + G3_CH8; B_ += G3_CH8
    bool pre = false;
    for (int tile = cx.bid; tile < 132 * 40; tile += cx.nb) {
        G2_DESC(tile, A, B, K, epi);
        const int tn = tile + cx.nb; const bool hn = tn < 132 * 40;
        G2_DESC(hn ? tn : tile, An, Bn, Kn, epin); (void)epin;
        G3Next nx; nx.has = hn; nx.a0 = An + (size_t)G3_ROW(0) * 384; nx.a1 = An + (size_t)G3_ROW(1) * 384; nx.b0 = Bn + (size_t)G3_ROW(0) * Kn; nx.b1 = Bn + (size_t)G3_ROW(1) * Kn; nx.K = Kn;
        gemm3_tile(cx, A + (size_t)G3_ROW(0) * 384, A + (size_t)G3_ROW(1) * 384,
                   B + (size_t)G3_ROW(0) * K, B + (size_t)G3_ROW(1) * K, K, epi, lds, pre, nx);
        pre = hn;
    }
#undef G2_DESC
}
__device__ __forceinline__ void ph_prep(const Ctx cx, PRef p) { (void)cx; (void)p; }
#define NCHUNK 132
#define CH_ROW 72
#define L_AT 0
#define L_BT 9216
#define L_KT 18432
#define L_RT 27648
#define L_BH 36864
#define L_KH 46080
#define L_VT 55296
#define L_AAB 64512
#define L_PC 80896
#define L_X2 L_AT
#define L_UT L_KT
#define L_WT L_KH
#define S1_LDS_BYTES (80896 + 256)
__device__ __forceinline__ void chunk_rows(int b, int dir, int n, int& rbase, int& sgn) {
    sgn = dir ? -1 : 1;
    if (n < 4) { const int t0 = 64 * n; rbase = ROWS_LAT + b * LCTX + (dir ? (LCTX - 1 - t0) : t0); }
    else { const int t0 = 64 * (n - 4); rbase = b * TLAT + (dir ? (TLAT - 1 - t0) : t0); }
}
__device__ __forceinline__ bf16x8 pack8(const f32x4& a, const f32x4& b) {
    uint4 u; u.x = pack2(a[0], a[1]); u.y = pack2(a[2], a[3]); u.z = pack2(b[0], b[1]); u.w = pack2(b[2], b[3]);
    return *(bf16x8*)&u;
}
__device__ __forceinline__ void mm64(f32x4 (&acc)[4][4], const bf16_t* X, const bf16_t* Y, int l15, int g) {
    bf16x8 yf[4][2];
#pragma unroll
    for (int yt = 0; yt < 4; ++yt) { yf[yt][0] = *(const bf16x8*)(Y + (16 * yt + l15) * CH_ROW + 8 * g); yf[yt][1] = *(const bf16x8*)(Y + (16 * yt + l15) * CH_ROW + 32 + 8 * g); }
#pragma unroll
    for (int xt = 0; xt < 4; ++xt) {
        const bf16x8 x0 = *(const bf16x8*)(X + (16 * xt + l15) * CH_ROW + 8 * g), x1 = *(const bf16x8*)(X + (16 * xt + l15) * CH_ROW + 32 + 8 * g);
#pragma unroll
        for (int yt = 0; yt < 4; ++yt) {
            acc[xt][yt] = __builtin_amdgcn_mfma_f32_16x16x32_bf16(x0, yf[yt][0], acc[xt][yt], 0, 0, 0);
            acc[xt][yt] = __builtin_amdgcn_mfma_f32_16x16x32_bf16(x1, yf[yt][1], acc[xt][yt], 0, 0, 0);
        }
    }
}
__device__ __forceinline__ void mm64_accB(f32x4 (&out)[4][4], const bf16_t* X, const f32x4 (&acc)[4][4], int l15, int g) {
#pragma unroll
    for (int js = 0; js < 2; ++js) {
        bf16x8 bfr[4];
#pragma unroll
        for (int tt = 0; tt < 4; ++tt) bfr[tt] = pack8(acc[2 * js][tt], acc[2 * js + 1][tt]);
#pragma unroll
        for (int xt = 0; xt < 4; ++xt) {
            const bf16_t* xp = X + (16 * xt + l15) * CH_ROW + 32 * js + 4 * g;
            const uint2 lo = *(const uint2*)xp, hi = *(const uint2*)(xp + 16);
            uint4 u; u.x = lo.x; u.y = lo.y; u.z = hi.x; u.w = hi.y;
            const bf16x8 af = *(bf16x8*)&u;
#pragma unroll
            for (int tt = 0; tt < 4; ++tt) out[xt][tt] = __builtin_amdgcn_mfma_f32_16x16x32_bf16(af, bfr[tt], out[xt][tt], 0, 0, 0);
        }
    }
}
__device__ __forceinline__ void zero44(f32x4 (&a)[4][4]) {
#pragma unroll
    for (int i = 0; i < 4; ++i)
#pragma unroll
        for (int j = 0; j < 4; ++j) a[i][j] = (f32x4){0.f, 0.f, 0.f, 0.f};
}
__device__ __forceinline__ void mask44(f32x4 (&a)[4][4], int l15, int g, bool strict) {
#pragma unroll
    for (int jt = 0; jt < 4; ++jt)
#pragma unroll
        for (int tt = 0; tt < 4; ++tt)
#pragma unroll
            for (int r = 0; r < 4; ++r) {
                const int j = 16 * jt + 4 * g + r, t = 16 * tt + l15;
                const bool keep = strict ? (j < t) : (j <= t);
                a[jt][tt][r] = keep ? a[jt][tt][r] : 0.f;
            }
}
__host__ __device__ constexpr int fsub_qp(int J) { return J < 24 ? 10 : 16; }
template <int J> __device__ __forceinline__ void fsub_col(float (&z)[64], const float* AabT, const float4 (&cur)[16]) {
    float4 nxt[16];
    if constexpr (J < 62) {
#pragma unroll
        for (int q = (J + 2) / 4; q < fsub_qp(J); ++q) nxt[q] = *(const float4*)(AabT + (J + 1) * 64 + 4 * q);
    }
    const float zj = z[J];
    constexpr int QV = J == 0 ? 16 : fsub_qp(J - 1);
#pragma unroll
    for (int q = (J + 1) / 4; q < 16; ++q) {
        const float4 c4 = q < QV ? cur[q] : *(const float4*)(AabT + J * 64 + 4 * q);
        if (4 * q + 0 > J) z[4 * q + 0] += c4.x * zj;
        if (4 * q + 1 > J) z[4 * q + 1] += c4.y * zj;
        if (4 * q + 2 > J) z[4 * q + 2] += c4.z * zj;
        if (4 * q + 3 > J) z[4 * q + 3] += c4.w * zj;
    }
#define ZPIN16(a) asm volatile("" : "+v"(z[a]), "+v"(z[a+1]), "+v"(z[a+2]), "+v"(z[a+3]), "+v"(z[a+4]), "+v"(z[a+5]), "+v"(z[a+6]), "+v"(z[a+7]), \
                                    "+v"(z[a+8]), "+v"(z[a+9]), "+v"(z[a+10]), "+v"(z[a+11]), "+v"(z[a+12]), "+v"(z[a+13]), "+v"(z[a+14]), "+v"(z[a+15]) :: "memory")
    if constexpr (J < 15) ZPIN16(0);
    if constexpr (J < 31) ZPIN16(16);
    if constexpr (J < 47) ZPIN16(32);
    ZPIN16(48);
#undef ZPIN16
    if constexpr (J < 62) fsub_col<J + 1>(z, AabT, nxt);
}
__device__ __forceinline__ void s1_diag_inverse(const bf16_t* Abf, bf16_t* TD, int lane) {
    const int bi = lane >> 4, c = lane & 15;
    float z[16];
#pragma unroll
    for (int t = 0; t < 16; ++t) {
        const uint4 u0 = *(const uint4*)(Abf + (16 * bi + t) * CH_ROW + 16 * bi), u1 = *(const uint4*)(Abf + (16 * bi + t) * CH_ROW + 16 * bi + 8);
        const unsigned uw[8] = {u0.x, u0.y, u0.z, u0.w, u1.x, u1.y, u1.z, u1.w};
        float acc_ = (t == c) ? 1.f : 0.f;
#pragma unroll
        for (int j = 0; j < t; ++j) acc_ += ((j & 1) ? bfhi(uw[j >> 1]) : bflo(uw[j >> 1])) * z[j];
        z[t] = acc_;
        TD[(16 * bi + t) * 24 + c] = f2bf(acc_);
    }
}
__device__ __forceinline__ void s1_load_slab(f32x4 (&Rs)[4][2], const bf16_t* X, int cb, int l15, int g) {
#pragma unroll
    for (int i = 0; i < 4; ++i)
#pragma unroll
        for (int ct = 0; ct < 2; ++ct)
#pragma unroll
            for (int r = 0; r < 4; ++r) Rs[i][ct][r] = bflo((unsigned)X[(16 * i + 4 * g + r) * CH_ROW + cb + 16 * ct + l15]);
}
__device__ __forceinline__ void s1_x2_slab(f32x4 (&Rs)[4][2], const bf16_t* Kbf, const bf16_t* VT, int vb, int l15, int g) {
#pragma unroll
    for (int i = 0; i < 4; ++i) { Rs[i][0] = (f32x4){0.f, 0.f, 0.f, 0.f}; Rs[i][1] = (f32x4){0.f, 0.f, 0.f, 0.f}; }
#pragma unroll
    for (int ks = 0; ks < 2; ++ks) {
        const bf16x8 v0 = *(const bf16x8*)(VT + (vb + l15) * CH_ROW + 32 * ks + 8 * g), v1 = *(const bf16x8*)(VT + (vb + 16 + l15) * CH_ROW + 32 * ks + 8 * g);
#pragma unroll
        for (int i = 0; i < 4; ++i) {
            const bf16x8 kf = *(const bf16x8*)(Kbf + (16 * i + l15) * CH_ROW + 32 * ks + 8 * g);
            Rs[i][0] = __builtin_amdgcn_mfma_f32_16x16x32_bf16(kf, v0, Rs[i][0], 0, 0, 0);
            Rs[i][1] = __builtin_amdgcn_mfma_f32_16x16x32_bf16(kf, v1, Rs[i][1], 0, 0, 0);
        }
    }
}
__device__ __forceinline__ void s1_slab_solve(f32x4 (&Rs)[4][2], const bf16_t* Abf, const bf16_t* TD, bf16_t* XT, int l15, int g) {
#pragma unroll
    for (int i = 0; i < 4; ++i) {
        f32x4 X0 = Rs[i][0], X1 = Rs[i][1];
#pragma unroll
        for (int j = 0; j < i; ++j) {
            const uint2 av = *(const uint2*)(Abf + (16 * i + l15) * CH_ROW + 16 * j + 4 * g);
            uint4 ua; ua.x = av.x; ua.y = av.y; ua.z = 0u; ua.w = 0u;
            uint4 ub0, ub1; ub0.x = pack2(Rs[j][0][0], Rs[j][0][1]); ub0.y = pack2(Rs[j][0][2], Rs[j][0][3]); ub0.z = 0u; ub0.w = 0u;
            ub1.x = pack2(Rs[j][1][0], Rs[j][1][1]); ub1.y = pack2(Rs[j][1][2], Rs[j][1][3]); ub1.z = 0u; ub1.w = 0u;
            X0 = __builtin_amdgcn_mfma_f32_16x16x32_bf16(*(bf16x8*)&ua, *(bf16x8*)&ub0, X0, 0, 0, 0);
            X1 = __builtin_amdgcn_mfma_f32_16x16x32_bf16(*(bf16x8*)&ua, *(bf16x8*)&ub1, X1, 0, 0, 0);
        }
        const uint2 tv = *(const uint2*)(TD + (16 * i + l15) * 24 + 4 * g);
        uint4 ut; ut.x = tv.x; ut.y = tv.y; ut.z = 0u; ut.w = 0u;
        uint4 ux0, ux1; ux0.x = pack2(X0[0], X0[1]); ux0.y = pack2(X0[2], X0[3]); ux0.z = 0u; ux0.w = 0u;
        ux1.x = pack2(X1[0], X1[1]); ux1.y = pack2(X1[2], X1[3]); ux1.z = 0u; ux1.w = 0u;
        const f32x4 zz = (f32x4){0.f, 0.f, 0.f, 0.f};
        Rs[i][0] = __builtin_amdgcn_mfma_f32_16x16x32_bf16(*(bf16x8*)&ut, *(bf16x8*)&ux0, zz, 0, 0, 0);
        Rs[i][1] = __builtin_amdgcn_mfma_f32_16x16x32_bf16(*(bf16x8*)&ut, *(bf16x8*)&ux1, zz, 0, 0, 0);
    }
#pragma unroll
    for (int i = 0; i < 4; ++i)
#pragma unroll
        for (int ct = 0; ct < 2; ++ct) { uint2 o; o.x = pack2(Rs[i][ct][0], Rs[i][ct][1]); o.y = pack2(Rs[i][ct][2], Rs[i][ct][3]); *(uint2*)(XT + (16 * ct + l15) * CH_ROW + 16 * i + 4 * g) = o; }
}
__device__ __forceinline__ void ph_s1(const Ctx cx, PRef p, char* lds) {
    const int wave = (__builtin_amdgcn_readfirstlane(cx.tid >> 6) + 2 * (cx.bid & 1)) & 3;
    for (int pairi = cx.bid >> 1; pairi < 32 * NCHUNK; pairi += cx.nb >> 1) {
        int lz = 0; asm volatile("" : "+v"(lz));
        char* ldsb = lds + lz;
        bf16_t* At = (bf16_t*)(ldsb + L_AT); bf16_t* Bt = (bf16_t*)(ldsb + L_BT); bf16_t* Kt = (bf16_t*)(ldsb + L_KT); bf16_t* Rt = (bf16_t*)(ldsb + L_RT);
        bf16_t* BhT = (bf16_t*)(ldsb + L_BH); bf16_t* KhT = (bf16_t*)(ldsb + L_KH); bf16_t* VT = (bf16_t*)(ldsb + L_VT);
        float* Aab = (float*)(ldsb + L_AAB); float* pcl = (float*)(ldsb + L_PC); float* X2 = (float*)(ldsb + L_X2);
        bf16_t* UT = (bf16_t*)(ldsb + L_UT); bf16_t* WT = (bf16_t*)(ldsb + L_WT);
        int tid = cx.tid; asm volatile("" : "+v"(tid));
        const int lane = tid & 63, l15 = lane & 15, g = lane >> 4;
        const int bh_ = pairi / NCHUNK, cc_ = pairi % NCHUNK, dir = cx.bid & 1;
        const int chain = bh_ * 2 + dir, n = dir ? (cc_ < 4 ? 3 - cc_ : 135 - cc_) : cc_, task = chain * NCHUNK + n;
        const int h = (chain >> 1) & 15, b = chain >> 5;
        int rbase, sgn; chunk_rows(b, dir, n, rbase, sgn);
        const bf16_t* Wd = dir ? p.W1 : p.W0; const bf16_t* ADd = dir ? p.AD1 : p.AD0;
        {
            const int kq = lane & 15, gq = lane >> 4;
            f32x4 wv[4], kkv[4]; uint2 adv[4], kvv[4], rvv[4], vvv[4];
#pragma unroll
            for (int i = 0; i < 4; ++i) {
                const size_t off = (size_t)(rbase + sgn * (16 * wave + 4 * gq + i)) * DM + h * 64 + 4 * kq;
                { const uint2 zw = *(const uint2*)(Wd + off), zk = *(const uint2*)(p.KK + off);
                  wv[i][0] = __expf(-0.606531f * sigmoidf_(bflo(zw.x))); wv[i][1] = __expf(-0.606531f * sigmoidf_(bfhi(zw.x))); wv[i][2] = __expf(-0.606531f * sigmoidf_(bflo(zw.y))); wv[i][3] = __expf(-0.606531f * sigmoidf_(bfhi(zw.y)));
                  kkv[i][0] = bflo(zk.x); kkv[i][1] = bfhi(zk.x); kkv[i][2] = bflo(zk.y); kkv[i][3] = bfhi(zk.y); }
                adv[i] = *(const uint2*)(ADd + off); kvv[i] = *(const uint2*)(p.K + off); rvv[i] = *(const uint2*)(p.R + off); vvv[i] = *(const uint2*)(p.V + off);
            }
            f32x4 lp[4];
            lp[0] = wv[0]; lp[1] = lp[0] * wv[1]; lp[2] = lp[1] * wv[2]; lp[3] = lp[2] * wv[3];
            f32x4 eg = (f32x4){1.f, 1.f, 1.f, 1.f}, wt = (f32x4){1.f, 1.f, 1.f, 1.f};
#pragma unroll
            for (int g2 = 0; g2 < 4; ++g2)
#pragma unroll
                for (int c = 0; c < 4; ++c) {
                    const float tv = __int_as_float(shidx(__float_as_int(lp[3][c]), kq + 16 * g2));
                    eg[c] = (g2 < gq) ? eg[c] * tv : eg[c]; wt[c] *= tv;
                }
            if (gq == 0) *(f32x4*)(Aab + wave * 64 + 4 * kq) = wt;
            __syncthreads();
            f32x4 prefix = eg, pC = (f32x4){1.f, 1.f, 1.f, 1.f};
#pragma unroll
            for (int w2 = 0; w2 < 4; ++w2) { const f32x4 tv = *(const f32x4*)(Aab + w2 * 64 + 4 * kq); if (w2 < wave) prefix = prefix * tv; pC = pC * tv; }
            if (wave == 0 && gq == 0) *(f32x4*)(pcl + 4 * kq) = pC;
            const f32x4 ka = *(const f32x4*)(p.rw_ka + h * 64 + 4 * kq);
            float bh[4][4], kh[4][4];
#pragma unroll
            for (int i = 0; i < 4; ++i) {
                const int t = 16 * wave + 4 * gq + i;
                const float adf[4] = {bflo(adv[i].x), bfhi(adv[i].x), bflo(adv[i].y), bfhi(adv[i].y)};
                const float kvf[4] = {bflo(kvv[i].x), bfhi(kvv[i].x), bflo(kvv[i].y), bfhi(kvv[i].y)};
                const float rvf[4] = {bflo(rvv[i].x), bfhi(rvv[i].x), bflo(rvv[i].y), bfhi(rvv[i].y)};
                float at[4], bt[4], kt[4], rt[4];
#pragma unroll
                for (int c = 0; c < 4; ++c) {
                    const float pt = prefix[c] * lp[i][c], pprev = i ? prefix[c] * lp[i ? i - 1 : 0][c] : prefix[c];
                    const float ip = 1.f / pt;
                    at[c] = -kkv[i][c] * pprev; bt[c] = kkv[i][c] * adf[c] * ip; kt[c] = kvf[c] * (1.f + (adf[c] - 1.f) * ka[c]) * ip; rt[c] = rvf[c] * pt;
                    bh[i][c] = bt[c] * pC[c]; kh[i][c] = kt[c] * pC[c];
                }
                uint2 o;
                o.x = pack2(at[0], at[1]); o.y = pack2(at[2], at[3]); *(uint2*)(At + t * CH_ROW + 4 * kq) = o;
                o.x = pack2(bt[0], bt[1]); o.y = pack2(bt[2], bt[3]); *(uint2*)(Bt + t * CH_ROW + 4 * kq) = o;
                o.x = pack2(kt[0], kt[1]); o.y = pack2(kt[2], kt[3]); *(uint2*)(Kt + t * CH_ROW + 4 * kq) = o;
                o.x = pack2(rt[0], rt[1]); o.y = pack2(rt[2], rt[3]); *(uint2*)(Rt + t * CH_ROW + 4 * kq) = o;
            }
#pragma unroll
            for (int c = 0; c < 4; ++c) {
                const int col = 16 * wave + 4 * gq;
                uint2 o;
                o.x = pack2(bh[0][c], bh[1][c]); o.y = pack2(bh[2][c], bh[3][c]); *(uint2*)(BhT + (4 * kq + c) * CH_ROW + col) = o;
                o.x = pack2(kh[0][c], kh[1][c]); o.y = pack2(kh[2][c], kh[3][c]); *(uint2*)(KhT + (4 * kq + c) * CH_ROW + col) = o;
                const unsigned v0 = (c & 1) ? (((c >> 1) ? vvv[0].y : vvv[0].x) >> 16) : (((c >> 1) ? vvv[0].y : vvv[0].x) & 0xffffu);
                const unsigned v1 = (c & 1) ? (((c >> 1) ? vvv[1].y : vvv[1].x) >> 16) : (((c >> 1) ? vvv[1].y : vvv[1].x) & 0xffffu);
                const unsigned v2 = (c & 1) ? (((c >> 1) ? vvv[2].y : vvv[2].x) >> 16) : (((c >> 1) ? vvv[2].y : vvv[2].x) & 0xffffu);
                const unsigned v3 = (c & 1) ? (((c >> 1) ? vvv[3].y : vvv[3].x) >> 16) : (((c >> 1) ? vvv[3].y : vvv[3].x) & 0xffffu);
                o.x = v0 | (v1 << 16); o.y = v2 | (v3 << 16); *(uint2*)(VT + (4 * kq + c) * CH_ROW + col) = o;
            }
        }
        __syncthreads();
        const size_t tb = (size_t)task * 4096;
        bf16_t* Abf = (bf16_t*)(ldsb + L_AAB);
        bf16_t* TD = (bf16_t*)(ldsb + L_AAB + 9216);
        bf16_t* Kbf = Bt;
        if (wave == 0) {
            f32x4 Rs[4][2];
            {
                f32x4 accP[4][4]; zero44(accP);
                mm64(accP, Bt, At, l15, g); mask44(accP, l15, g, true);
#pragma unroll
                for (int xt = 0; xt < 4; ++xt)
#pragma unroll
                    for (int yt = 0; yt < 4; ++yt) { uint2 o; o.x = pack2(accP[xt][yt][0], accP[xt][yt][1]); o.y = pack2(accP[xt][yt][2], accP[xt][yt][3]); *(uint2*)(Abf + (16 * yt + l15) * CH_ROW + 16 * xt + 4 * g) = o; }
            }
            s1_diag_inverse(Abf, TD, lane);
            __syncthreads();
            s1_load_slab(Rs, At, 0, l15, g);
            __syncthreads();
            s1_slab_solve(Rs, Abf, TD, WT, l15, g);
            __syncthreads();
            {
                f32x4 accM[4][4]; zero44(accM);
                mm64(accM, WT, BhT, l15, g);
#pragma unroll
                for (int kpt = 0; kpt < 4; ++kpt)
#pragma unroll
                    for (int kt = 0; kt < 4; ++kt) {
                        const int k = 16 * kt + l15;
                        const float pc = pcl[k];
                        float v[4];
#pragma unroll
                        for (int r = 0; r < 4; ++r) v[r] = accM[kpt][kt][r] + ((16 * kpt + 4 * g + r) == k ? pc : 0.f);
                        uint2 o; o.x = pack2(v[0], v[1]); o.y = pack2(v[2], v[3]);
                        *(uint2*)(p.CM + tb + k * 64 + 32 * (kpt >> 1) + 8 * g + 4 * (kpt & 1)) = o;
                    }
            }
            __syncthreads();
        } else if (wave == 1) {
            f32x4 Rs[4][2];
            {
                f32x4 accA[4][4]; zero44(accA);
                mm64(accA, Kt, At, l15, g); mask44(accA, l15, g, true);
                __syncthreads();
#pragma unroll
                for (int xt = 0; xt < 4; ++xt)
#pragma unroll
                    for (int yt = 0; yt < 4; ++yt) { uint2 o; o.x = pack2(accA[xt][yt][0], accA[xt][yt][1]); o.y = pack2(accA[xt][yt][2], accA[xt][yt][3]); *(uint2*)(Kbf + (16 * yt + l15) * CH_ROW + 16 * xt + 4 * g) = o; }
            }
            s1_load_slab(Rs, At, 32, l15, g);
            __syncthreads();
            s1_slab_solve(Rs, Abf, TD, WT + 32 * CH_ROW, l15, g);
            __syncthreads();
            __syncthreads();
        } else if (wave == 2) {
            f32x4 accP[4][4], accQ[4][4];
            zero44(accP); zero44(accQ);
            mm64(accP, Kt, Rt, l15, g); mask44(accP, l15, g, false);
            mm64_accB(accQ, VT, accP, l15, g);
            zero44(accP);
            mm64(accP, Bt, Rt, l15, g); mask44(accP, l15, g, false);
            __syncthreads();
            __syncthreads();
            {
                f32x4 Rs[4][2];
                s1_x2_slab(Rs, Kbf, VT, 0, l15, g);
                s1_slab_solve(Rs, Abf, TD, UT, l15, g);
            }
            __syncthreads();
            mm64_accB(accQ, UT, accP, l15, g);
#pragma unroll
            for (int vt = 0; vt < 4; ++vt)
#pragma unroll
                for (int tt = 0; tt < 4; ++tt) {
                    uint2 o; o.x = pack2(accQ[vt][tt][0], accQ[vt][tt][1]); o.y = pack2(accQ[vt][tt][2], accQ[vt][tt][3]);
                    *(uint2*)(p.CY + tb + (16 * tt + l15) * 64 + 16 * vt + 4 * g) = o;
                }
            zero44(accQ);
            mm64_accB(accQ, WT, accP, l15, g);
#pragma unroll
            for (int kt = 0; kt < 4; ++kt)
#pragma unroll
                for (int tt = 0; tt < 4; ++tt) {
                    const uint2 rr = *(const uint2*)(Rt + (16 * tt + l15) * CH_ROW + 16 * kt + 4 * g);
                    uint2 o; o.x = pack2(accQ[kt][tt][0] + bflo(rr.x), accQ[kt][tt][1] + bfhi(rr.x)); o.y = pack2(accQ[kt][tt][2] + bflo(rr.y), accQ[kt][tt][3] + bfhi(rr.y));
                    *(uint2*)(p.CR + tb + (16 * tt + l15) * 64 + 16 * kt + 4 * g) = o;
                }
            __syncthreads();
        } else {
            f32x4 accP[4][4];
            zero44(accP);
            mm64(accP, KhT, VT, l15, g);
            __syncthreads();
            __syncthreads();
            {
                f32x4 Rs[4][2];
                s1_x2_slab(Rs, Kbf, VT, 32, l15, g);
                s1_slab_solve(Rs, Abf, TD, UT + 32 * CH_ROW, l15, g);
            }
            __syncthreads();
            mm64(accP, BhT, UT, l15, g);
#pragma unroll
            for (int kt = 0; kt < 4; ++kt)
#pragma unroll
                for (int vt = 0; vt < 4; ++vt) {
                    uint2 o; o.x = pack2(accP[kt][vt][0], accP[kt][vt][1]); o.y = pack2(accP[kt][vt][2], accP[kt][vt][3]);
                    *(uint2*)(p.CN + tb + (16 * vt + l15) * 64 + 16 * kt + 4 * g) = o;
                }
            __syncthreads();
        }
    }
}
#define S2_PF 4
__device__ __forceinline__ void s2_body(const Ctx cx, PRef p) {
    const int lane = cx.tid & 63, l15 = lane & 15, g = lane >> 4;
    const int item = cx.bid, chain = item >> 2, vs = (item & 3) * 16;
    const bf16_t* Mb = p.CM + (size_t)chain * NCHUNK * 4096;
    const bf16_t* Nb = p.CN + (size_t)chain * NCHUNK * 4096 + (vs + l15) * 64 + 4 * g;
    bf16_t* Sb = p.CS + (size_t)chain * NCHUNK * 4096 + (vs + l15) * 64 + 4 * g;
    f32x4 sacc[4];
#pragma unroll
    for (int kt = 0; kt < 4; ++kt) sacc[kt] = (f32x4){0.f, 0.f, 0.f, 0.f};
    uint4 mreg[S2_PF][8]; uint2 nreg[S2_PF][4];
    auto ldstep = [&](int slot, int n) {
#pragma unroll
        for (int kt = 0; kt < 4; ++kt) {
            mreg[slot][2 * kt] = *(const uint4*)(Mb + (size_t)n * 4096 + (16 * kt + l15) * 64 + 8 * g);
            mreg[slot][2 * kt + 1] = *(const uint4*)(Mb + (size_t)n * 4096 + (16 * kt + l15) * 64 + 32 + 8 * g);
            nreg[slot][kt] = *(const uint2*)(Nb + (size_t)n * 4096 + 16 * kt);
        }
    };
#pragma unroll
    for (int s2 = 0; s2 < S2_PF; ++s2) ldstep(s2, s2);
    for (int n0 = 0; n0 < NCHUNK; n0 += S2_PF) {
#pragma unroll
        for (int s2 = 0; s2 < S2_PF; ++s2) {
            const int n = n0 + s2;
#pragma unroll
            for (int kt = 0; kt < 4; ++kt) { uint2 o; o.x = pack2(sacc[kt][0], sacc[kt][1]); o.y = pack2(sacc[kt][2], sacc[kt][3]); *(uint2*)(Sb + (size_t)n * 4096 + 16 * kt) = o; }
            const bf16x8 sb0 = pack8(sacc[0], sacc[1]), sb1 = pack8(sacc[2], sacc[3]);
#pragma unroll
            for (int kt = 0; kt < 4; ++kt) {
                f32x4 a; a[0] = bflo(nreg[s2][kt].x); a[1] = bfhi(nreg[s2][kt].x); a[2] = bflo(nreg[s2][kt].y); a[3] = bfhi(nreg[s2][kt].y);
                a = __builtin_amdgcn_mfma_f32_16x16x32_bf16(*(bf16x8*)&mreg[s2][2 * kt], sb0, a, 0, 0, 0);
                a = __builtin_amdgcn_mfma_f32_16x16x32_bf16(*(bf16x8*)&mreg[s2][2 * kt + 1], sb1, a, 0, 0, 0);
                sacc[kt] = a;
            }
            if (n + S2_PF < NCHUNK) ldstep(s2, n + S2_PF);
        }
    }
}
#define S2R_SLOTS 8
#define S2R_AHEAD 7
__device__ __forceinline__ void s2_ring(const Ctx px, PRef p, char* lds) {
    const int wv = __builtin_amdgcn_readfirstlane(px.tid >> 6), lane = px.tid & 63, l15 = lane & 15, g = lane >> 4;
    const int chain = px.bid;
    const bf16_t* Mb = p.CM + (size_t)chain * NCHUNK * 4096;
    const bf16_t* Nb = p.CN + (size_t)chain * NCHUNK * 4096;
    if (wv >= 4) {
        const int lw = wv - 4;
        unsigned so[2];
#pragma unroll
        for (int i = 0; i < 2; ++i) { const int sl = lw * 128 + i * 64 + lane, row = sl >> 3, cp = sl & 7; so[i] = (unsigned)(row * 64 + ((cp ^ (row & 7)) * 8)); }
        auto issue = [&](int n) {
            char* slot = lds + (n & (S2R_SLOTS - 1)) * 16384 + lw * 2048;
            glds16(Mb + (size_t)n * 4096 + so[0], slot); glds16(Mb + (size_t)n * 4096 + so[1], slot + 1024);
            glds16(Nb + (size_t)n * 4096 + so[0], slot + 8192); glds16(Nb + (size_t)n * 4096 + so[1], slot + 8192 + 1024);
        };
        for (int n = 0; n < S2R_AHEAD; ++n) issue(n);
        asm volatile("s_waitcnt vmcnt(24)" ::: "memory");
        __builtin_amdgcn_s_barrier();
        for (int n = 0; n < NCHUNK; ++n) {
            if (n + S2R_AHEAD < NCHUNK) { issue(n + S2R_AHEAD); asm volatile("s_waitcnt vmcnt(24)" ::: "memory"); }
            else asm volatile("s_waitcnt vmcnt(0)" ::: "memory");
            __builtin_amdgcn_s_barrier();
        }
    } else {
        const int vs = wv * 16;
        bf16_t* Sb = p.CS + (size_t)chain * NCHUNK * 4096 + (vs + l15) * 64 + 4 * g;
        f32x4 sacc[4];
#pragma unroll
        for (int kt = 0; kt < 4; ++kt) sacc[kt] = (f32x4){0.f, 0.f, 0.f, 0.f};
        __builtin_amdgcn_s_barrier();
        for (int n = 0; n < NCHUNK; ++n) {
            const char* slot = lds + (n & (S2R_SLOTS - 1)) * 16384;
            bf16x8 mf[8]; uint2 nf[4];
#pragma unroll
            for (int kt = 0; kt < 4; ++kt) {
                const int row = 16 * kt + l15;
                mf[2 * kt] = *(const bf16x8*)(slot + row * 128 + ((g ^ (row & 7)) << 4));
                mf[2 * kt + 1] = *(const bf16x8*)(slot + row * 128 + (((4 + g) ^ (row & 7)) << 4));
                const int nrow = vs + l15;
                nf[kt] = *(const uint2*)(slot + 8192 + nrow * 128 + (((2 * kt + (g >> 1)) ^ (nrow & 7)) << 4) + (g & 1) * 8);
            }
#pragma unroll
            for (int kt = 0; kt < 4; ++kt) { uint2 o; o.x = pack2(sacc[kt][0], sacc[kt][1]); o.y = pack2(sacc[kt][2], sacc[kt][3]); *(uint2*)(Sb + (size_t)n * 4096 + 16 * kt) = o; }
            const bf16x8 sb0 = pack8(sacc[0], sacc[1]), sb1 = pack8(sacc[2], sacc[3]);
#pragma unroll
            for (int kt = 0; kt < 4; ++kt) {
                f32x4 a2; a2[0] = bflo(nf[kt].x); a2[1] = bfhi(nf[kt].x); a2[2] = bflo(nf[kt].y); a2[3] = bfhi(nf[kt].y);
                a2 = __builtin_amdgcn_mfma_f32_16x16x32_bf16(mf[2 * kt], sb0, a2, 0, 0, 0);
                a2 = __builtin_amdgcn_mfma_f32_16x16x32_bf16(mf[2 * kt + 1], sb1, a2, 0, 0, 0);
                sacc[kt] = a2;
            }
            asm volatile("s_waitcnt lgkmcnt(0)" ::: "memory");
            __builtin_amdgcn_s_barrier();
        }
    }
}
__device__ __forceinline__ void ph_s2(const Ctx px, const Ctx cx, PRef p, char* ldsv, char* ldsq) {
    if (px.bid < 64) {
        s2_ring(px, p, ldsq);
    } else {
        conv_small(cx, p, ldsv, 960, 1856, cx.bid - 128, cx.nb - 128);
        conv_moe(cx, p, ldsv, cx.bid - 128, cx.nb - 128);
    }
}
__device__ __forceinline__ void ph_s3o(const Ctx cx, PRef p) {
    const int lane = cx.tid & 63, tt = cx.tid >> 6, l15 = lane & 15, g = lane >> 4;
    for (int task = cx.bid; task < 32 * NCHUNK; task += cx.nb) {
        const int bh = task / NCHUNK, cc = task % NCHUNK, h = bh & 15, b = bh >> 4;
        const int t = 16 * tt + l15;
        const size_t tbf = ((size_t)(bh * 2) * NCHUNK + cc) * 4096;
        const size_t tbb = ((size_t)(bh * 2 + 1) * NCHUNK + (cc < 4 ? 3 - cc : 135 - cc)) * 4096;
        const int tb_ = 63 - t;
        const bf16x8 rf0 = *(const bf16x8*)(p.CR + tbf + t * 64 + 8 * g), rf1 = *(const bf16x8*)(p.CR + tbf + t * 64 + 32 + 8 * g);
        const bf16x8 rb0 = *(const bf16x8*)(p.CR + tbb + tb_ * 64 + 8 * g), rb1 = *(const bf16x8*)(p.CR + tbb + tb_ * 64 + 32 + 8 * g);
        const int row = cc < 4 ? ROWS_LAT + b * LCTX + 64 * cc + t : b * TLAT + 64 * (cc - 4) + t;
        const size_t off = (size_t)row * DM + h * 64 + 4 * g;
        float4 rkw4[4], lg4[4], lb4[4];
#pragma unroll
        for (int vt = 0; vt < 4; ++vt) { rkw4[vt] = *(const float4*)(p.rw_rk + h * 64 + 16 * vt + 4 * g); lg4[vt] = *(const float4*)(p.rw_lnx_g + h * 64 + 16 * vt + 4 * g); lb4[vt] = *(const float4*)(p.rw_lnx_b + h * 64 + 16 * vt + 4 * g); }
        uint2 ur4[4], uk4[4], uv4[4], ug4[4];
#pragma unroll
        for (int vt = 0; vt < 4; ++vt) { ur4[vt] = *(const uint2*)(p.R + off + 16 * vt); uk4[vt] = *(const uint2*)(p.K + off + 16 * vt); uv4[vt] = *(const uint2*)(p.V + off + 16 * vt); ug4[vt] = *(const uint2*)(p.G + off + 16 * vt); }
        f32x4 y[4];
#pragma unroll
        for (int vt = 0; vt < 4; ++vt) {
            const bf16x8 sf0 = *(const bf16x8*)(p.CS + tbf + (16 * vt + l15) * 64 + 8 * g), sf1 = *(const bf16x8*)(p.CS + tbf + (16 * vt + l15) * 64 + 32 + 8 * g);
            const bf16x8 sb0 = *(const bf16x8*)(p.CS + tbb + (16 * vt + l15) * 64 + 8 * g), sb1 = *(const bf16x8*)(p.CS + tbb + (16 * vt + l15) * 64 + 32 + 8 * g);
            const uint2 yf = *(const uint2*)(p.CY + tbf + t * 64 + 16 * vt + 4 * g), yb = *(const uint2*)(p.CY + tbb + tb_ * 64 + 16 * vt + 4 * g);
            f32x4 a; a[0] = bflo(yf.x) + bflo(yb.x); a[1] = bfhi(yf.x) + bfhi(yb.x); a[2] = bflo(yf.y) + bflo(yb.y); a[3] = bfhi(yf.y) + bfhi(yb.y);
            a = __builtin_amdgcn_mfma_f32_16x16x32_bf16(sf0, rf0, a, 0, 0, 0);
            a = __builtin_amdgcn_mfma_f32_16x16x32_bf16(sf1, rf1, a, 0, 0, 0);
            a = __builtin_amdgcn_mfma_f32_16x16x32_bf16(sb0, rb0, a, 0, 0, 0);
            a = __builtin_amdgcn_mfma_f32_16x16x32_bf16(sb1, rb1, a, 0, 0, 0);
            y[vt] = a;
        }
        float s = 0.f;
#pragma unroll
        for (int vt = 0; vt < 4; ++vt) s += (y[vt][0] + y[vt][1]) + (y[vt][2] + y[vt][3]);
        s += shx(s, 16, lane); s += shx(s, 32, lane);
        const float mu = s * (1.f / 64.f);
        float q2 = 0.f, rk = 0.f;
        float rr[4][4], vv[4][4], gg[4][4];
#pragma unroll
        for (int vt = 0; vt < 4; ++vt) {
            const uint2 ur = ur4[vt], uk = uk4[vt], uv = uv4[vt], ug = ug4[vt];
            const float4 rkw = rkw4[vt];
            rr[vt][0] = bflo(ur.x); rr[vt][1] = bfhi(ur.x); rr[vt][2] = bflo(ur.y); rr[vt][3] = bfhi(ur.y);
            vv[vt][0] = bflo(uv.x); vv[vt][1] = bfhi(uv.x); vv[vt][2] = bflo(uv.y); vv[vt][3] = bfhi(uv.y);
            gg[vt][0] = bflo(ug.x); gg[vt][1] = bfhi(ug.x); gg[vt][2] = bflo(ug.y); gg[vt][3] = bfhi(ug.y);
            rk += rr[vt][0] * bflo(uk.x) * rkw.x + rr[vt][1] * bfhi(uk.x) * rkw.y + rr[vt][2] * bflo(uk.y) * rkw.z + rr[vt][3] * bfhi(uk.y) * rkw.w;
#pragma unroll
            for (int r = 0; r < 4; ++r) { const float d = y[vt][r] - mu; q2 += d * d; }
        }
        q2 += shx(q2, 16, lane); q2 += shx(q2, 32, lane); rk += shx(rk, 16, lane); rk += shx(rk, 32, lane);
        const float rstd = __builtin_amdgcn_rsqf(q2 * (1.f / 64.f) + 64e-5f);
#pragma unroll
        for (int vt = 0; vt < 4; ++vt) {
            const float4 lg = lg4[vt], lb = lb4[vt];
            const float z0 = ((y[vt][0] - mu) * rstd * lg.x + lb.x + rk * vv[vt][0]) * gg[vt][0];
            const float z1 = ((y[vt][1] - mu) * rstd * lg.y + lb.y + rk * vv[vt][1]) * gg[vt][1];
            const float z2 = ((y[vt][2] - mu) * rstd * lg.z + lb.z + rk * vv[vt][2]) * gg[vt][2];
            const float z3 = ((y[vt][3] - mu) * rstd * lg.w + lb.w + rk * vv[vt][3]) * gg[vt][3];
            uint2 o; o.x = pack2(z0, z1); o.y = pack2(z2, z3);
            *(uint2*)(p.G + off + 16 * vt) = o;
        }
    }
}
__device__ __forceinline__ void ph_oproj(const Ctx cx, PRef p, char* lds, const bf16_t* A_, const bf16_t* Wt, const float* xl, const float* xc, const float* modl, int mt_lo, int mtiles) {
    for (int tile = cx.bid; tile < mtiles * 8; tile += cx.nb) {
        const int mt = mt_lo + (tile >> 3), n0 = (tile & 7) * 128, m0 = mt * 128;
        const bf16_t* A = A_ + (size_t)m0 * DM + G3_CH8;
        const bf16_t* B = Wt + (size_t)n0 * 1024 + G3_CH8;
        EpiResid epi; epi.out = p.PRE; epi.xl = xl; epi.xc = xc; epi.modl = modl; epi.m0 = m0; epi.n0 = n0;
        gemm3_tile(cx, A + (size_t)G3_ROW(0) * DM, A + (size_t)G3_ROW(1) * DM,
                   B + (size_t)G3_ROW(0) * 1024, B + (size_t)G3_ROW(1) * 1024, 1024, epi, lds);
    }
}
__device__ __forceinline__ void ph_ln_router(const Ctx cx, PRef p, int layer, int nrows) {
    const int lane_ = cx.tid & 63, gw = (cx.bid * NTHR + cx.tid) >> 6, nw = (cx.nb * NTHR) >> 6;
    const float* lg = p.ln1_g + layer * DM; const float* lb = p.ln1_b + layer * DM;
    const float* rw = p.router_w + (size_t)layer * DM * 16;
    const bool b5 = lane_ & 32, b4 = lane_ & 16, b3 = lane_ & 8, b2 = lane_ & 4;
    const int myidx = (b5 ? 8 : 0) + (b4 ? 4 : 0) + (b3 ? 2 : 0) + (b2 ? 1 : 0);
    const int nmain = (nrows / (nw * 4)) * (nw * 4);
    const int ntail = nrows - nmain;
    for (int it = gw; it < nmain / 4 + ntail; it += nw) {
        const int rstep = it < nmain / 4 ? 1 : 0;
        const int r0 = rstep ? it * 4 : nmain + (it - nmain / 4);
        int lane = lane_; asm volatile("" : "+v"(lane));
        float mu[4], rstd[4];
        float4 v[4][4];
        {
#pragma unroll
            for (int rr = 0; rr < 4; ++rr) {
                const float* pr = p.PRE + (size_t)(r0 + rr * rstep) * DM;
                float s = 0.f;
#pragma unroll
                for (int i = 0; i < 4; ++i) { v[rr][i] = *(const float4*)(pr + i * 256 + lane * 4); s += (v[rr][i].x + v[rr][i].y) + (v[rr][i].z + v[rr][i].w); }
                mu[rr] = s;
            }
#pragma unroll
            for (int rr = 0; rr < 4; ++rr) mu[rr] = wsum(mu[rr]) * (1.f / 1024.f);
#pragma unroll
            for (int rr = 0; rr < 4; ++rr) {
                float q = 0.f;
#pragma unroll
                for (int i = 0; i < 4; ++i) { const float a = v[rr][i].x - mu[rr], b = v[rr][i].y - mu[rr], c = v[rr][i].z - mu[rr], d = v[rr][i].w - mu[rr]; q += (a * a + b * b) + (c * c + d * d); }
                rstd[rr] = q;
            }
#pragma unroll
            for (int rr = 0; rr < 4; ++rr) rstd[rr] = __builtin_amdgcn_rsqf(wsum(rstd[rr]) * (1.f / 1024.f) + 1e-5f);
        }
        const float* mv = p.modv + (size_t)(layer * 3 + mod_of_row(r0)) * 6144;
        float lgt[4][16];
#pragma unroll
        for (int rr = 0; rr < 4; ++rr)
#pragma unroll
            for (int e = 0; e < 16; ++e) lgt[rr][e] = 0.f;
        float4 wq0, wq1, wq2, wq3;
        { const float* rp = rw + (size_t)(lane * 4) * 16; wq0 = *(const float4*)(rp); wq1 = *(const float4*)(rp + 4); wq2 = *(const float4*)(rp + 8); wq3 = *(const float4*)(rp + 12); }
#pragma unroll
        for (int i = 0; i < 4; ++i) {
            const int col = i * 256 + lane * 4;
            const float4 g4 = *(const float4*)(lg + col), b4v = *(const float4*)(lb + col);
            const float4 sh = *(const float4*)(mv + 3 * 1024 + col), sc = *(const float4*)(mv + 4 * 1024 + col);
            float hh[4][4];
#pragma unroll
            for (int rr = 0; rr < 4; ++rr) {
                const float4 vv = v[rr][i];
                float4 x1;
                x1.x = (vv.x - mu[rr]) * rstd[rr] * g4.x + b4v.x; x1.y = (vv.y - mu[rr]) * rstd[rr] * g4.y + b4v.y;
                x1.z = (vv.z - mu[rr]) * rstd[rr] * g4.z + b4v.z; x1.w = (vv.w - mu[rr]) * rstd[rr] * g4.w + b4v.w;
                *(float4*)(p.X1 + (size_t)(r0 + rr * rstep) * DM + col) = x1;
                hh[rr][0] = x1.x * (1.f + sc.x) + sh.x; hh[rr][1] = x1.y * (1.f + sc.y) + sh.y; hh[rr][2] = x1.z * (1.f + sc.z) + sh.z; hh[rr][3] = x1.w * (1.f + sc.w) + sh.w;
                uint2 o; o.x = pack2(hh[rr][0], hh[rr][1]); o.y = pack2(hh[rr][2], hh[rr][3]);
                *(uint2*)(p.H2 + (size_t)(r0 + rr * rstep) * DM + col) = o;
            }
#pragma unroll
            for (int c = 0; c < 4; ++c) {
                float4 n0 = wq0, n1 = wq1, n2 = wq2, n3 = wq3;
                if (i * 4 + c + 1 < 16) {
                    const int ncol = (c == 3 ? (i + 1) * 256 + lane * 4 : col + c + 1);
                    const float* rp = rw + (size_t)ncol * 16;
                    n0 = *(const float4*)(rp); n1 = *(const float4*)(rp + 4); n2 = *(const float4*)(rp + 8); n3 = *(const float4*)(rp + 12);
                }
                const float4 w0 = wq0, w1 = wq1, w2 = wq2, w3 = wq3;
#pragma unroll
                for (int rr = 0; rr < 4; ++rr) {
                    const float hv = hh[rr][c];
                    lgt[rr][0] += hv * w0.x; lgt[rr][1] += hv * w0.y; lgt[rr][2] += hv * w0.z; lgt[rr][3] += hv * w0.w;
                    lgt[rr][4] += hv * w1.x; lgt[rr][5] += hv * w1.y; lgt[rr][6] += hv * w1.z; lgt[rr][7] += hv * w1.w;
                    lgt[rr][8] += hv * w2.x; lgt[rr][9] += hv * w2.y; lgt[rr][10] += hv * w2.z; lgt[rr][11] += hv * w2.w;
                    lgt[rr][12] += hv * w3.x; lgt[rr][13] += hv * w3.y; lgt[rr][14] += hv * w3.z; lgt[rr][15] += hv * w3.w;
                }
                if (c & 1) {
#define LPIN(rr) asm volatile("" : "+v"(lgt[rr][0]), "+v"(lgt[rr][1]), "+v"(lgt[rr][2]), "+v"(lgt[rr][3]), "+v"(lgt[rr][4]), "+v"(lgt[rr][5]), "+v"(lgt[rr][6]), "+v"(lgt[rr][7]), \
                                   "+v"(lgt[rr][8]), "+v"(lgt[rr][9]), "+v"(lgt[rr][10]), "+v"(lgt[rr][11]), "+v"(lgt[rr][12]), "+v"(lgt[rr][13]), "+v"(lgt[rr][14]), "+v"(lgt[rr][15]) :: "memory")
                    LPIN(0); LPIN(1); LPIN(2); LPIN(3);
#undef LPIN
                }
                wq0 = n0; wq1 = n1; wq2 = n2; wq3 = n3;
            }
        }
#pragma unroll
        for (int rr = 0; rr < 4; ++rr) {
            float a8[8], a4[4], a2[2], a1;
#pragma unroll
            for (int i = 0; i < 8; ++i) { const float snd = b5 ? lgt[rr][i] : lgt[rr][i + 8]; const float kp = b5 ? lgt[rr][i + 8] : lgt[rr][i]; a8[i] = kp + shx(snd, 32, lane); }
#pragma unroll
            for (int i = 0; i < 4; ++i) { const float snd = b4 ? a8[i] : a8[i + 4]; const float kp = b4 ? a8[i + 4] : a8[i]; a4[i] = kp + shx(snd, 16, lane); }
#pragma unroll
            for (int i = 0; i < 2; ++i) { const float snd = b3 ? a4[i] : a4[i + 2]; const float kp = b3 ? a4[i + 2] : a4[i]; a2[i] = kp + shx(snd, 8, lane); }
            { const float snd = b2 ? a2[0] : a2[1]; const float kp = b2 ? a2[1] : a2[0]; a1 = kp + shx(snd, 4, lane); }
            a1 += shx(a1, 2, lane); a1 += shx(a1, 1, lane);
            float mx = a1;
            mx = fmaxf(mx, shx(mx, 32, lane)); mx = fmaxf(mx, shx(mx, 16, lane)); mx = fmaxf(mx, shx(mx, 8, lane)); mx = fmaxf(mx, shx(mx, 4, lane));
            const float ex = __expf(a1 - mx);
            float se = ex;
            se += shx(se, 32, lane); se += shx(se, 16, lane); se += shx(se, 8, lane); se += shx(se, 4, lane);
            if ((lane & 3) == 0) { p.afft[(size_t)myidx * ROWS + r0 + rr * rstep] = ex / se; p.inv[(size_t)(r0 + rr * rstep) * 16 + myidx] = -1; }
        }
    }
}
template <int CH>
__device__ __forceinline__ void topk_list(const Ctx cx, PRef p, int e, int rowbase, int cap, int slotbase, unsigned* sh) {
    const int tid = cx.tid, lane = tid & 63, wave = tid >> 6;
    const float* src = p.afft + (size_t)e * ROWS + rowbase + tid * CH;
    unsigned key[CH];
    if (CH >= 4) {
#pragma unroll
        for (int j = 0; j < CH / 4; ++j) { const uint4 u = *(const uint4*)(src + 4 * j); key[4 * j] = u.x; key[4 * j + 1] = u.y; key[4 * j + 2] = u.z; key[4 * j + 3] = u.w; }
    } else {
#pragma unroll
        for (int j = 0; j < CH; ++j) key[j] = __float_as_uint(src[j]);
    }
    unsigned prefix = 0u;
    for (int bit = 30; bit >= 0; --bit) {
        const unsigned cand = prefix | (1u << bit);
        int c = 0;
#pragma unroll
        for (int j = 0; j < CH; ++j) c += (key[j] >= cand) ? 1 : 0;
#pragma unroll
        for (int o = 32; o > 0; o >>= 1) c += shxi(c, o, lane);
        const int slot = (30 - bit) & 1;
        if (lane == 0) sh[slot * 4 + wave] = (unsigned)c;
        __syncthreads();
        const int tot = (int)(sh[slot * 4] + sh[slot * 4 + 1] + sh[slot * 4 + 2] + sh[slot * 4 + 3]);
        if (tot >= cap) prefix = cand;
    }
    __syncthreads();
    const unsigned thr = prefix;
    int cg = 0, ce = 0;
#pragma unroll
    for (int j = 0; j < CH; ++j) { cg += key[j] > thr; ce += key[j] == thr; }
    unsigned pk = (unsigned)cg | ((unsigned)ce << 16);
    unsigned incl = pk;
#pragma unroll
    for (int o = 1; o < 64; o <<= 1) { const unsigned n = (unsigned)shidx((int)incl, (lane - o) & 63); if (lane >= o) incl += n; }
    if (lane == 63) sh[8 + wave] = incl;
    __syncthreads();
    unsigned wbase = 0u, total = 0u;
#pragma unroll
    for (int w = 0; w < 4; ++w) { const unsigned v = sh[8 + w]; if (w < wave) wbase += v; total += v; }
    const unsigned excl = wbase + incl - pk;
    const int tot_gt = (int)(total & 0xffffu);
    const int need_eq = cap - tot_gt;
    int eq_rank = (int)(excl >> 16);
    int gt_before = (int)(excl & 0xffffu);
#pragma unroll
    for (int j = 0; j < CH; ++j) {
        const bool isg = key[j] > thr, ise = key[j] == thr;
        const bool sel = isg || (ise && eq_rank < need_eq);
        if (sel) {
            const int slot = slotbase + gt_before + (eq_rank < need_eq ? eq_rank : need_eq);
            const int row = rowbase + tid * CH + j;
            p.idx[e * MPAD0 + slot] = row;
            p.gate[e * MPAD0 + slot] = __uint_as_float(key[j]);
            p.inv[(size_t)row * 16 + e] = slot;
        }
        gt_before += isg; eq_rank += ise;
    }
    __syncthreads();
}
__device__ __forceinline__ void ph_topk(const Ctx cx, PRef p, int layer, char* lds) {
    unsigned* sh = (unsigned*)lds;
    const int nlists = layer == 0 ? 64 : 32;
    for (int li = cx.bid; li < nlists; li += cx.nb) {
        const int s = li >> 4, e = li & 15;
        if (s < 2) topk_list<32>(cx, p, e, s * TLAT, 1024, s * 1024, sh);
        else {
            topk_list<1>(cx, p, e, ROWS_LAT + (s - 2) * LCTX, 32, 2048 + (s - 2) * 32, sh);
            if (s == 3 && cx.tid < 64) { p.idx[e * MPAD0 + 2112 + cx.tid] = -1; p.gate[e * MPAD0 + 2112 + cx.tid] = 0.f; }
        }
    }
}
__device__ __forceinline__ void ph_moe_up(const Ctx cx, PRef p, int layer, char* lds) {
    if (layer != 0) return;
    for (int tile = cx.bid; tile < 16 * 32; tile += cx.nb) {
        const int e = tile >> 5, nt = tile & 31, m0 = 2048, j0 = nt * 64;
        const bf16_t* ar[2]; const bf16_t* br[2];
        const bf16_t* We = p.CW + (size_t)(layer * 16 + e) * 3 * 2097152;
#pragma unroll
        for (int i = 0; i < 2; ++i) {
            const int r = G3_ROW(i);
            int src = p.idx[e * MPAD0 + m0 + r]; if (src < 0) src = 0;
            ar[i] = p.H2 + (size_t)src * DM + G3_CH8;
            const int j = j0 + (r >> 6) * 32 + ((r >> 4) & 1) * 16 + (r & 15);
            br[i] = We + (size_t)((r >> 5) & 1) * 2097152 + (size_t)j * 1024 + G3_CH8;
        }
        EpiSwiGLU epi; epi.out = p.HMID + (size_t)e * MPAD0 * 2048; epi.m0 = m0; epi.j0 = j0;
        gemm3_tile(cx, ar[0], ar[1], br[0], br[1], 1024, epi, lds);
    }
}
__device__ __forceinline__ void ph_moe_down(const Ctx cx, PRef p, int layer, char* lds) {
    if (layer != 0) return;
    for (int tile = cx.bid; tile < 16 * 8; tile += cx.nb) {
        const int e = tile >> 3, nt = tile & 7, m0 = 2048, n0 = nt * 128;
        const bf16_t* A = p.HMID + ((size_t)e * MPAD0 + m0) * 2048 + G3_CH8;
        const bf16_t* B = p.CW + ((size_t)(layer * 16 + e) * 3 + 2) * 2097152 + (size_t)n0 * 2048 + G3_CH8;
        EpiDown epi; epi.out = p.YE + (size_t)e * MPAD0 * DM; epi.gate = p.gate + e * MPAD0; epi.m0 = m0; epi.n0 = n0;
        gemm3_tile(cx, A + (size_t)G3_ROW(0) * 2048, A + (size_t)G3_ROW(1) * 2048,
                   B + (size_t)G3_ROW(0) * 2048, B + (size_t)G3_ROW(1) * 2048, 2048, epi, lds);
    }
}
__device__ __forceinline__ void ph_combine(const Ctx cx, PRef p, int layer, int nrows) {
    const int lane = cx.tid & 63, gw = (cx.bid * NTHR + cx.tid) >> 6, nw = (cx.nb * NTHR) >> 6;
    const float* lg = p.ln2_g + layer * DM; const float* lb = p.ln2_b + layer * DM;
    int inv_next = (gw < nrows && lane < 16) ? p.inv[(size_t)gw * 16 + lane] : -1;
    for (int row = gw; row < nrows; row += nw) {
        const float* mv = p.modv + (size_t)(layer * 3 + mod_of_row(row)) * 6144;
        float4 m[4];
#pragma unroll
        for (int i = 0; i < 4; ++i) m[i] = make_float4(0.f, 0.f, 0.f, 0.f);
        const int myinv = inv_next;
        float4 x1r[4], g5r[4];
#pragma unroll
        for (int i = 0; i < 4; ++i) { const int col = i * 256 + lane * 4; x1r[i] = *(const float4*)(p.X1 + (size_t)row * DM + col); g5r[i] = *(const float4*)(mv + 5 * 1024 + col); }
        inv_next = (row + nw < nrows && lane < 16) ? p.inv[(size_t)(row + nw) * 16 + lane] : -1;
        unsigned vm = (unsigned)(__builtin_amdgcn_ballot_w64(myinv >= 0) & 0xffffull);
        while (vm) {
            int ek[4]; float wk[4];
#pragma unroll
            for (int k = 0; k < 4; ++k) { if (vm) { ek[k] = __builtin_ctz(vm); vm &= vm - 1u; wk[k] = 1.f; } else { ek[k] = ek[0]; wk[k] = 0.f; } }
            uint2 y[4][4];
#pragma unroll
            for (int k = 0; k < 4; ++k) {
                const int sl = shidx(myinv, ek[k]);
                const bf16_t* yr = p.YE + ((size_t)ek[k] * MPAD0 + sl) * DM;
#pragma unroll
                for (int i = 0; i < 4; ++i) y[k][i] = *(const uint2*)(yr + i * 256 + lane * 4);
            }
#pragma unroll
            for (int k = 0; k < 4; ++k)
#pragma unroll
                for (int i = 0; i < 4; ++i) { m[i].x += wk[k] * bflo(y[k][i].x); m[i].y += wk[k] * bfhi(y[k][i].x); m[i].z += wk[k] * bflo(y[k][i].y); m[i].w += wk[k] * bfhi(y[k][i].y); }
        }
        float4 v[4]; float s = 0.f;
#pragma unroll
        for (int i = 0; i < 4; ++i) {
            const int col = i * 256 + lane * 4;
            const float4 x1 = x1r[i], g5 = g5r[i];
            v[i].x = ALPHA_F * x1.x + g5.x * m[i].x; v[i].y = ALPHA_F * x1.y + g5.y * m[i].y; v[i].z = ALPHA_F * x1.z + g5.z * m[i].z; v[i].w = ALPHA_F * x1.w + g5.w * m[i].w;
            s += (v[i].x + v[i].y) + (v[i].z + v[i].w);
        }
        const float mu = wsum(s) * (1.f / 1024.f);
        float q = 0.f;
#pragma unroll
        for (int i = 0; i < 4; ++i) { const float a = v[i].x - mu, b = v[i].y - mu, c = v[i].z - mu, d = v[i].w - mu; q += (a * a + b * b) + (c * c + d * d); }
        const float rstd = __builtin_amdgcn_rsqf(wsum(q) * (1.f / 1024.f) + 1e-5f);
        const float* mv1 = p.modv + (size_t)(3 + mod_of_row(row)) * 6144;
#pragma unroll
        for (int i = 0; i < 4; ++i) {
            const int col = i * 256 + lane * 4;
            const float4 g4 = *(const float4*)(lg + col), b4 = *(const float4*)(lb + col);
            float4 x2;
            x2.x = (v[i].x - mu) * rstd * g4.x + b4.x; x2.y = (v[i].y - mu) * rstd * g4.y + b4.y;
            x2.z = (v[i].z - mu) * rstd * g4.z + b4.z; x2.w = (v[i].w - mu) * rstd * g4.w + b4.w;
            if (layer == 0) {
                *(float4*)(p.X1 + (size_t)row * DM + col) = x2;
                const float4 sh = *(const float4*)(mv1 + col), sc = *(const float4*)(mv1 + 1024 + col);
                uint2 o; o.x = pack2(x2.x * (1.f + sc.x) + sh.x, x2.y * (1.f + sc.y) + sh.y); o.y = pack2(x2.z * (1.f + sc.z) + sh.z, x2.w * (1.f + sc.w) + sh.w);
                *(uint2*)(p.HB + (size_t)row * DM + col) = o;
            } else {
                *(float4*)(p.out + (size_t)row * DM + col) = x2;
            }
        }
    }
}
__device__ __forceinline__ void ph_qkv(const Ctx cx, PRef p, char* lds) {
    for (int tile = cx.bid; tile < 16; tile += cx.nb) {
        const int mt = 128 + (tile >> 2), n0 = (8 + (tile & 3)) * 128, m0 = mt * 128;
        const bf16_t* A = p.HB + (size_t)m0 * DM + G3_CH8;
        const bf16_t* B = p.wqkvT + (size_t)n0 * 1024 + G3_CH8;
        EpiQKV epi; epi.p = &p; epi.m0 = m0; epi.n0 = n0;
        gemm3_tile(cx, A + (size_t)G3_ROW(0) * DM, A + (size_t)G3_ROW(1) * DM,
                   B + (size_t)G3_ROW(0) * 1024, B + (size_t)G3_ROW(1) * 1024, 1024, epi, lds);
    }
}
#define AT_ROW 72
__device__ __forceinline__ void ph_attn(const Ctx cx, PRef p, char* lds) {
    const int tid = cx.tid, lane = tid & 63, wave = tid >> 6, qi = lane & 15, g = lane >> 4;
    bf16_t* Ks = (bf16_t*)lds;
    bf16_t* Vs = Ks + 64 * AT_ROW;
    const float LOG2E = 1.4426950408889634f;
    for (int item = cx.bid; item < 2 * 128 * 4; item += cx.nb) {
        const int hk = item & 3, qb = (item >> 2) & 127, b = item >> 9;
        const int hq = hk * 4 + wave, q0 = qb * 64;
        bf16x8 qf[4][2];
#pragma unroll
        for (int qs = 0; qs < 4; ++qs)
#pragma unroll
            for (int ks = 0; ks < 2; ++ks)
                qf[qs][ks] = *(const bf16x8*)(p.Q + (size_t)(b * TLAT + q0 + qs * 16 + qi) * DM + hq * 64 + ks * 32 + 8 * g);
        f32x4 o[4][4];
#pragma unroll
        for (int i = 0; i < 4; ++i)
#pragma unroll
            for (int j = 0; j < 4; ++j) o[i][j] = (f32x4){0.f, 0.f, 0.f, 0.f};
        const float sink = p.at_sink[hq] * LOG2E;
        float mrow[4], lrow[4];
#pragma unroll
        for (int qs = 0; qs < 4; ++qs) { mrow[qs] = sink; lrow[qs] = (g == 0) ? 1.f : 0.f; }
        uint4 kr0, kr1, vr0, vr1;
        kr0 = kr1 = vr0 = vr1 = make_uint4(0u, 0u, 0u, 0u);
#define AT_GEOM(tile_, isctx_, ts_, skip_) const bool isctx_ = (tile_) < 4; const int ts_ = isctx_ ? (tile_) * 64 : q0 - 128 + ((tile_) - 4) * 64; const bool skip_ = !isctx_ && (ts_ < 0 || ts_ >= TLAT)
#define AT_LOAD(tile_) do { AT_GEOM(tile_, ic_, tl_, sk_); if (!sk_) { \
            const bf16_t* kbase = ic_ ? p.KA + (size_t)(ROWS_LAT + b * LCTX + tl_) * 256 + hk * 64 : p.KA + (size_t)(b * TLAT + tl_) * 256 + hk * 64; \
            const bf16_t* vbase = ic_ ? p.VTC + (size_t)(b * 4 + hk) * 64 * LCTX + tl_ : p.VTL + (size_t)(b * 4 + hk) * 64 * TLAT + tl_; \
            const int ldv = ic_ ? LCTX : TLAT; \
            const int r0_ = tid >> 3, r1_ = (tid + 256) >> 3, c8_ = (tid & 7) * 8; \
            kr0 = *(const uint4*)(kbase + (size_t)r0_ * 256 + c8_); vr0 = *(const uint4*)(vbase + (size_t)r0_ * ldv + c8_); \
            kr1 = *(const uint4*)(kbase + (size_t)r1_ * 256 + c8_); vr1 = *(const uint4*)(vbase + (size_t)r1_ * ldv + c8_); } } while (0)
        AT_LOAD(0);
        for (int tile = 0; tile < 9; ++tile) {
            AT_GEOM(tile, isctx, ts, skip);
            __syncthreads();
            if (!skip) {
                const int r0_ = tid >> 3, r1_ = (tid + 256) >> 3, c8_ = (tid & 7) * 8;
                *(uint4*)(Ks + r0_ * AT_ROW + c8_) = kr0; *(uint4*)(Vs + r0_ * AT_ROW + c8_) = vr0;
                *(uint4*)(Ks + r1_ * AT_ROW + c8_) = kr1; *(uint4*)(Vs + r1_ * AT_ROW + c8_) = vr1;
            }
            if (tile + 1 < 9) AT_LOAD(tile + 1);
            __syncthreads();
            if (!skip)
#pragma unroll
            for (int qh = 0; qh < 2; ++qh) {
                f32x4 s[4][2];
#pragma unroll
                for (int kt = 0; kt < 4; ++kt) {
                    const bf16x8 k0 = *(const bf16x8*)(Ks + (kt * 16 + qi) * AT_ROW + 8 * g);
                    const bf16x8 k1 = *(const bf16x8*)(Ks + (kt * 16 + qi) * AT_ROW + 32 + 8 * g);
#pragma unroll
                    for (int q2 = 0; q2 < 2; ++q2) {
                        f32x4 a = (f32x4){0.f, 0.f, 0.f, 0.f};
                        a = __builtin_amdgcn_mfma_f32_16x16x32_bf16(k0, qf[2 * qh + q2][0], a, 0, 0, 0);
                        a = __builtin_amdgcn_mfma_f32_16x16x32_bf16(k1, qf[2 * qh + q2][1], a, 0, 0, 0);
                        s[kt][q2] = a;
                    }
                }
                __builtin_amdgcn_sched_barrier(0);
#pragma unroll
                for (int q2 = 0; q2 < 2; ++q2) {
                    const int qs = 2 * qh + q2;
                    const int qp = q0 + qs * 16 + qi;
                    float tmax = -1e30f;
#pragma unroll
                    for (int kt = 0; kt < 4; ++kt)
#pragma unroll
                        for (int r = 0; r < 4; ++r) {
                            float v = s[kt][q2][r] * LOG2E;
                            if (!isctx) { const int kp = ts + kt * 16 + 4 * g + r; const int dd = qp - kp; if (dd > 128 || dd < -128) v = -1e30f; }
                            s[kt][q2][r] = v; tmax = fmaxf(tmax, v);
                        }
                    tmax = fmaxf(tmax, shx(tmax, 16, lane)); tmax = fmaxf(tmax, shx(tmax, 32, lane));
                    const float mn = fmaxf(mrow[qs], tmax);
                    const float alpha = __builtin_amdgcn_exp2f(mrow[qs] - mn);
                    mrow[qs] = mn;
                    float ls = 0.f;
#pragma unroll
                    for (int kt = 0; kt < 4; ++kt)
#pragma unroll
                        for (int r = 0; r < 4; ++r) { const float pv = __builtin_amdgcn_exp2f(s[kt][q2][r] - mn); s[kt][q2][r] = pv; ls += pv; }
                    lrow[qs] = lrow[qs] * alpha + ls;
#pragma unroll
                    for (int dt = 0; dt < 4; ++dt) o[dt][qs] = o[dt][qs] * alpha;
                }
                __builtin_amdgcn_sched_barrier(0);
#pragma unroll
                for (int kk = 0; kk < 2; ++kk) {
                    bf16x8 pf[2];
#pragma unroll
                    for (int q2 = 0; q2 < 2; ++q2) {
                        uint4 u;
                        u.x = pack2(s[2 * kk][q2][0], s[2 * kk][q2][1]); u.y = pack2(s[2 * kk][q2][2], s[2 * kk][q2][3]);
                        u.z = pack2(s[2 * kk + 1][q2][0], s[2 * kk + 1][q2][1]); u.w = pack2(s[2 * kk + 1][q2][2], s[2 * kk + 1][q2][3]);
                        pf[q2] = *(bf16x8*)&u;
                    }
#pragma unroll
                    for (int dt = 0; dt < 4; ++dt) {
                        const bf16_t* vr = Vs + (dt * 16 + qi) * AT_ROW + 32 * kk + 4 * g;
                        uint4 u; const uint2 lo = *(const uint2*)(vr), hi = *(const uint2*)(vr + 16);
                        u.x = lo.x; u.y = lo.y; u.z = hi.x; u.w = hi.y;
                        const bf16x8 vf = *(bf16x8*)&u;
#pragma unroll
                        for (int q2 = 0; q2 < 2; ++q2) o[dt][2 * qh + q2] = __builtin_amdgcn_mfma_f32_16x16x32_bf16(vf, pf[q2], o[dt][2 * qh + q2], 0, 0, 0);
                    }
                }
            }
        }
#pragma unroll
        for (int qs = 0; qs < 4; ++qs) {
            float l = lrow[qs]; l += shx(l, 16, lane); l += shx(l, 32, lane);
            const float il = 1.f / l;
            bf16_t* op = p.O + (size_t)(b * TLAT + q0 + qs * 16 + qi) * DM + hq * 64 + 4 * g;
#pragma unroll
            for (int dt = 0; dt < 4; ++dt) {
                uint2 u; u.x = pack2(o[dt][qs][0] * il, o[dt][qs][1] * il); u.y = pack2(o[dt][qs][2] * il, o[dt][qs][3] * il);
                *(uint2*)(op + dt * 16) = u;
            }
        }
    }
}

#define N_PHASES 23
#define VLDS (S1_LDS_BYTES)
__global__ void __launch_bounds__(2 * NTHR, 2) mk_forward(Params p_by_value) {
    __shared__ __attribute__((aligned(16))) char lds[2 * VLDS + 64];
    volatile unsigned* bst = (volatile unsigned*)(lds + 2 * VLDS);
    PPtr pp = (PPtr)__builtin_amdgcn_kernarg_segment_ptr();
    const int ph_lo = pp->ph_lo, ph_hi = pp->ph_hi;
    const int wave_s = __builtin_amdgcn_readfirstlane((int)threadIdx.x >> 6);
    const bool multi = ph_hi > ph_lo;
    if (multi) {
        if (threadIdx.x == 0) { bst[0] = 0u; bst[1] = 0u; }
        __syncthreads();
        (void)xcd_barrier_post(pp->bar, bst);
    }
    bool dup_done = false; (void)dup_done;
    for (int ph = ph_lo; ph <= ph_hi; ++ph) {
#ifdef ONLY_PH
        if (ph != ONLY_PH) continue;
#endif
        if (ph == 4 || ph == 8) continue;
        PPtr q = pp; asm volatile("" : "+s"(q));
        PRef p = *q;
#define LDSP (lds + (wave_s >> 2) * VLDS + fresh_zero())
#define MKPX(name) Ctx name; name.tid = wave_s * 64 + fresh_lane(); name.bid = blockIdx.x; name.nb = gridDim.x; asm volatile("" : "+v"(name.tid), "+s"(name.bid), "+s"(name.nb))
#define MKCX(name) Ctx name; name.tid = (wave_s & 3) * 64 + fresh_lane(); name.bid = blockIdx.x * 2 + (wave_s >> 2); name.nb = gridDim.x * 2; asm volatile("" : "+v"(name.tid), "+s"(name.bid), "+s"(name.nb)); int lz2_ = 0; asm volatile("" : "+v"(lz2_)); char* ldsy = lds + (wave_s >> 2) * VLDS + lz2_
        switch (ph) {
            case 0: { MKCX(cx);  ph_ada(cx, p, LDSP); } break;
            case 1: { MKCX(cx);  ph_pre0(cx, p); } break;
            case 2: { MKPX(px);  { ProbRKV pr; pr.p = q; pr.K = 1024; pr.c = px.bid; pr.G = px.nb; { int z8 = 0; asm volatile("" : "+v"(z8)); gemm8(px, lds + z8, pr); } MKCX(cy); ph_g1(cy, p, ldsy); } } break;
            case 3: { MKCX(cx);  ph_g2(cx, p, LDSP); } break;
            case 4: { MKCX(cx);  ph_prep(cx, p); } break;
            case 5: { MKCX(cx);  ph_s1(cx, p, LDSP); } break;
            case 6: { MKPX(px); MKCX(cx);  ph_s2(px, cx, p, LDSP, lds + fresh_zero()); } break;
            case 7: { MKCX(cx);  ph_s3o(cx, p); } break;
            case 9: case 17: {
                const bool l1 = ph == 17; MKPX(px);
                {
                    ProbOproj pr; pr.A = l1 ? p.O : p.G; pr.Wt = l1 ? p.atwoT : p.woT; pr.out = p.PRE; pr.xl = l1 ? p.X1 : p.x; pr.modl = l1 ? p.modv + 3 * 6144 : p.modv; pr.K = 1024; pr.c = px.bid; pr.G = px.nb;
                    { int z8 = 0; asm volatile("" : "+v"(z8)); gemm8(px, lds + z8, pr); }
                }
                if (!l1) { MKCX(cy); ph_oproj(cy, p, ldsy, p.G, p.woT, p.x, p.ctx, p.modv, 128, 4); }
            } break;
            case 10: case 18: { MKCX(cx); ph_ln_router(cx, p, ph == 18 ? 1 : 0, ph == 18 ? ROWS_LAT : ROWS); } break;
            case 11: case 19: { MKCX(cx); ph_topk(cx, p, ph == 19 ? 1 : 0, LDSP); } break;
            case 12: case 20: { MKPX(px); { ProbUp pr; pr.p = q; pr.K = 1024; pr.c = px.bid; pr.G = px.nb; pr.layer = ph == 20 ? 1 : 0; { int z8 = 0; asm volatile("" : "+v"(z8)); gemm8(px, lds + z8, pr); } MKCX(cy); ph_moe_up(cy, p, ph == 20 ? 1 : 0, ldsy); } } break;
            case 13: case 21: { MKPX(px); { ProbDown pr; pr.p = q; pr.K = 2048; pr.c = px.bid; pr.G = px.nb; pr.layer = ph == 21 ? 1 : 0; { int z8 = 0; asm volatile("" : "+v"(z8)); gemm8(px, lds + z8, pr); } MKCX(cy); ph_moe_down(cy, p, ph == 21 ? 1 : 0, ldsy); } } break;
            case 14: case 22: { MKCX(cx); ph_combine(cx, p, ph == 22 ? 1 : 0, ph == 22 ? ROWS_LAT : ROWS); } break;
            case 15: { MKPX(px);  { ProbQKV pr; pr.p = q; pr.K = 1024; pr.c = px.bid; pr.G = px.nb; { int z8 = 0; asm volatile("" : "+v"(z8)); gemm8(px, lds + z8, pr); } MKCX(cy); ph_qkv(cy, p, ldsy); } } break;
            case 16: { MKCX(cx);  ph_attn(cx, p, LDSP); } break;
        }
#ifdef DUP_MASK
        if (((DUP_MASK >> ph) & 1u) && !dup_done) { dup_done = true; --ph; } else dup_done = false;
        if (ph + 1 <= ph_hi && (ph < ph_hi)) {
#else
        if (ph < ph_hi) {
#endif
            if (ph == ph_lo && q->bar == nullptr) cg::this_grid().sync();
            { XcdBarrier xb2; xb2.bar = q->bar; xb2.x = xb_xcc_id(); int lz3 = 0; asm volatile("" : "+v"(lz3)); xb2.st = (volatile unsigned*)(lds + 2 * VLDS + lz3); asm volatile("" : "+s"(xb2.x)); xcd_barrier(xb2); }
        }
    }
}

extern "C" void kernel_launch(void* const* d_in, const int* in_sizes, int n_in, void* d_out, int out_size, void* d_ws, size_t ws_size, hipStream_t stream) {
    Params p{};
    const float** f = (const float**)d_in;
    p.x = f[0]; p.c = f[1]; p.ctx = f[2]; p.c_ctx = f[3]; p.ada_w = f[4]; p.ada_b = f[5]; p.ln1_g = f[6]; p.ln1_b = f[7]; p.ln2_g = f[8]; p.ln2_b = f[9];
    p.rw_mu = f[10]; p.rw_wr = f[11]; p.rw_wk = f[12]; p.rw_wv = f[13]; p.rw_w0 = f[14]; p.rw_w1 = f[15]; p.rw_w2 = f[16]; p.rw_a0 = f[17]; p.rw_a1 = f[18]; p.rw_a2 = f[19];
    p.rw_g1 = f[20]; p.rw_g2 = f[21]; p.rw_kk = f[22]; p.rw_ka = f[23]; p.rw_rk = f[24]; p.rw_lnx_g = f[25]; p.rw_lnx_b = f[26]; p.rw_wo = f[27];
    p.at_wqkv = f[28]; p.at_wo = f[29]; p.at_sink = f[30]; p.router_w = f[31]; p.moe_w_gate = f[32]; p.moe_w_up = f[33]; p.moe_w_down = f[34];
    p.out = (float*)d_out;
    char* ws = (char*)d_ws; size_t off = 0;
    auto take = [&](size_t bytes) { char* r = ws + off; off += (bytes + 255) & ~(size_t)255; return r; };
    const size_t U = (size_t)ROWS * DM * 2;
    p.bar = (unsigned*)take(16384);
    p.modv = (float*)take(2 * 3 * 6144 * 4);
    p.modp = (float*)take((size_t)16 * 2 * 3 * 6144 * 4);
    p.rope = (float*)take(128 * 16 * 2 * 4);
    p.afft = (float*)take((size_t)16 * ROWS * 4);
    p.inv = (int*)take((size_t)ROWS * 16 * 4);
    p.idx = (int*)take(16 * MPAD0 * 4);
    p.gate = (float*)take(16 * MPAD0 * 4);
    p.wrT = (bf16_t*)take(2097152); p.wkT = (bf16_t*)take(2097152); p.wvT = (bf16_t*)take(2097152); p.woT = (bf16_t*)take(2097152);
    p.l1T = (bf16_t*)take(384 * 1024 * 2); p.g2T = (bf16_t*)take(1024 * 128 * 2); p.w2T = (bf16_t*)take(2 * 65536 * 2); p.a2T = (bf16_t*)take(2 * 65536 * 2);
    p.wqkvT = (bf16_t*)take(1536 * 1024 * 2); p.atwoT = (bf16_t*)take(2097152);
    char* base = take(30 * U);
    char* RA = base, *RB = base + 12 * U, *RC = base + 20 * U, *RD = base + 23 * U, *RE = base + 25 * U, *RF = base + 26 * U;
    p.XM = (bf16_t*)RA;
    p.W0 = (bf16_t*)RA; p.W1 = (bf16_t*)(RA + 2 * U); p.AD0 = (bf16_t*)(RA + 4 * U); p.AD1 = (bf16_t*)(RA + 5 * U); p.KK = (bf16_t*)(RA + 6 * U);
    p.CW = (bf16_t*)RA;
    p.CM = (bf16_t*)RB; p.CN = (bf16_t*)(RB + 2 * U); p.CR = (bf16_t*)(RB + 4 * U); p.CY = (bf16_t*)(RB + 6 * U);
    p.HMID = (bf16_t*)RB; p.YE = (bf16_t*)(RB + (size_t)16 * MPAD0 * 2048 * 2);
    p.R = (bf16_t*)RC; p.K = (bf16_t*)(RC + U); p.V = (bf16_t*)(RC + 2 * U);
    p.Q = (bf16_t*)RC; p.O = (bf16_t*)(RC + (size_t)ROWS_LAT * DM * 2); p.KA = (bf16_t*)(RC + (size_t)2 * ROWS_LAT * DM * 2);
    p.VTL = p.KA + (size_t)ROWS * 256; p.VTC = p.VTL + (size_t)2 * 4 * 64 * TLAT;
    p.LH = (bf16_t*)RD; p.CS = (bf16_t*)RD; p.H2 = (bf16_t*)RD; p.HB = (bf16_t*)(RD + U);
    p.G = (bf16_t*)RE;
    p.Y0 = (float*)RF; p.Y1 = (float*)(RF + 2 * U); p.PRE = (float*)RF; p.X1 = (float*)(RF + 2 * U);
    p.XXB = nullptr;
    if (off > ws_size) fprintf(stderr, "workspace too small: need %zu have %zu\n", off, ws_size);

    static int grid_blocks = 0;
    if (!grid_blocks) {
        int dev = 0, cus = 0, per_cu = 0;
        hipGetDevice(&dev);
        hipDeviceGetAttribute(&cus, hipDeviceAttributeMultiprocessorCount, dev);
        hipOccupancyMaxActiveBlocksPerMultiprocessor(&per_cu, mk_forward, 2 * NTHR, 0);
        if (per_cu > 1) per_cu = 1;
        if (per_cu < 1) per_cu = 1;
        grid_blocks = cus * per_cu;
    }
#if MK_SINGLE
    hipMemsetAsync(p.bar, 0, 16384, stream);
    p.ph_lo = 0; p.ph_hi = N_PHASES - 1;
    void* args[] = {&p};
    hipError_t e = hipLaunchCooperativeKernel((void*)mk_forward, dim3(grid_blocks), dim3(2 * NTHR), args, 0, stream);
    if (e != hipSuccess) fprintf(stderr, "cooperative launch failed: %s (grid %d)\n", hipGetErrorString(e), grid_blocks);
#else
    for (int ph = 0; ph < N_PHASES; ++ph) {
        p.ph_lo = ph; p.ph_hi = ph;
        hipLaunchKernelGGL(mk_forward, dim3(grid_blocks), dim3(2 * NTHR), 0, stream, p);
    }
#endif
}
```

```cpp
#include <hip/hip_runtime.h>
#include <hip/hip_cooperative_groups.h>
#include <cstdio>
#include <cstdint>
namespace cg = cooperative_groups;

#ifndef MK_SINGLE
#define MK_SINGLE 1
#endif

typedef short bf16x8 __attribute__((ext_vector_type(8)));
typedef float f32x4 __attribute__((ext_vector_type(4)));
typedef unsigned short bf16_t;

#define DM 1024
#define TLAT 8192
#define LCTX 256
#define ROWS_LAT 16384
#define ROWS_CTX 512
#define ROWS 16896
#define NTHR 256
#define ALPHA_F 1.41421356237f
#define MPAD0 2176
#define MPAD1 2048

struct Params {
    const float *x, *c, *ctx, *c_ctx, *ada_w, *ada_b, *ln1_g, *ln1_b, *ln2_g, *ln2_b;
    const float *rw_mu, *rw_wr, *rw_wk, *rw_wv, *rw_w0, *rw_w1, *rw_w2, *rw_a0, *rw_a1, *rw_a2, *rw_g1, *rw_g2;
    const float *rw_kk, *rw_ka, *rw_rk, *rw_lnx_g, *rw_lnx_b, *rw_wo;
    const float *at_wqkv, *at_wo, *at_sink, *router_w, *moe_w_gate, *moe_w_up, *moe_w_down;
    float* out;
    unsigned* bar;
    float* modv;
    float* modp;
    float* rope;
    float* afft;
    int* inv;
    int* idx;
    float* gate;
    float* X1;
    float* PRE;
    bf16_t* HB;
    bf16_t* XXB;
    bf16_t* H2;
    bf16_t *R, *K, *V;
    float *KK, *W0, *W1;
    bf16_t *AD0, *AD1;
    bf16_t *CM, *CN, *CR, *CY, *CS;
    bf16_t* G;
    bf16_t* LH;
    float *Y0, *Y1;
    bf16_t* HMID;
    bf16_t* YE;
    bf16_t *Q, *KA, *VTL, *VTC, *O;
    bf16_t* XM;
    bf16_t *wrT, *wkT, *wvT, *woT, *l1T, *g2T, *w2T, *a2T, *wqkvT, *atwoT;
    bf16_t* CW;
    int ph_lo, ph_hi;
};

struct Ctx { int tid, bid, nb; };
typedef const __attribute__((address_space(4))) Params& PRef;
typedef const __attribute__((address_space(4))) Params* PPtr;
__device__ __forceinline__ unsigned short f2bf(float f) { return __builtin_bit_cast(unsigned short, (__bf16)f); }
__device__ __forceinline__ unsigned pack2(float lo, float hi) { typedef __bf16 bf2_t __attribute__((ext_vector_type(2))); bf2_t v; v[0] = (__bf16)lo; v[1] = (__bf16)hi; return __builtin_bit_cast(unsigned, v); }
__device__ __forceinline__ float bflo(unsigned u) { return __uint_as_float(u << 16); }
__device__ __forceinline__ float bfhi(unsigned u) { return __uint_as_float(u & 0xffff0000u); }
__device__ __forceinline__ float sigmoidf_(float v) { return __builtin_amdgcn_rcpf(1.f + __expf(-v)); }
__device__ __forceinline__ float shx(float v, int o, int lane) { return __int_as_float(__builtin_amdgcn_ds_bpermute((lane ^ o) << 2, __float_as_int(v))); }
__device__ __forceinline__ int shxi(int v, int o, int lane) { return __builtin_amdgcn_ds_bpermute((lane ^ o) << 2, v); }
__device__ __forceinline__ int shidx(int v, int src) { return __builtin_amdgcn_ds_bpermute(src << 2, v); }
__device__ __forceinline__ float wsum_l(float v, int lane) {
#pragma unroll
    for (int o = 32; o > 0; o >>= 1) v += shx(v, o, lane);
    return v;
}
#define wsum(v) wsum_l((v), lane)
__device__ __forceinline__ int mod_of_row(int row) { return row < ROWS_LAT ? (row >> 13) : 2; }
__device__ __forceinline__ const float* xin_row(PRef p, int row) {
    return row < ROWS_LAT ? p.x + (size_t)row * DM : p.ctx + (size_t)(row - ROWS_LAT) * DM;
}

#define XB_TMO      128
#define XB_XCNT(j)  (256  + 64 * (j))
#define XB_XSUB(j)  (1280 + 64 * (j))
#define XB_XGEN(j)  (2304 + 64 * (j))
#define XB_TOP      3328
#define XB_TOPGEN   3392
#define XCD_BAR_WORDS 3456
#define XB_SPIN_CAP (1u << 22)
#define LAS __attribute__((address_space(3)))
__device__ __forceinline__ unsigned xb_ld(unsigned* p)              { return __hip_atomic_load(p, __ATOMIC_RELAXED, __HIP_MEMORY_SCOPE_AGENT); }
__device__ __forceinline__ unsigned xb_add(unsigned* p, unsigned v) { return __hip_atomic_fetch_add(p, v, __ATOMIC_RELAXED, __HIP_MEMORY_SCOPE_AGENT); }
__device__ __forceinline__ unsigned xb_xcc_id() { return (unsigned)__builtin_amdgcn_s_getreg((3 << 11) | 20) & 0xFu; }
#define XB_SPIN(cond, bar) do { unsigned _sp = 0; while (cond) { __builtin_amdgcn_s_sleep(1); \
    if ((++_sp & 255u) == 0u) { if (xb_ld(&(bar)[XB_TMO])) break; if (_sp > XB_SPIN_CAP) { atomicAdd(&(bar)[XB_TMO], 1u); break; } } } } while (0)
struct XcdBarrier { unsigned* bar; unsigned x; volatile unsigned* st; };
__device__ __forceinline__ XcdBarrier xcd_barrier_post(unsigned* bar, volatile unsigned* st) {
    XcdBarrier b; b.bar = bar; b.x = xb_xcc_id(); b.st = st;
    if (threadIdx.x == 0) (void)xb_add(&bar[XB_XCNT(b.x)], 1u);
    return b;
}
__device__ __forceinline__ void xcd_barrier_complete(unsigned* bar, unsigned x, unsigned& nloc, unsigned& nx) {
    const unsigned G = gridDim.x * gridDim.y * gridDim.z;
    unsigned sum, cnt, mine, sp = 0u;
    for (;;) {
        sum = 0u; cnt = 0u; mine = 0u;
#pragma unroll
        for (unsigned j = 0; j < 16; ++j) { const unsigned c = xb_ld(&bar[XB_XCNT(j)]); sum += c; cnt += (c > 0u) ? 1u : 0u; }
        mine = xb_ld(&bar[XB_XCNT(x)]);
        if (sum == G) break;
        __builtin_amdgcn_s_sleep(1);
        if ((++sp & 255u) == 0u) { if (xb_ld(&bar[XB_TMO])) break; if (sp > XB_SPIN_CAP) { atomicAdd(&bar[XB_TMO], 1u); break; } }
    }
    nloc = mine > 0u ? mine : 1u; nx = cnt > 0u ? cnt : 1u;
}
__device__ __forceinline__ void xcd_barrier(const XcdBarrier& b) {
    asm volatile("s_waitcnt vmcnt(0)" ::: "memory");
    __syncthreads();
    if (threadIdx.x == 0) {
        unsigned* bar = b.bar;
        __builtin_amdgcn_s_waitcnt(0);
        unsigned nloc = b.st[0], nx = b.st[1];
        if (nloc == 0u) { xcd_barrier_complete(bar, b.x, nloc, nx); b.st[0] = nloc; b.st[1] = nx; }
        const unsigned old = xb_add(&bar[XB_XSUB(b.x)], 1u);
        const unsigned gen = old / nloc;
        if (old + 1u == (gen + 1u) * nloc) {
            __builtin_amdgcn_fence(__ATOMIC_RELEASE, "agent");
            asm volatile("s_waitcnt vmcnt(0)" ::: "memory");
            const unsigned og = xb_add(&bar[XB_TOP], 1u);
            const unsigned tg = og / nx;
            if (og + 1u == (tg + 1u) * nx) xb_add(&bar[XB_TOPGEN], 1u);
            else XB_SPIN(xb_ld(&bar[XB_TOPGEN]) == tg, bar);
            __builtin_amdgcn_fence(__ATOMIC_ACQUIRE, "agent");
            xb_add(&bar[XB_XGEN(b.x)], 1u);
            asm volatile("s_waitcnt vmcnt(0)" ::: "memory");
        } else {
            XB_SPIN(xb_ld(&bar[XB_XGEN(b.x)]) == gen, bar);
            __builtin_amdgcn_fence(__ATOMIC_ACQUIRE, "agent");
            asm volatile("s_waitcnt vmcnt(0)" ::: "memory");
        }
    }
    __syncthreads();
}

#define G_BK 32
#define G_LDSROW 40
#define G_BUFB (128 * G_LDSROW * 2)
#define G_LDS_BYTES (4 * G_BUFB)

struct ALBf16 {
    struct Raw { uint4 a, b; };
    const bf16_t* rowp;
    __device__ __forceinline__ Raw ld(int k) const { Raw r; r.a = *(const uint4*)(rowp + k); r.b = *(const uint4*)(rowp + k + 8); return r; }
    __device__ __forceinline__ void cvt(const Raw& r, int k, uint4& lo, uint4& hi) const { lo = r.a; hi = r.b; }
};
struct ALMix {
    struct Raw { uint4 h0, h1, x0, x1; };
    const bf16_t *hp, *xp; const float* mu;
    __device__ __forceinline__ Raw ld(int k) const { Raw r; r.h0 = *(const uint4*)(hp + k); r.h1 = *(const uint4*)(hp + k + 8); r.x0 = *(const uint4*)(xp + k); r.x1 = *(const uint4*)(xp + k + 8); return r; }
    __device__ __forceinline__ unsigned mix2(unsigned h, unsigned x, float m0, float m1) const { return pack2(bflo(h) + bflo(x) * m0, bfhi(h) + bfhi(x) * m1); }
    __device__ __forceinline__ void cvt(const Raw& r, int k, uint4& lo, uint4& hi) const {
        const float4 m0 = *(const float4*)(mu + k), m1 = *(const float4*)(mu + k + 4), m2 = *(const float4*)(mu + k + 8), m3 = *(const float4*)(mu + k + 12);
        lo.x = mix2(r.h0.x, r.x0.x, m0.x, m0.y); lo.y = mix2(r.h0.y, r.x0.y, m0.z, m0.w); lo.z = mix2(r.h0.z, r.x0.z, m1.x, m1.y); lo.w = mix2(r.h0.w, r.x0.w, m1.z, m1.w);
        hi.x = mix2(r.h1.x, r.x1.x, m2.x, m2.y); hi.y = mix2(r.h1.y, r.x1.y, m2.z, m2.w); hi.z = mix2(r.h1.z, r.x1.z, m3.x, m3.y); hi.w = mix2(r.h1.w, r.x1.w, m3.z, m3.w);
    }
};

template <class AL, class EPI>
__device__ __forceinline__ void gemm_tile(const Ctx cx, const AL& al, const float* bp  , int ldb, int K, const EPI& epi, char* lds) {
    const int tid = cx.tid, lane = tid & 63, wid = tid >> 6, wr = wid >> 1, wc = wid & 1, fr = lane & 15, fq = lane >> 4;
    const int arow = tid >> 1, akq = (tid & 1) * 16;
    const int bn4 = (tid & 31) * 4, bk4 = (tid >> 5) * 4;
    f32x4 acc[4][4];
#pragma unroll
    for (int i = 0; i < 4; ++i)
#pragma unroll
        for (int j = 0; j < 4; ++j) acc[i][j] = (f32x4){0.f, 0.f, 0.f, 0.f};
    const int nk = K / G_BK;
    typename AL::Raw ra; float4 rb0, rb1, rb2, rb3;
    auto ldB = [&](int k0) {
        const float* q = bp + (size_t)(k0 + bk4) * ldb;
        rb0 = *(const float4*)(q); rb1 = *(const float4*)(q + ldb); rb2 = *(const float4*)(q + 2 * (size_t)ldb); rb3 = *(const float4*)(q + 3 * (size_t)ldb);
    };
    auto stage = [&](int buf, int k0) {
        char* As = lds + buf * 2 * G_BUFB; char* Bs = As + G_BUFB;
        uint4 lo, hi; al.cvt(ra, k0 + akq, lo, hi);
        *(uint4*)(As + arow * (G_LDSROW * 2) + akq * 2) = lo;
        *(uint4*)(As + arow * (G_LDSROW * 2) + akq * 2 + 16) = hi;
        uint2 w;
        w.x = pack2(rb0.x, rb1.x); w.y = pack2(rb2.x, rb3.x); *(uint2*)(Bs + (bn4 + 0) * (G_LDSROW * 2) + bk4 * 2) = w;
        w.x = pack2(rb0.y, rb1.y); w.y = pack2(rb2.y, rb3.y); *(uint2*)(Bs + (bn4 + 1) * (G_LDSROW * 2) + bk4 * 2) = w;
        w.x = pack2(rb0.z, rb1.z); w.y = pack2(rb2.z, rb3.z); *(uint2*)(Bs + (bn4 + 2) * (G_LDSROW * 2) + bk4 * 2) = w;
        w.x = pack2(rb0.w, rb1.w); w.y = pack2(rb2.w, rb3.w); *(uint2*)(Bs + (bn4 + 3) * (G_LDSROW * 2) + bk4 * 2) = w;
    };
    ra = al.ld(akq); ldB(0);
    stage(0, 0);
    __syncthreads();
    for (int kt = 0; kt < nk; ++kt) {
        const bool more = (kt + 1 < nk);
        if (more) { ra = al.ld((kt + 1) * G_BK + akq); ldB((kt + 1) * G_BK); }
        const char* As = lds + (kt & 1) * 2 * G_BUFB; const char* Bs = As + G_BUFB;
        bf16x8 af[4], bfr[4];
#pragma unroll
        for (int i = 0; i < 4; ++i) {
            af[i] = *(const bf16x8*)(As + (wr * 64 + i * 16 + fr) * (G_LDSROW * 2) + fq * 16);
            bfr[i] = *(const bf16x8*)(Bs + (wc * 64 + i * 16 + fr) * (G_LDSROW * 2) + fq * 16);
        }
#pragma unroll
        for (int i = 0; i < 4; ++i)
#pragma unroll
            for (int j = 0; j < 4; ++j) acc[i][j] = __builtin_amdgcn_mfma_f32_16x16x32_bf16(bfr[j], af[i], acc[i][j], 0, 0, 0);
        if (more) stage((kt + 1) & 1, (kt + 1) * G_BK);
        __syncthreads();
    }
    epi(acc, wr, wc, fr, fq);
}

#define G2_STAGE 32768
__device__ __forceinline__ void glds16(const bf16_t* g, char* l) {
    __builtin_amdgcn_global_load_lds((const unsigned*)g, (__attribute__((address_space(3))) unsigned*)l, 16, 0, 0);
}
template <class EPI>
__device__ __forceinline__ void gemm2_tile(const Ctx cx, const bf16_t* a0, const bf16_t* a1, const bf16_t* a2, const bf16_t* a3,
                                           const bf16_t* b0, const bf16_t* b1, const bf16_t* b2, const bf16_t* b3, int K, const EPI& epi, char* lds) {
    const int tid = cx.tid, lane = tid & 63, wid = __builtin_amdgcn_readfirstlane(tid >> 6), wr = wid >> 1, wc = wid & 1, fr = lane & 15, fq = lane >> 4;
    f32x4 acc[4][4];
#pragma unroll
    for (int i = 0; i < 4; ++i)
#pragma unroll
        for (int j = 0; j < 4; ++j) acc[i][j] = (f32x4){0.f, 0.f, 0.f, 0.f};
    const int nk = K >> 6;
    auto issue = [&](int kt, int st) {
        char* sa = lds + st * G2_STAGE + wid * 1024;
        const int ko = kt * 64;
        glds16(a0 + ko, sa); glds16(a1 + ko, sa + 4096); glds16(a2 + ko, sa + 8192); glds16(a3 + ko, sa + 12288);
        glds16(b0 + ko, sa + 16384); glds16(b1 + ko, sa + 20480); glds16(b2 + ko, sa + 24576); glds16(b3 + ko, sa + 28672);
    };
    issue(0, 0);
    asm volatile("s_waitcnt vmcnt(0)" ::: "memory");
    __builtin_amdgcn_s_barrier();
    for (int kt = 0; kt < nk; ++kt) {
        if (kt + 1 < nk) issue(kt + 1, (kt + 1) & 1);
        const char* As = lds + (kt & 1) * G2_STAGE; const char* Bs = As + 16384;
#pragma unroll
        for (int ks = 0; ks < 2; ++ks) {
            const int co = ((ks * 4 + fq) ^ (fr & 7)) << 4;
            bf16x8 af[4], bfr[4];
#pragma unroll
            for (int i = 0; i < 4; ++i) {
                af[i] = *(const bf16x8*)(As + (wr * 64 + i * 16 + fr) * 128 + co);
                bfr[i] = *(const bf16x8*)(Bs + (wc * 64 + i * 16 + fr) * 128 + co);
            }
#pragma unroll
            for (int i = 0; i < 4; ++i)
#pragma unroll
                for (int j = 0; j < 4; ++j) acc[i][j] = __builtin_amdgcn_mfma_f32_16x16x32_bf16(bfr[j], af[i], acc[i][j], 0, 0, 0);
        }
        asm volatile("s_waitcnt vmcnt(0) lgkmcnt(0)" ::: "memory");
        __builtin_amdgcn_s_barrier();
    }
    epi(acc, wr, wc, fr, fq);
}
#define G3_STAGE 16384
#define G3_H(q) ((0x1320 >> (4 * (q))) & 3)
#define G3_ROW(i) ((i) * 64 + (cx.tid >> 2))
#define G3_CH8 ((((cx.tid) & 3) ^ G3_H(((cx.tid) >> 4) & 3)) * 8)
struct G3Next { bool has; const bf16_t *a0, *a1, *b0, *b1; int K; };
template <class EPI>
__device__ __forceinline__ void gemm3_tile(const Ctx cx, const bf16_t* a0, const bf16_t* a1, const bf16_t* b0, const bf16_t* b1, int K, const EPI& epi, char* lds, bool pre = false, G3Next nx = G3Next{false, nullptr, nullptr, nullptr, nullptr, 0}) {
    const int tid = cx.tid, lane = tid & 63, wid = __builtin_amdgcn_readfirstlane(tid >> 6), wr = wid >> 1, wc = wid & 1, fr = lane & 15, fq = lane >> 4;
    f32x4 acc[4][4];
#pragma unroll
    for (int i = 0; i < 4; ++i)
#pragma unroll
        for (int j = 0; j < 4; ++j) acc[i][j] = (f32x4){0.f, 0.f, 0.f, 0.f};
    const int nk = K >> 5;
    auto issue = [&](int kt) {
        char* sa = lds + (kt & 3) * G3_STAGE + wid * 1024;
        const int ko = kt * 32;
        glds16(a0 + ko, sa); glds16(a1 + ko, sa + 4096); glds16(b0 + ko, sa + 8192); glds16(b1 + ko, sa + 12288);
    };
    if (!pre) { issue(0); if (nk > 1) issue(1); if (nk > 2) issue(2); }
    else asm volatile("s_waitcnt vmcnt(0)" ::: "memory");
    const int co = (fq ^ G3_H((fr >> 2) & 3)) << 4;
    for (int kt = 0; kt < nk; ++kt) {
        if (kt + 2 < nk) asm volatile("s_waitcnt vmcnt(8)" ::: "memory");
        else if (kt + 1 < nk) asm volatile("s_waitcnt vmcnt(4)" ::: "memory");
        else asm volatile("s_waitcnt vmcnt(0)" ::: "memory");
        asm volatile("s_waitcnt lgkmcnt(0)" ::: "memory");
        __builtin_amdgcn_s_barrier();
        if (kt + 3 < nk) issue(kt + 3);
        const char* As = lds + (kt & 3) * G3_STAGE; const char* Bs = As + 8192;
        bf16x8 af[4], bfr[4];
#pragma unroll
        for (int i = 0; i < 4; ++i) {
            af[i] = *(const bf16x8*)(As + (wr * 64 + i * 16 + fr) * 64 + co);
            bfr[i] = *(const bf16x8*)(Bs + (wc * 64 + i * 16 + fr) * 64 + co);
        }
#pragma unroll
        for (int i = 0; i < 4; ++i)
#pragma unroll
            for (int j = 0; j < 4; ++j) acc[i][j] = __builtin_amdgcn_mfma_f32_16x16x32_bf16(bfr[j], af[i], acc[i][j], 0, 0, 0);
    }
    asm volatile("s_waitcnt lgkmcnt(0)" ::: "memory");
    __builtin_amdgcn_s_barrier();
    if (nx.has) {
        const int nkn = nx.K >> 5;
#pragma unroll
        for (int st = 0; st < 3; ++st) if (st < nkn) {
            char* sa = lds + st * G3_STAGE + wid * 1024; const int ko = st * 32;
            glds16(nx.a0 + ko, sa); glds16(nx.a1 + ko, sa + 4096); glds16(nx.b0 + ko, sa + 8192); glds16(nx.b1 + ko, sa + 12288);
        }
    }
    epi(acc, wr, wc, fr, fq);
}
#define G8_HTB 16384
typedef __attribute__((address_space(3))) unsigned char* G8LP;
__device__ __forceinline__ int g8_lds_byte(int r, int c) { const int st = (r >> 4) * 2 + (c >> 5), rr = r & 15, cc = c & 31, ob = rr * 64 + cc * 2; return st * 1024 + (ob ^ (((ob >> 9) & 1) << 5)); }
__device__ __forceinline__ void g8_stage_rc(int b, int& R, int& C) { const int st = b / 1024, sb = b % 1024, swz = sb ^ (((sb >> 9) & 1) << 5); R = (st >> 1) * 16 + swz / 64; C = (st & 1) * 32 + (swz % 64) / 2; }
struct Unit8 { int pm, pn, e; };
__device__ __forceinline__ int fresh_zero() { int z = 0; asm volatile("" : "+v"(z)); return z; }
__device__ __forceinline__ int fresh_lane() { int l; asm volatile("v_mbcnt_lo_u32_b32 %0, -1, 0\n\tv_mbcnt_hi_u32_b32 %0, -1, %0" : "=v"(l)); return l; }
template <class P>
__device__ __forceinline__ void gemm8(const Ctx px, char* ldsg, const P& prob) {
    G8LP lds = (G8LP)ldsg;
    const int tid = px.tid, wid = __builtin_amdgcn_readfirstlane(tid >> 6), lane = tid & 63, wr = wid >> 2, wc = wid & 3, fr = lane & 15, fq = lane >> 4;
    const int nt = prob.K / 64;
    int R0, C0, R1, C1; g8_stage_rc(tid * 16, R0, C0); g8_stage_rc(tid * 16 + 8192, R1, C1);
    Unit8 cur, nxt; int ui = 0;
    if (!prob.next(0, cur)) return;
    unsigned cA[2][2], cB[2][2], nA[2][2], nB[2][2];
#define G8_OFFS(u, oa, ob) do { _Pragma("unroll") for (int h_ = 0; h_ < 2; ++h_) { \
        oa[h_][0] = prob.offA(u, h_ * 128 + R0) + (unsigned)C0 * 2u; oa[h_][1] = prob.offA(u, h_ * 128 + R1) + (unsigned)C1 * 2u; \
        ob[h_][0] = prob.offB(u, h_ * 128 + R0) + (unsigned)C0 * 2u; ob[h_][1] = prob.offB(u, h_ * 128 + R1) + (unsigned)C1 * 2u; } } while (0)
    G8_OFFS(cur, cA, cB);
    const char* bAc = prob.baseA(cur); const char* bBc = prob.baseB(cur);
    const unsigned ldsw = (unsigned)wid * 1024u;
    const int aoff = g8_lds_byte(wr * 64 + fr, fq * 8), boff = g8_lds_byte(wc * 32 + fr, fq * 8);
#define G8_SA(b, h) (((b) * 2 + (h)) * G8_HTB)
#define G8_SB(b, h) ((4 + (b) * 2 + (h)) * G8_HTB)
#define G8_STAGE(bufoff, gbase, voff, kb) do { _Pragma("unroll") for (int _i = 0; _i < 2; ++_i) \
        __builtin_amdgcn_global_load_lds((const unsigned*)((gbase) + (size_t)((voff)[_i] + (unsigned)(kb))), (__attribute__((address_space(3))) unsigned*)(lds + (bufoff) + ldsw + _i * 8192), 16, 0, 0); } while (0)
#define G8_LDA(dst, b, h) do { _Pragma("unroll") for (int m = 0; m < 4; ++m) _Pragma("unroll") for (int k = 0; k < 2; ++k) dst[m][k] = *(const __attribute__((address_space(3))) bf16x8*)(lds + G8_SA(b, h) + aoff + m * 2048 + k * 1024); } while (0)
#define G8_LDB(dst, b, h) do { _Pragma("unroll") for (int n = 0; n < 2; ++n) _Pragma("unroll") for (int k = 0; k < 2; ++k) dst[n][k] = *(const __attribute__((address_space(3))) bf16x8*)(lds + G8_SB(b, h) + boff + n * 2048 + k * 1024); } while (0)
#define G8_MMA(ai, bj, At, Bt) do { __builtin_amdgcn_s_setprio(1); _Pragma("unroll") for (int m = 0; m < 4; ++m) _Pragma("unroll") for (int n = 0; n < 2; ++n) _Pragma("unroll") for (int k = 0; k < 2; ++k) \
        acc[ai][bj][m][n] = __builtin_amdgcn_mfma_f32_16x16x32_bf16(Bt[n][k], At[m][k], acc[ai][bj][m][n], 0, 0, 0); __builtin_amdgcn_s_setprio(0); } while (0)
#define G8_WAIT_V(n) asm volatile("s_waitcnt vmcnt(" #n ")" ::: "memory")
#define G8_WAIT_L(n) asm volatile("s_waitcnt lgkmcnt(" #n ")" ::: "memory")
#define G8_BAR __builtin_amdgcn_s_barrier()
#define G8_SCHED __builtin_amdgcn_sched_barrier(0)
    f32x4 acc[2][2][4][2];
#pragma unroll
    for (int a = 0; a < 2; ++a)
#pragma unroll
        for (int b = 0; b < 2; ++b)
#pragma unroll
            for (int m = 0; m < 4; ++m)
#pragma unroll
                for (int n = 0; n < 2; ++n) acc[a][b][m][n] = (f32x4){0.f, 0.f, 0.f, 0.f};
    bf16x8 At[4][2], B0[2][2], B1[2][2];
    G8_STAGE(G8_SB(0, 0), bBc, cB[0], 0); G8_STAGE(G8_SA(0, 0), bAc, cA[0], 0); G8_STAGE(G8_SB(0, 1), bBc, cB[1], 0); G8_STAGE(G8_SA(0, 1), bAc, cA[1], 0);
    if (wr == 1) G8_BAR;
    G8_WAIT_V(4); G8_BAR;
    G8_STAGE(G8_SB(1, 0), bBc, cB[0], 128); G8_STAGE(G8_SA(1, 0), bAc, cA[0], 128); G8_STAGE(G8_SB(1, 1), bBc, cB[1], 128);
    G8_WAIT_V(6); G8_BAR;
    for (;;) {
        const bool has_next = prob.next(ui + 1, nxt);
        const char* bAn = bAc; const char* bBn = bBc;
        if (has_next) { G8_OFFS(nxt, nA, nB); bAn = prob.baseA(nxt); bBn = prob.baseB(nxt); }
        else {
#pragma unroll
            for (int h_ = 0; h_ < 2; ++h_) { nA[h_][0] = cA[h_][0]; nA[h_][1] = cA[h_][1]; nB[h_][0] = cB[h_][0]; nB[h_][1] = cB[h_][1]; }
        }
        for (int t = 0; t < nt; t += 2) {
            const bool last = (t == nt - 2);
            const unsigned k1 = (unsigned)(t + 1) * 128u;
            const char* a2b = last ? bAn : bAc; const char* b2b = last ? bBn : bBc;
            const unsigned k2 = last ? 0u : (unsigned)(t + 2) * 128u, k3 = k2 + 128u;
            unsigned a2o0[2], a2o1[2], b2o0[2], b2o1[2];
            a2o0[0] = last ? nA[0][0] : cA[0][0]; a2o0[1] = last ? nA[0][1] : cA[0][1]; a2o1[0] = last ? nA[1][0] : cA[1][0]; a2o1[1] = last ? nA[1][1] : cA[1][1];
            b2o0[0] = last ? nB[0][0] : cB[0][0]; b2o0[1] = last ? nB[0][1] : cB[0][1]; b2o1[0] = last ? nB[1][0] : cB[1][0]; b2o1[1] = last ? nB[1][1] : cB[1][1];
            G8_LDB(B0, 0, 0); G8_SCHED; G8_LDA(At, 0, 0); G8_STAGE(G8_SA(1, 1), bAc, cA[1], k1);
            G8_WAIT_L(8); G8_BAR; G8_WAIT_L(0); G8_MMA(0, 0, At, B0); G8_BAR; G8_SCHED;
            G8_LDB(B1, 0, 1); G8_STAGE(G8_SB(0, 0), b2b, b2o0, k2);
            G8_BAR; G8_WAIT_L(0); G8_MMA(0, 1, At, B1); G8_BAR;
            G8_LDA(At, 0, 1); G8_STAGE(G8_SA(0, 0), a2b, a2o0, k2);
            G8_BAR; G8_WAIT_L(0); G8_MMA(1, 0, At, B0); G8_BAR; G8_SCHED;
            G8_STAGE(G8_SB(0, 1), b2b, b2o1, k2);
            G8_WAIT_V(6); G8_BAR; G8_MMA(1, 1, At, B1); G8_BAR;
            G8_LDB(B0, 1, 0); G8_SCHED; G8_LDA(At, 1, 0); G8_STAGE(G8_SA(0, 1), a2b, a2o1, k2);
            G8_WAIT_L(8); G8_BAR; G8_WAIT_L(0); G8_MMA(0, 0, At, B0); G8_BAR; G8_SCHED;
            G8_LDB(B1, 1, 1); G8_STAGE(G8_SB(1, 0), b2b, b2o0, k3);
            G8_BAR; G8_WAIT_L(0); G8_MMA(0, 1, At, B1); G8_BAR;
            G8_LDA(At, 1, 1); G8_STAGE(G8_SA(1, 0), a2b, a2o0, k3);
            G8_BAR; G8_WAIT_L(0); G8_MMA(1, 0, At, B0); G8_BAR; G8_SCHED;
            G8_STAGE(G8_SB(1, 1), b2b, b2o1, k3);
            G8_WAIT_V(6); G8_BAR; G8_MMA(1, 1, At, B1); G8_BAR;
        }
        { const int le = fresh_lane(); prob.epi(acc, cur, wr, wc, le & 15, le >> 4); }
        if (!has_next) break;
#pragma unroll
        for (int a = 0; a < 2; ++a)
#pragma unroll
            for (int b = 0; b < 2; ++b)
#pragma unroll
                for (int m = 0; m < 4; ++m)
#pragma unroll
                    for (int n = 0; n < 2; ++n) acc[a][b][m][n] = (f32x4){0.f, 0.f, 0.f, 0.f};
        cur = nxt; bAc = bAn; bBc = bBn; ++ui;
#pragma unroll
        for (int h_ = 0; h_ < 2; ++h_) { cA[h_][0] = nA[h_][0]; cA[h_][1] = nA[h_][1]; cB[h_][0] = nB[h_][0]; cB[h_][1] = nB[h_][1]; }
    }
    G8_WAIT_V(0);
    if (wr == 0) G8_BAR;
    G8_BAR;
#undef G8_OFFS
#undef G8_SA
#undef G8_SB
#undef G8_STAGE
#undef G8_LDA
#undef G8_LDB
#undef G8_MMA
#undef G8_WAIT_V
#undef G8_WAIT_L
#undef G8_BAR
#undef G8_SCHED
}
struct ProbOproj {
    const bf16_t* A; const bf16_t* Wt; float* out; const float* xl; const float* modl; int K; int c, G;
    __device__ __forceinline__ bool next(int i, Unit8& u) const { const int L = i * G + c; if (L >= 256) return false; const int x = L & 7, j = L >> 3; u.pn = j >> 3; u.pm = 8 * x + (j & 7); u.e = 0; return true; }
    __device__ __forceinline__ const char* baseA(const Unit8& u) const { return (const char*)(A + (size_t)u.pm * 256 * DM); }
    __device__ __forceinline__ const char* baseB(const Unit8& u) const { return (const char*)(Wt + (size_t)u.pn * 256 * 1024); }
    __device__ __forceinline__ unsigned offA(const Unit8&, int row) const { return (unsigned)row * (DM * 2); }
    __device__ __forceinline__ unsigned offB(const Unit8&, int rho) const { return (unsigned)rho * 2048u; }
    __device__ __forceinline__ void epi(const f32x4 (&acc)[2][2][4][2], const Unit8& u, int wr, int wc, int fr, int fq) const {
#pragma unroll
        for (int ai = 0; ai < 2; ++ai)
#pragma unroll
            for (int m = 0; m < 4; ++m) {
                const int row = u.pm * 256 + ai * 128 + wr * 64 + m * 16 + fr;
                const float* xr = xl + (size_t)row * DM;
                const float* gt = modl + (size_t)(row >> 13) * 6144 + 2 * 1024;
#pragma unroll
                for (int bj = 0; bj < 2; ++bj)
#pragma unroll
                    for (int n = 0; n < 2; ++n) {
                        const int col = u.pn * 256 + bj * 128 + wc * 32 + n * 16 + 4 * fq;
                        const f32x4 xv = *(const f32x4*)(xr + col), gv = *(const f32x4*)(gt + col);
                        f32x4 o;
#pragma unroll
                        for (int r = 0; r < 4; ++r) o[r] = ALPHA_F * xv[r] + gv[r] * acc[ai][bj][m][n][r];
                        *(f32x4*)(out + (size_t)row * DM + col) = o;
                    }
            }
    }
};
struct ProbRKV {
    PPtr p; int K; int c, G;
    __device__ __forceinline__ bool next(int i, Unit8& u) const { const int L = i * G + c; if (L >= 768) return false; const int cc = L & 255, x = cc & 7, j = cc >> 3; u.pn = (L >> 8) * 4 + (j >> 3); u.pm = 8 * x + (j & 7); u.e = 0; return true; }
    __device__ __forceinline__ const char* baseA(const Unit8& u) const { const int g = u.pn >> 2; const int msel = g == 0 ? 0 : (g == 1 ? 2 : 3); return (const char*)(p->XM + ((size_t)msel * ROWS + (size_t)u.pm * 256) * DM); }
    __device__ __forceinline__ const char* baseB(const Unit8& u) const { const int g = u.pn >> 2; const bf16_t* w = g == 0 ? p->wrT : (g == 1 ? p->wkT : p->wvT); return (const char*)(w + (size_t)(u.pn & 3) * 256 * 1024); }
    __device__ __forceinline__ unsigned offA(const Unit8&, int row) const { return (unsigned)row * 2048u; }
    __device__ __forceinline__ unsigned offB(const Unit8&, int rho) const { const int bj = rho >> 7, wc = (rho >> 5) & 3, w = rho & 31; return (unsigned)(64 * wc + 32 * bj + w) * 2048u; }
    __device__ __forceinline__ void epi(const f32x4 (&acc)[2][2][4][2], const Unit8& u, int wr, int wc, int fr, int fq) const {
        const int g = u.pn >> 2, lane = fr + 16 * fq;
        const int cb = (u.pn & 3) * 256 + 64 * wc + 4 * fq;
        bf16_t* out = g == 0 ? p->R : (g == 1 ? p->K : p->V);
#pragma unroll
        for (int ai = 0; ai < 2; ++ai)
#pragma unroll
            for (int m = 0; m < 4; ++m) {
                const int row = u.pm * 256 + ai * 128 + wr * 64 + m * 16 + fr;
                if (g != 1) {
#pragma unroll
                    for (int bj = 0; bj < 2; ++bj)
#pragma unroll
                        for (int n = 0; n < 2; ++n) {
                            uint2 o; o.x = pack2(acc[ai][bj][m][n][0], acc[ai][bj][m][n][1]); o.y = pack2(acc[ai][bj][m][n][2], acc[ai][bj][m][n][3]);
                            *(uint2*)(out + (size_t)row * DM + cb + 32 * bj + 16 * n) = o;
                        }
                } else {
                    f32x4 kv[2][2]; float ss = 0.f;
#pragma unroll
                    for (int bj = 0; bj < 2; ++bj)
#pragma unroll
                        for (int n = 0; n < 2; ++n) {
                            const int col = cb + 32 * bj + 16 * n;
                            const f32x4 kw = *(const f32x4*)(p->rw_kk + col);
                            uint2 o; o.x = pack2(acc[ai][bj][m][n][0], acc[ai][bj][m][n][1]); o.y = pack2(acc[ai][bj][m][n][2], acc[ai][bj][m][n][3]);
                            *(uint2*)(out + (size_t)row * DM + col) = o;
                            f32x4 t; t[0] = bflo(o.x) * kw[0]; t[1] = bfhi(o.x) * kw[1]; t[2] = bflo(o.y) * kw[2]; t[3] = bfhi(o.y) * kw[3];
                            kv[bj][n] = t; ss += (t[0] * t[0] + t[1] * t[1]) + (t[2] * t[2] + t[3] * t[3]);
                        }
                    ss += shx(ss, 16, lane); ss += shx(ss, 32, lane);
                    const float inv = fminf(__builtin_amdgcn_rsqf(ss), 1e12f);
#pragma unroll
                    for (int bj = 0; bj < 2; ++bj)
#pragma unroll
                        for (int n = 0; n < 2; ++n) *(f32x4*)(p->KK + (size_t)row * DM + cb + 32 * bj + 16 * n) = kv[bj][n] * inv;
                }
            }
    }
};
struct ProbQKV {
    PPtr p; int K; int c, G;
    __device__ __forceinline__ bool next(int i, Unit8& u) const { const int L = i * G + c; if (L >= 384) return false; const int cc = L & 255, x = cc & 7, j = cc >> 3; u.pn = (L >> 8) * 4 + (j >> 3); u.pm = 8 * x + (j & 7); u.e = 0; return true; }
    __device__ __forceinline__ const char* baseA(const Unit8& u) const { return (const char*)(p->HB + (size_t)u.pm * 256 * DM); }
    __device__ __forceinline__ const char* baseB(const Unit8& u) const { return (const char*)(p->wqkvT + (size_t)u.pn * 256 * 1024); }
    __device__ __forceinline__ unsigned offA(const Unit8&, int row) const { return (unsigned)row * 2048u; }
    __device__ __forceinline__ unsigned offB(const Unit8&, int rho) const { const int bj = rho >> 7, wc = (rho >> 5) & 3, w = rho & 31; return (unsigned)(64 * wc + 32 * bj + w) * 2048u; }
    __device__ __forceinline__ void epi(const f32x4 (&acc)[2][2][4][2], const Unit8& u, int wr, int wc, int fr, int fq) const {
        const int hs = u.pn * 4 + wc;
#pragma unroll
        for (int ai = 0; ai < 2; ++ai)
#pragma unroll
            for (int m = 0; m < 4; ++m) {
                const int row = u.pm * 256 + ai * 128 + wr * 64 + m * 16 + fr;
                const int t = row & (TLAT - 1), b = row >> 13;
                if (hs < 20) {
                    f32x4 v0 = acc[ai][0][m][0], v1 = acc[ai][0][m][1], v2 = acc[ai][1][m][0], v3 = acc[ai][1][m][1];
                    const int rp = t >> 6, cp = t & 63;
#pragma unroll
                    for (int r = 0; r < 4; ++r) {
                        const int fi = 4 * fq + r;
                        const float2 cr = *(const float2*)(p->rope + 2 * (rp * 16 + fi)), cc = *(const float2*)(p->rope + 2 * (cp * 16 + fi));
                        const float a = v0[r], bb = v1[r]; v0[r] = a * cr.x - bb * cr.y; v1[r] = bb * cr.x + a * cr.y;
                        const float c2 = v2[r], d2 = v3[r]; v2[r] = c2 * cc.x - d2 * cc.y; v3[r] = d2 * cc.x + c2 * cc.y;
                    }
                    const float sc = hs < 16 ? 0.125f : 1.f;
                    bf16_t* dst = hs < 16 ? p->Q + (size_t)row * DM + hs * 64 + 4 * fq : p->KA + (size_t)row * 256 + (hs - 16) * 64 + 4 * fq;
                    uint2 o;
                    o.x = pack2(v0[0] * sc, v0[1] * sc); o.y = pack2(v0[2] * sc, v0[3] * sc); *(uint2*)(dst) = o;
                    o.x = pack2(v1[0] * sc, v1[1] * sc); o.y = pack2(v1[2] * sc, v1[3] * sc); *(uint2*)(dst + 16) = o;
                    o.x = pack2(v2[0] * sc, v2[1] * sc); o.y = pack2(v2[2] * sc, v2[3] * sc); *(uint2*)(dst + 32) = o;
                    o.x = pack2(v3[0] * sc, v3[1] * sc); o.y = pack2(v3[2] * sc, v3[3] * sc); *(uint2*)(dst + 48) = o;
                } else {
                    bf16_t* vt = p->VTL + (size_t)(b * 4 + (hs - 20)) * 64 * TLAT + t;
#pragma unroll
                    for (int bj = 0; bj < 2; ++bj)
#pragma unroll
                        for (int n = 0; n < 2; ++n)
#pragma unroll
                            for (int r = 0; r < 4; ++r) vt[(size_t)(32 * bj + 16 * n + 4 * fq + r) * TLAT] = f2bf(acc[ai][bj][m][n][r]);
                }
            }
    }
};
struct ProbUp {
    PPtr p; int K; int c, G; int layer;
    __device__ __forceinline__ bool next(int i, Unit8& u) const { const int L = i * G + c; if (L >= 2048) return false; const int cc = L & 255, x = cc & 7, j = cc >> 3; u.e = (L >> 8) * 2 + (x >> 2); u.pn = 4 * (x & 3) + (j & 3); u.pm = j >> 2; return true; }
    __device__ __forceinline__ const char* baseA(const Unit8&) const { return (const char*)p->H2; }
    __device__ __forceinline__ const char* baseB(const Unit8& u) const { return (const char*)(p->CW + (size_t)(layer * 16 + u.e) * 3 * 2097152); }
    __device__ __forceinline__ unsigned offA(const Unit8& u, int row) const { const int src = p->idx[u.e * MPAD0 + u.pm * 256 + row]; return (unsigned)src * 2048u; }
    __device__ __forceinline__ unsigned offB(const Unit8& u, int rho) const { const int bj = rho >> 7, wc = (rho >> 5) & 3, n = (rho >> 4) & 1, cc = rho & 15; return (unsigned)n * 4194304u + (unsigned)(128 * u.pn + 64 * bj + 16 * wc + cc) * 2048u; }
    __device__ __forceinline__ void epi(const f32x4 (&acc)[2][2][4][2], const Unit8& u, int wr, int wc, int fr, int fq) const {
        bf16_t* out = p->HMID + (size_t)u.e * MPAD0 * 2048;
#pragma unroll
        for (int ai = 0; ai < 2; ++ai)
#pragma unroll
            for (int m = 0; m < 4; ++m) {
                const int slot = u.pm * 256 + ai * 128 + wr * 64 + m * 16 + fr;
#pragma unroll
                for (int bj = 0; bj < 2; ++bj) {
                    float v[4];
#pragma unroll
                    for (int r = 0; r < 4; ++r) { const float a = acc[ai][bj][m][0][r], uu = acc[ai][bj][m][1][r]; v[r] = a * sigmoidf_(a) * uu; }
                    uint2 o; o.x = pack2(v[0], v[1]); o.y = pack2(v[2], v[3]);
                    *(uint2*)(out + (size_t)slot * 2048 + 128 * u.pn + 64 * bj + 16 * wc + 4 * fq) = o;
                }
            }
    }
};
struct ProbDown {
    PPtr p; int K; int c, G; int layer;
    __device__ __forceinline__ bool next(int i, Unit8& u) const { const int L = i * G + c; if (L >= 512) return false; const int cc = L & 255, x = cc & 7, j = cc >> 3; u.e = (L >> 8) * 8 + x; u.pn = j & 3; u.pm = j >> 2; return true; }
    __device__ __forceinline__ const char* baseA(const Unit8& u) const { return (const char*)(p->HMID + ((size_t)u.e * MPAD0 + (size_t)u.pm * 256) * 2048); }
    __device__ __forceinline__ const char* baseB(const Unit8& u) const { return (const char*)(p->CW + ((size_t)(layer * 16 + u.e) * 3 + 2) * 2097152 + (size_t)u.pn * 256 * 2048); }
    __device__ __forceinline__ unsigned offA(const Unit8&, int row) const { return (unsigned)row * 4096u; }
    __device__ __forceinline__ unsigned offB(const Unit8&, int rho) const { return (unsigned)rho * 4096u; }
    __device__ __forceinline__ void epi(const f32x4 (&acc)[2][2][4][2], const Unit8& u, int wr, int wc, int fr, int fq) const {
        bf16_t* out = p->YE + (size_t)u.e * MPAD0 * DM;
#pragma unroll
        for (int ai = 0; ai < 2; ++ai)
#pragma unroll
            for (int m = 0; m < 4; ++m) {
                const int slot = u.pm * 256 + ai * 128 + wr * 64 + m * 16 + fr;
                const float g = p->gate[u.e * MPAD0 + slot];
#pragma unroll
                for (int bj = 0; bj < 2; ++bj)
#pragma unroll
                    for (int n = 0; n < 2; ++n) {
                        uint2 o; o.x = pack2(acc[ai][bj][m][n][0] * g, acc[ai][bj][m][n][1] * g); o.y = pack2(acc[ai][bj][m][n][2] * g, acc[ai][bj][m][n][3] * g);
                        *(uint2*)(out + (size_t)slot * DM + u.pn * 256 + bj * 128 + wc * 32 + n * 16 + 4 * fq) = o;
                    }
            }
    }
};
__device__ __forceinline__ void conv_tile(const Ctx cx, const float* src, int ldn, bf16_t* dst, int ldk, int k0, int n0, char* lds, bool valid) {
    bf16_t* T = (bf16_t*)lds;
    const int tid = cx.tid;
    {
        const int k4 = (tid >> 4) * 4, n4 = (tid & 15) * 4;
        const float* q = src + (size_t)(k0 + k4) * ldn + n0 + n4;
        float4 r0 = make_float4(0.f, 0.f, 0.f, 0.f), r1 = r0, r2 = r0, r3 = r0;
        if (valid) { r0 = *(const float4*)q; r1 = *(const float4*)(q + ldn); r2 = *(const float4*)(q + 2 * (size_t)ldn); r3 = *(const float4*)(q + 3 * (size_t)ldn); }
        uint2 w;
        w.x = pack2(r0.x, r1.x); w.y = pack2(r2.x, r3.x); *(uint2*)(T + (n4 + 0) * 72 + k4) = w;
        w.x = pack2(r0.y, r1.y); w.y = pack2(r2.y, r3.y); *(uint2*)(T + (n4 + 1) * 72 + k4) = w;
        w.x = pack2(r0.z, r1.z); w.y = pack2(r2.z, r3.z); *(uint2*)(T + (n4 + 2) * 72 + k4) = w;
        w.x = pack2(r0.w, r1.w); w.y = pack2(r2.w, r3.w); *(uint2*)(T + (n4 + 3) * 72 + k4) = w;
    }
    __syncthreads();
    {
        const int n = tid >> 2, kc = (tid & 3) * 16;
        const uint4 u0 = *(const uint4*)(T + n * 72 + kc), u1 = *(const uint4*)(T + n * 72 + kc + 8);
        bf16_t* d = dst + (size_t)(n0 + n) * ldk + k0 + kc;
        if (valid) { *(uint4*)d = u0; *(uint4*)(d + 8) = u1; }
    }
    __syncthreads();
}
struct Conv4Regs { float4 r[4][4]; };
__device__ __forceinline__ void conv4_load(const Ctx cx, Conv4Regs& R, const float* src, int ldn, int k0, int n0, bool valid) {
    const int tid = cx.tid, k4 = (tid >> 4) * 4, n4 = (tid & 15) * 4;
#pragma unroll
    for (int s4 = 0; s4 < 4; ++s4) {
        const float* q = src + (size_t)(k0 + k4) * ldn + n0 + 64 * s4 + n4;
        if (valid) { R.r[s4][0] = *(const float4*)q; R.r[s4][1] = *(const float4*)(q + ldn); R.r[s4][2] = *(const float4*)(q + 2 * (size_t)ldn); R.r[s4][3] = *(const float4*)(q + 3 * (size_t)ldn); }
        else { R.r[s4][0] = R.r[s4][1] = R.r[s4][2] = R.r[s4][3] = make_float4(0.f, 0.f, 0.f, 0.f); }
    }
}
__device__ __forceinline__ void conv4_finish(const Ctx cx, const Conv4Regs& R, bf16_t* dst, int ldk, int k0, int n0, char* lds, bool valid) {
    const int tid = cx.tid, k4 = (tid >> 4) * 4, n4 = (tid & 15) * 4;
#pragma unroll
    for (int s4 = 0; s4 < 4; ++s4) {
        bf16_t* T = (bf16_t*)lds + s4 * (64 * 72);
        uint2 w;
        w.x = pack2(R.r[s4][0].x, R.r[s4][1].x); w.y = pack2(R.r[s4][2].x, R.r[s4][3].x); *(uint2*)(T + (n4 + 0) * 72 + k4) = w;
        w.x = pack2(R.r[s4][0].y, R.r[s4][1].y); w.y = pack2(R.r[s4][2].y, R.r[s4][3].y); *(uint2*)(T + (n4 + 1) * 72 + k4) = w;
        w.x = pack2(R.r[s4][0].z, R.r[s4][1].z); w.y = pack2(R.r[s4][2].z, R.r[s4][3].z); *(uint2*)(T + (n4 + 2) * 72 + k4) = w;
        w.x = pack2(R.r[s4][0].w, R.r[s4][1].w); w.y = pack2(R.r[s4][2].w, R.r[s4][3].w); *(uint2*)(T + (n4 + 3) * 72 + k4) = w;
    }
    __syncthreads();
    {
        const int n = tid >> 2, kc = (tid & 3) * 16;
#pragma unroll
        for (int s4 = 0; s4 < 4; ++s4) {
            const bf16_t* T = (const bf16_t*)lds + s4 * (64 * 72);
            const uint4 u0 = *(const uint4*)(T + n * 72 + kc), u1 = *(const uint4*)(T + n * 72 + kc + 8);
            bf16_t* d = dst + (size_t)(n0 + 64 * s4 + n) * ldk + k0 + kc;
            if (valid) { *(uint4*)d = u0; *(uint4*)(d + 8) = u1; }
        }
    }
    __syncthreads();
}
__device__ __forceinline__ void conv_tile_w(int lane, const float* src, int ldn, bf16_t* dst, int ldk, int k0, int n0, bf16_t* T) {
    const int n4 = (lane & 15) * 4, kq = lane >> 4;
    float4 r[4][4];
#pragma unroll
    for (int i = 0; i < 4; ++i) {
        const float* q = src + (size_t)(k0 + (kq + 4 * i) * 4) * ldn + n0 + n4;
        r[i][0] = *(const float4*)q; r[i][1] = *(const float4*)(q + ldn); r[i][2] = *(const float4*)(q + 2 * (size_t)ldn); r[i][3] = *(const float4*)(q + 3 * (size_t)ldn);
    }
#pragma unroll
    for (int i = 0; i < 4; ++i) {
        const int k4 = (kq + 4 * i) * 4;
        uint2 w;
        w.x = pack2(r[i][0].x, r[i][1].x); w.y = pack2(r[i][2].x, r[i][3].x); *(uint2*)(T + (n4 + 0) * 72 + k4) = w;
        w.x = pack2(r[i][0].y, r[i][1].y); w.y = pack2(r[i][2].y, r[i][3].y); *(uint2*)(T + (n4 + 1) * 72 + k4) = w;
        w.x = pack2(r[i][0].z, r[i][1].z); w.y = pack2(r[i][2].z, r[i][3].z); *(uint2*)(T + (n4 + 2) * 72 + k4) = w;
        w.x = pack2(r[i][0].w, r[i][1].w); w.y = pack2(r[i][2].w, r[i][3].w); *(uint2*)(T + (n4 + 3) * 72 + k4) = w;
    }
    asm volatile("s_waitcnt lgkmcnt(0)" ::: "memory");
    bf16_t* d = dst + (size_t)(n0 + lane) * ldk + k0;
#pragma unroll
    for (int j = 0; j < 8; ++j) { const uint4 u = *(const uint4*)(T + lane * 72 + 8 * j); *(uint4*)(d + 8 * j) = u; }
    asm volatile("s_waitcnt lgkmcnt(0)" ::: "memory");
}
__device__ __forceinline__ void conv_moe_w(PRef p, int lane, int cw, int ncw, bf16_t* T) {
    for (int t = cw; t < 2 * 16 * 3 * 512; t += ncw) {
        const int le = t / 1536, rem = t % 1536, mat = rem >> 9, tl = rem & 511;
        const float* src = (mat == 0 ? p.moe_w_gate : (mat == 1 ? p.moe_w_up : p.moe_w_down)) + (size_t)le * 2097152;
        bf16_t* dst = p.CW + ((size_t)le * 3 + mat) * 2097152;
        const int K = mat == 2 ? 2048 : 1024, N = mat == 2 ? 1024 : 2048;
        const int nn = N >> 6, nt = tl % nn, kt = tl / nn;
        conv_tile_w(lane, src, N, dst, K, kt * 64, nt * 64, T);
    }
}
__device__ __forceinline__ void conv_small(const Ctx cx, PRef p, char* lds, int t_lo, int t_hi, int cid, int cnb) {
    const int ntl = t_hi - t_lo;
    const int trips = (ntl - (cid & ~1) + cnb - 1) / cnb;
    for (int it = 0; it < trips; ++it) {
        const int t0 = cid + it * cnb; const bool valid = t0 < ntl; const int t = t_lo + (valid ? t0 : 0);
        const float* src; bf16_t* dst; int K, N, tl;
        if (t < 768) { const int w = t >> 8; tl = t & 255; src = w == 0 ? p.rw_wr : (w == 1 ? p.rw_wk : p.rw_wv); dst = w == 0 ? p.wrT : (w == 1 ? p.wkT : p.wvT); K = 1024; N = 1024; }
        else if (t < 800) { tl = t - 768; src = p.rw_g1; dst = p.l1T; K = 1024; N = 128; }
        else if (t < 832) { const int d = (t - 800) >> 4; tl = (t - 800) & 15; src = p.rw_w1 + (size_t)d * 65536; dst = p.l1T + (size_t)(128 + 64 * d) * 1024; K = 1024; N = 64; }
        else if (t < 864) { const int d = (t - 832) >> 4; tl = (t - 832) & 15; src = p.rw_a1 + (size_t)d * 65536; dst = p.l1T + (size_t)(256 + 64 * d) * 1024; K = 1024; N = 64; }
        else if (t < 896) { tl = t - 864; src = p.rw_g2; dst = p.g2T; K = 128; N = 1024; }
        else if (t < 928) { const int d = (t - 896) >> 4; tl = (t - 896) & 15; src = p.rw_w2 + (size_t)d * 65536; dst = p.w2T + (size_t)d * 65536; K = 64; N = 1024; }
        else if (t < 960) { const int d = (t - 928) >> 4; tl = (t - 928) & 15; src = p.rw_a2 + (size_t)d * 65536; dst = p.a2T + (size_t)d * 65536; K = 64; N = 1024; }
        else if (t < 1216) { tl = t - 960; src = p.rw_wo; dst = p.woT; K = 1024; N = 1024; }
        else if (t < 1600) { tl = t - 1216; src = p.at_wqkv; dst = p.wqkvT; K = 1024; N = 1536; }
        else { tl = t - 1600; src = p.at_wo; dst = p.atwoT; K = 1024; N = 1024; }
        const int nn = N >> 6, nt = tl % nn, kt = tl / nn;
        conv_tile(cx, src, N, dst, K, kt * 64, nt * 64, lds, valid);
    }
}
__device__ __forceinline__ void conv_moe(const Ctx cx, PRef p, char* lds, int cid, int cnb) {
    const int NTL = 2 * 16 * 3 * 128;
    const int trips = (NTL - (cid & ~1) + cnb - 1) / cnb;
#define CONV_DESC(t0_, valid_, src_, dst_, K_, N_, k0_, n0_) \
        const bool valid_ = (t0_) < NTL; const int tq_##valid_ = valid_ ? (t0_) : 0; \
        const int le_##valid_ = tq_##valid_ / 384, rem_##valid_ = tq_##valid_ % 384, mat_##valid_ = rem_##valid_ >> 7, tl_##valid_ = rem_##valid_ & 127; \
        const float* src_ = (mat_##valid_ == 0 ? p.moe_w_gate : (mat_##valid_ == 1 ? p.moe_w_up : p.moe_w_down)) + (size_t)le_##valid_ * 2097152; \
        bf16_t* dst_ = p.CW + ((size_t)le_##valid_ * 3 + mat_##valid_) * 2097152; \
        const int K_ = mat_##valid_ == 2 ? 2048 : 1024, N_ = mat_##valid_ == 2 ? 1024 : 2048; \
        const int k0_ = (tl_##valid_ / (N_ >> 8)) * 64, n0_ = (tl_##valid_ % (N_ >> 8)) * 256
    Conv4Regs Ra, Rb;
    { CONV_DESC(cid, v0, s0, d0, K0, N0, k00, n00); (void)d0; (void)K0; conv4_load(cx, Ra, s0, N0, k00, n00, v0); }
    for (int it = 0; it < trips; it += 2) {
        { CONV_DESC(cid + (it + 1) * cnb, v1, s1, d1, K1, N1, k01, n01); (void)d1; (void)K1; conv4_load(cx, Rb, s1, N1, k01, n01, v1 && (it + 1 < trips)); }
        { CONV_DESC(cid + it * cnb, v2, s2, d2, K2, N2, k02, n02); (void)s2; (void)N2; conv4_finish(cx, Ra, d2, K2, k02, n02, lds, v2); }
        if (it + 1 < trips) {
            { CONV_DESC(cid + (it + 2) * cnb, v3, s3, d3, K3, N3, k03, n03); (void)d3; (void)K3; conv4_load(cx, Ra, s3, N3, k03, n03, v3 && (it + 2 < trips)); }
            { CONV_DESC(cid + (it + 1) * cnb, v4, s4, d4, K4, N4, k04, n04); (void)s4; (void)N4; conv4_finish(cx, Rb, d4, K4, k04, n04, lds, v4); }
        }
    }
#undef CONV_DESC
}
__device__ __forceinline__ void ph_ada(const Ctx cx, PRef p, char* ldsc) {
    float* sv = (float*)ldsc;
    for (int i = cx.tid; i < 3072; i += NTHR) {
        const int s = i >> 10, k = i & 1023;
        const float v = (s < 2) ? p.c[s * 1024 + k] : p.c_ctx[k];
        sv[i] = v / (1.f + __expf(-v));
    }
    __syncthreads();
    const int lane = cx.tid & 63, gw = (cx.bid * NTHR + cx.tid) >> 6, nw = (cx.nb * NTHR) >> 6;
    for (int item = gw; item < 3072; item += nw) {
        const int ks = item & 15, ch = (item >> 4) % 96, l = item / (16 * 96), n0 = ch * 64, kb = ks * 64;
        const float* w = p.ada_w + (size_t)l * 1024 * 6144 + n0 + lane;
        float a0 = 0.f, a1 = 0.f, a2 = 0.f;
#pragma unroll 32
        for (int k = 0; k < 64; ++k) {
            const float wv = w[(size_t)(kb + k) * 6144];
            a0 += wv * sv[kb + k]; a1 += wv * sv[1024 + kb + k]; a2 += wv * sv[2048 + kb + k];
        }
        float* mo = p.modp + ((size_t)ks * 6 + l * 3) * 6144 + n0 + lane;
        mo[0] = a0; mo[6144] = a1; mo[2 * 6144] = a2;
    }
    for (int i = cx.bid * NTHR + cx.tid; i < 128 * 16; i += cx.nb * NTHR) {
        const int pos = i >> 4, fi = i & 15;
        const float th = __builtin_amdgcn_exp2f(-(float)fi * (13.287712379549449f / 16.0f));
        const float t2 = th * th;
        float cs = 1.f - t2 * (0.5f - t2 * (1.f / 24.f - t2 * (1.f / 720.f - t2 * (1.f / 40320.f - t2 * (1.f / 3628800.f)))));
        float sn = th * (1.f - t2 * (1.f / 6.f - t2 * (1.f / 120.f - t2 * (1.f / 5040.f - t2 * (1.f / 362880.f - t2 * (1.f / 39916800.f))))));
        float rc = 1.f, rs = 0.f;
#pragma unroll
        for (int bb = 0; bb < 7; ++bb) {
            if ((pos >> bb) & 1) { const float nc = rc * cs - rs * sn, ns = rc * sn + rs * cs; rc = nc; rs = ns; }
            const float c2 = cs * cs - sn * sn, s2 = 2.f * cs * sn; cs = c2; sn = s2;
        }
        p.rope[2 * i] = rc; p.rope[2 * i + 1] = rs;
    }
    __syncthreads();
    conv_small(cx, p, ldsc, 0, 960, cx.bid, cx.nb);
}
__device__ __forceinline__ void ph_pre0(const Ctx cx, PRef p) {
    const int col = cx.tid * 4;
    for (int i = cx.bid * NTHR + cx.tid; i < 2 * 3 * 6144; i += cx.nb * NTHR) {
        float v = p.ada_b[(i / (3 * 6144)) * 6144 + i % 6144];
#pragma unroll
        for (int ks = 0; ks < 16; ++ks) v += p.modp[(size_t)ks * 36864 + i];
        p.modv[i] = v;
    }
    float4 sh0, sh1, sh2, sc0, sc1, sc2;
#define PRE0_RED(S3, SH, SC) do { float4 a = *(const float4*)(p.ada_b + col), b = *(const float4*)(p.ada_b + 1024 + col); \
        _Pragma("unroll") for (int ks = 0; ks < 16; ++ks) { \
            const float4 pa = *(const float4*)(p.modp + (size_t)ks * 36864 + (S3) * 6144 + col), pb = *(const float4*)(p.modp + (size_t)ks * 36864 + (S3) * 6144 + 1024 + col); \
            a.x += pa.x; a.y += pa.y; a.z += pa.z; a.w += pa.w; b.x += pb.x; b.y += pb.y; b.z += pb.z; b.w += pb.w; } \
        SH = a; SC = b; } while (0)
    PRE0_RED(0, sh0, sc0); PRE0_RED(1, sh1, sc1); PRE0_RED(2, sh2, sc2);
#undef PRE0_RED
    for (int r0 = cx.bid * 4; r0 < ROWS; r0 += cx.nb * 4) {
        const int s = mod_of_row(r0);
        const int t0 = r0 < ROWS_LAT ? (r0 & (TLAT - 1)) : ((r0 - ROWS_LAT) & (LCTX - 1));
        const int len = r0 < ROWS_LAT ? TLAT : LCTX;
        const float4 sh = s == 0 ? sh0 : (s == 1 ? sh1 : sh2), sc = s == 0 ? sc0 : (s == 1 ? sc1 : sc2);
        const float* xr = xin_row(p, r0);
        float4 xv[6];
#pragma unroll
        for (int j = 0; j < 6; ++j) {
            const int t = t0 - 1 + j;
            xv[j] = make_float4(0.f, 0.f, 0.f, 0.f);
            if (t >= 0 && t < len) xv[j] = *(const float4*)(xr + (ptrdiff_t)(j - 1) * DM + col);
        }
        float4 mu[6];
#pragma unroll
        for (int m = 0; m < 6; ++m) mu[m] = *(const float4*)(p.rw_mu + m * 1024 + col);
        float hv[6][4];
#pragma unroll
        for (int j = 0; j < 6; ++j) {
            const int t = t0 - 1 + j; const bool in = (t >= 0 && t < len);
            hv[j][0] = in ? xv[j].x * (1.f + sc.x) + sh.x : 0.f; hv[j][1] = in ? xv[j].y * (1.f + sc.y) + sh.y : 0.f;
            hv[j][2] = in ? xv[j].z * (1.f + sc.z) + sh.z : 0.f; hv[j][3] = in ? xv[j].w * (1.f + sc.w) + sh.w : 0.f;
        }
#pragma unroll
        for (int rr = 0; rr < 4; ++rr) {
            float h[4], xx[4];
#pragma unroll
            for (int i = 0; i < 4; ++i) { h[i] = hv[rr + 1][i]; xx[i] = 0.5f * (hv[rr][i] + hv[rr + 2][i]) - h[i]; }
#pragma unroll
            for (int m = 0; m < 6; ++m) {
                uint2 o; o.x = pack2(h[0] + xx[0] * mu[m].x, h[1] + xx[1] * mu[m].y); o.y = pack2(h[2] + xx[2] * mu[m].z, h[3] + xx[3] * mu[m].w);
                *(uint2*)(p.XM + ((size_t)m * ROWS + r0 + rr) * DM + col) = o;
            }
        }
    }
}

struct EpiF32 {
    float* out; int ld, m0, n0;
    __device__ __forceinline__ void operator()(const f32x4 (&acc)[4][4], int wr, int wc, int fr, int fq) const {
#pragma unroll
        for (int i = 0; i < 4; ++i)
#pragma unroll
            for (int j = 0; j < 4; ++j) {
                const int row = m0 + wr * 64 + i * 16 + fr, col = n0 + wc * 64 + j * 16 + 4 * fq;
                *(f32x4*)(out + (size_t)row * ld + col) = acc[i][j];
            }
    }
};
struct EpiBf {
    bf16_t* out; int ld, m0, n0;
    __device__ __forceinline__ void operator()(const f32x4 (&acc)[4][4], int wr, int wc, int fr, int fq) const {
#pragma unroll
        for (int i = 0; i < 4; ++i)
#pragma unroll
            for (int j = 0; j < 4; ++j) {
                const int row = m0 + wr * 64 + i * 16 + fr, col = n0 + wc * 64 + j * 16 + 4 * fq;
                uint2 o; o.x = pack2(acc[i][j][0], acc[i][j][1]); o.y = pack2(acc[i][j][2], acc[i][j][3]);
                *(uint2*)(out + (size_t)row * ld + col) = o;
            }
    }
};
struct EpiK {
    bf16_t* out; float* kk; const float* k_k; int m0, n0;
    __device__ __forceinline__ void operator()(const f32x4 (&acc)[4][4], int wr, int wc, int fr, int fq) const {
        const int lane = fr + 16 * fq;
#pragma unroll
        for (int i = 0; i < 4; ++i) {
            const int row = m0 + wr * 64 + i * 16 + fr;
            f32x4 kv[4]; float ss = 0.f;
#pragma unroll
            for (int j = 0; j < 4; ++j) {
                const int col = n0 + wc * 64 + j * 16 + 4 * fq;
                const f32x4 kw = *(const f32x4*)(k_k + col);
                uint2 o; o.x = pack2(acc[i][j][0], acc[i][j][1]); o.y = pack2(acc[i][j][2], acc[i][j][3]);
                *(uint2*)(out + (size_t)row * DM + col) = o;
                kv[j][0] = bflo(o.x) * kw[0]; kv[j][1] = bfhi(o.x) * kw[1]; kv[j][2] = bflo(o.y) * kw[2]; kv[j][3] = bfhi(o.y) * kw[3];
                ss += (kv[j][0] * kv[j][0] + kv[j][1] * kv[j][1]) + (kv[j][2] * kv[j][2] + kv[j][3] * kv[j][3]);
            }
            ss += shx(ss, 16, lane); ss += shx(ss, 32, lane);
            const float inv = fminf(__builtin_amdgcn_rsqf(ss), 1e12f);
#pragma unroll
            for (int j = 0; j < 4; ++j) {
                const int col = n0 + wc * 64 + j * 16 + 4 * fq;
                *(f32x4*)(kk + (size_t)row * DM + col) = kv[j] * inv;
            }
        }
    }
};
struct EpiLH {
    bf16_t* out; int m0, coff, act;
    __device__ __forceinline__ void operator()(const f32x4 (&acc)[4][4], int wr, int wc, int fr, int fq) const {
#pragma unroll
        for (int i = 0; i < 4; ++i)
#pragma unroll
            for (int j = 0; j < 4; ++j) {
                const int row = m0 + wr * 64 + i * 16 + fr, col = wc * 64 + j * 16 + 4 * fq;
                float v[4];
#pragma unroll
                for (int r = 0; r < 4; ++r) { const float a = acc[i][j][r]; v[r] = act == 0 ? sigmoidf_(a) : (act == 1 ? (1.f - 2.f * __builtin_amdgcn_rcpf(1.f + __expf(2.f * a))) : a); }
                uint2 o; o.x = pack2(v[0], v[1]); o.y = pack2(v[2], v[3]);
                *(uint2*)(out + (size_t)row * 384 + coff + col) = o;
            }
    }
};
struct EpiG2 {
    bf16_t* outb; float* outf; const float* bias; int m0, n0, kind;
    __device__ __forceinline__ void operator()(const f32x4 (&acc)[4][4], int wr, int wc, int fr, int fq) const {
#pragma unroll
        for (int i = 0; i < 4; ++i)
#pragma unroll
            for (int j = 0; j < 4; ++j) {
                const int row = m0 + wr * 64 + i * 16 + fr, col = n0 + wc * 64 + j * 16 + 4 * fq;
                if (kind == 0) {
                    uint2 o; o.x = pack2(acc[i][j][0], acc[i][j][1]); o.y = pack2(acc[i][j][2], acc[i][j][3]);
                    *(uint2*)(outb + (size_t)row * DM + col) = o;
                } else if (kind == 2) {
                    const float4 b = *(const float4*)(bias + col);
                    uint2 o; o.x = pack2(sigmoidf_(b.x + acc[i][j][0]), sigmoidf_(b.y + acc[i][j][1])); o.y = pack2(sigmoidf_(b.z + acc[i][j][2]), sigmoidf_(b.w + acc[i][j][3]));
                    *(uint2*)(outb + (size_t)row * DM + col) = o;
                } else {
                    const float4 b = *(const float4*)(bias + col);
                    const float bv[4] = {b.x, b.y, b.z, b.w};
                    f32x4 o;
#pragma unroll
                    for (int r = 0; r < 4; ++r) {
                        const float s = sigmoidf_(bv[r] + acc[i][j][r]);
                        o[r] = kind == 1 ? __expf(-0.606531f * s) : s;
                    }
                    *(f32x4*)(outf + (size_t)row * DM + col) = o;
                }
            }
    }
};
struct EpiResid {
    float* out; const float* xl; const float* xc; const float* modl; int m0, n0;
    __device__ __forceinline__ void operator()(const f32x4 (&acc)[4][4], int wr, int wc, int fr, int fq) const {
#pragma unroll
        for (int i = 0; i < 4; ++i) {
            const int row = m0 + wr * 64 + i * 16 + fr;
            const float* xr = row < ROWS_LAT ? xl + (size_t)row * DM : xc + (size_t)(row - ROWS_LAT) * DM;
            const float* gt = modl + (size_t)mod_of_row(row) * 6144 + 2 * 1024;
#pragma unroll
            for (int j = 0; j < 4; ++j) {
                const int col = n0 + wc * 64 + j * 16 + 4 * fq;
                const f32x4 xv = *(const f32x4*)(xr + col), gv = *(const f32x4*)(gt + col);
                f32x4 o;
#pragma unroll
                for (int r = 0; r < 4; ++r) o[r] = ALPHA_F * xv[r] + gv[r] * acc[i][j][r];
                *(f32x4*)(out + (size_t)row * DM + col) = o;
            }
        }
    }
};
struct EpiSwiGLU {
    bf16_t* out; int m0, j0;
    __device__ __forceinline__ void operator()(const f32x4 (&acc)[4][4], int wr, int wc, int fr, int fq) const {
#pragma unroll
        for (int i = 0; i < 4; ++i) {
            const int row = m0 + wr * 64 + i * 16 + fr;
#pragma unroll
            for (int j = 0; j < 2; ++j) {
                const int col = j0 + wc * 32 + j * 16 + 4 * fq;
                float v[4];
#pragma unroll
                for (int r = 0; r < 4; ++r) { const float a = acc[i][j][r], u = acc[i][j + 2][r]; v[r] = a * sigmoidf_(a) * u; }
                uint2 o; o.x = pack2(v[0], v[1]); o.y = pack2(v[2], v[3]);
                *(uint2*)(out + (size_t)row * 2048 + col) = o;
            }
        }
    }
};
struct EpiDown {
    bf16_t* out; const float* gate; int m0, n0;
    __device__ __forceinline__ void operator()(const f32x4 (&acc)[4][4], int wr, int wc, int fr, int fq) const {
#pragma unroll
        for (int i = 0; i < 4; ++i) {
            const int row = m0 + wr * 64 + i * 16 + fr;
            const float g = gate[row];
#pragma unroll
            for (int j = 0; j < 4; ++j) {
                const int col = n0 + wc * 64 + j * 16 + 4 * fq;
                uint2 o; o.x = pack2(acc[i][j][0] * g, acc[i][j][1] * g); o.y = pack2(acc[i][j][2] * g, acc[i][j][3] * g);
                *(uint2*)(out + (size_t)row * DM + col) = o;
            }
        }
    }
};
struct EpiQKV {
    PPtr p; int m0, n0;
    __device__ __forceinline__ void operator()(const f32x4 (&acc)[4][4], int wr, int wc, int fr, int fq) const {
        const int hs = (n0 + wc * 64) >> 6;
#pragma unroll
        for (int i = 0; i < 4; ++i) {
            const int row = m0 + wr * 64 + i * 16 + fr;
            const bool lat = row < ROWS_LAT;
            if (hs < 20) {
                f32x4 v0 = acc[i][0], v1 = acc[i][1], v2 = acc[i][2], v3 = acc[i][3];
                if (lat) {
                    const int t = row & (TLAT - 1), rp = t >> 6, cp = t & 63;
#pragma unroll
                    for (int r = 0; r < 4; ++r) {
                        const int fi = 4 * fq + r;
                        const float2 cr = *(const float2*)(p->rope + 2 * (rp * 16 + fi)), cc = *(const float2*)(p->rope + 2 * (cp * 16 + fi));
                        const float a = v0[r], b = v1[r]; v0[r] = a * cr.x - b * cr.y; v1[r] = b * cr.x + a * cr.y;
                        const float c2 = v2[r], d2 = v3[r]; v2[r] = c2 * cc.x - d2 * cc.y; v3[r] = d2 * cc.x + c2 * cc.y;
                    }
                }
                if (hs < 16) {
                    if (lat) {
                        bf16_t* q = p->Q + (size_t)row * DM + hs * 64 + 4 * fq;
                        uint2 o;
                        o.x = pack2(v0[0] * 0.125f, v0[1] * 0.125f); o.y = pack2(v0[2] * 0.125f, v0[3] * 0.125f); *(uint2*)(q) = o;
                        o.x = pack2(v1[0] * 0.125f, v1[1] * 0.125f); o.y = pack2(v1[2] * 0.125f, v1[3] * 0.125f); *(uint2*)(q + 16) = o;
                        o.x = pack2(v2[0] * 0.125f, v2[1] * 0.125f); o.y = pack2(v2[2] * 0.125f, v2[3] * 0.125f); *(uint2*)(q + 32) = o;
                        o.x = pack2(v3[0] * 0.125f, v3[1] * 0.125f); o.y = pack2(v3[2] * 0.125f, v3[3] * 0.125f); *(uint2*)(q + 48) = o;
                    }
                } else {
                    bf16_t* k = p->KA + (size_t)row * 256 + (hs - 16) * 64 + 4 * fq;
                    uint2 o;
                    o.x = pack2(v0[0], v0[1]); o.y = pack2(v0[2], v0[3]); *(uint2*)(k) = o;
                    o.x = pack2(v1[0], v1[1]); o.y = pack2(v1[2], v1[3]); *(uint2*)(k + 16) = o;
                    o.x = pack2(v2[0], v2[1]); o.y = pack2(v2[2], v2[3]); *(uint2*)(k + 32) = o;
                    o.x = pack2(v3[0], v3[1]); o.y = pack2(v3[2], v3[3]); *(uint2*)(k + 48) = o;
                }
            } else {
                const int hk = hs - 20;
                bf16_t* vt; int ldt, t;
                if (lat) { const int b = row >> 13; t = row & (TLAT - 1); vt = p->VTL + (size_t)(b * 4 + hk) * 64 * TLAT; ldt = TLAT; }
                else { const int rr = row - ROWS_LAT, b = rr >> 8; t = rr & (LCTX - 1); vt = p->VTC + (size_t)(b * 4 + hk) * 64 * LCTX; ldt = LCTX; }
#pragma unroll
                for (int j = 0; j < 4; ++j)
#pragma unroll
                    for (int r = 0; r < 4; ++r) vt[(size_t)(j * 16 + 4 * fq + r) * ldt + t] = f2bf(acc[i][j][r]);
            }
        }
    }
};

__device__ __forceinline__ void ph_g1(const Ctx cx, PRef p, char* lds) {
    for (int tile = cx.bid; tile < 96 + 396; tile += cx.nb) {
        int mt, nt;
        if (tile < 96) { mt = 128 + tile / 24; nt = tile % 24; } else { const int t2 = tile - 96; mt = t2 / 3; nt = 24 + t2 % 3; }
        const int m0 = mt * 128;
        int msel, n0; const bf16_t* Bt;
        if (nt < 24) { const int gsel = nt >> 3; n0 = (nt & 7) * 128; msel = gsel == 0 ? 0 : (gsel == 1 ? 2 : 3); Bt = (gsel == 0 ? p.wrT : (gsel == 1 ? p.wkT : p.wvT)) + (size_t)n0 * 1024; }
        else { const int q = nt - 24; n0 = 0; msel = q == 0 ? 5 : (q == 1 ? 1 : 4); Bt = p.l1T + (size_t)q * 128 * 1024; }
        const bf16_t* A = p.XM + ((size_t)msel * ROWS + m0) * DM + G3_CH8;
        const bf16_t* B = Bt + G3_CH8;
        if (nt < 24) {
            const int gsel = nt >> 3;
            if (gsel == 1) {
                EpiK epi; epi.out = p.K; epi.kk = p.KK; epi.k_k = p.rw_kk; epi.m0 = m0; epi.n0 = n0;
                gemm3_tile(cx, A + (size_t)G3_ROW(0) * DM, A + (size_t)G3_ROW(1) * DM,
                           B + (size_t)G3_ROW(0) * 1024, B + (size_t)G3_ROW(1) * 1024, 1024, epi, lds);
            } else {
                EpiBf epi; epi.out = gsel == 0 ? p.R : p.V; epi.ld = DM; epi.m0 = m0; epi.n0 = n0;
                gemm3_tile(cx, A + (size_t)G3_ROW(0) * DM, A + (size_t)G3_ROW(1) * DM,
                           B + (size_t)G3_ROW(0) * 1024, B + (size_t)G3_ROW(1) * 1024, 1024, epi, lds);
            }
        } else {
            const int q = nt - 24;
            EpiLH epi; epi.out = p.LH; epi.m0 = m0; epi.coff = q * 128; epi.act = q;
            gemm3_tile(cx, A + (size_t)G3_ROW(0) * DM, A + (size_t)G3_ROW(1) * DM,
                       B + (size_t)G3_ROW(0) * 1024, B + (size_t)G3_ROW(1) * 1024, 1024, epi, lds);
        }
    }
}
__device__ __forceinline__ void ph_g2(const Ctx cx, PRef p, char* lds) {
#define G2_DESC(tile_, A_, B_, K_, epi_) \
        const int mt_##A_ = (tile_) / 40, rem_##A_ = (tile_) % 40, gsel_##A_ = rem_##A_ >> 3, n0_##A_ = (rem_##A_ & 7) * 128, m0_##A_ = mt_##A_ * 128; \
        const bf16_t* A_; const bf16_t* B_; int K_; EpiG2 epi_; epi_.m0 = m0_##A_; epi_.n0 = n0_##A_; epi_.outb = nullptr; epi_.outf = nullptr; epi_.bias = nullptr; \
        if (gsel_##A_ == 0) { A_ = p.LH; B_ = p.g2T + (size_t)n0_##A_ * 128; K_ = 128; epi_.kind = 0; epi_.outb = p.G; } \
        else if (gsel_##A_ <= 2) { const int d = gsel_##A_ - 1; A_ = p.LH + 128 + 64 * d; B_ = p.w2T + (size_t)d * 65536 + (size_t)n0_##A_ * 64; K_ = 64; epi_.kind = 1; epi_.outf = d ? p.W1 : p.W0; epi_.bias = p.rw_w0 + d * 1024; } \
        else { const int d = gsel_##A_ - 3; A_ = p.LH + 256 + 64 * d; B_ = p.a2T + (size_t)d * 65536 + (size_t)n0_##A_ * 64; K_ = 64; epi_.kind = 2; epi_.outb = d ? p.AD1 : p.AD0; epi_.bias = p.rw_a0 + d * 1024; } \
        A_ += (size_t)m0_##A_ * 384 + G3_CH8; B_ += G3_CH8
    bool pre = false;
    for (int tile = cx.bid; tile < 132 * 40; tile += cx.nb) {
        G2_DESC(tile, A, B, K, epi);
        const int tn = tile + cx.nb; const bool hn = tn < 132 * 40;
        G2_DESC(hn ? tn : tile, An, Bn, Kn, epin); (void)epin;
        G3Next nx; nx.has = hn; nx.a0 = An + (size_t)G3_ROW(0) * 384; nx.a1 = An + (size_t)G3_ROW(1) * 384; nx.b0 = Bn + (size_t)G3_ROW(0) * Kn; nx.b1 = Bn + (size_t)G3_ROW(1) * Kn; nx.K = Kn;
        gemm3_tile(cx, A + (size_t)G3_ROW(0) * 384, A + (size_t)G3_ROW(1) * 384,
                   B + (size_t)G3_ROW(0) * K, B + (size_t)G3_ROW(1) * K, K, epi, lds, pre, nx);
        pre = hn;
    }
#undef G2_DESC
}
__device__ __forceinline__ void ph_prep(const Ctx cx, PRef p) { (void)cx; (void)p; }
#define NCHUNK 132
#define CH_ROW 72
#define L_AT 0
#define L_BT 9216
#define L_KT 18432
#define L_RT 27648
#define L_BH 36864
#define L_KH 46080
#define L_VT 55296
#define L_AAB 64512
#define L_PC 80896
#define L_X2 L_AT
#define L_UT L_KT
#define L_WT L_KH
#define S1_LDS_BYTES (80896 + 256)
__device__ __forceinline__ void chunk_rows(int b, int dir, int n, int& rbase, int& sgn) {
    sgn = dir ? -1 : 1;
    if (n < 4) { const int t0 = 64 * n; rbase = ROWS_LAT + b * LCTX + (dir ? (LCTX - 1 - t0) : t0); }
    else { const int t0 = 64 * (n - 4); rbase = b * TLAT + (dir ? (TLAT - 1 - t0) : t0); }
}
__device__ __forceinline__ bf16x8 pack8(const f32x4& a, const f32x4& b) {
    uint4 u; u.x = pack2(a[0], a[1]); u.y = pack2(a[2], a[3]); u.z = pack2(b[0], b[1]); u.w = pack2(b[2], b[3]);
    return *(bf16x8*)&u;
}
__device__ __forceinline__ void mm64(f32x4 (&acc)[4][4], const bf16_t* X, const bf16_t* Y, int l15, int g) {
    bf16x8 yf[4][2];
#pragma unroll
    for (int yt = 0; yt < 4; ++yt) { yf[yt][0] = *(const bf16x8*)(Y + (16 * yt + l15) * CH_ROW + 8 * g); yf[yt][1] = *(const bf16x8*)(Y + (16 * yt + l15) * CH_ROW + 32 + 8 * g); }
#pragma unroll
    for (int xt = 0; xt < 4; ++xt) {
        const bf16x8 x0 = *(const bf16x8*)(X + (16 * xt + l15) * CH_ROW + 8 * g), x1 = *(const bf16x8*)(X + (16 * xt + l15) * CH_ROW + 32 + 8 * g);
#pragma unroll
        for (int yt = 0; yt < 4; ++yt) {
            acc[xt][yt] = __builtin_amdgcn_mfma_f32_16x16x32_bf16(x0, yf[yt][0], acc[xt][yt], 0, 0, 0);
            acc[xt][yt] = __builtin_amdgcn_mfma_f32_16x16x32_bf16(x1, yf[yt][1], acc[xt][yt], 0, 0, 0);
        }
    }
}
__device__ __forceinline__ void mm64_accB(f32x4 (&out)[4][4], const bf16_t* X, const f32x4 (&acc)[4][4], int l15, int g) {
#pragma unroll
    for (int js = 0; js < 2; ++js) {
        bf16x8 bfr[4];
#pragma unroll
        for (int tt = 0; tt < 4; ++tt) bfr[tt] = pack8(acc[2 * js][tt], acc[2 * js + 1][tt]);
#pragma unroll
        for (int xt = 0; xt < 4; ++xt) {
            const bf16_t* xp = X + (16 * xt + l15) * CH_ROW + 32 * js + 4 * g;
            const uint2 lo = *(const uint2*)xp, hi = *(const uint2*)(xp + 16);
            uint4 u; u.x = lo.x; u.y = lo.y; u.z = hi.x; u.w = hi.y;
            const bf16x8 af = *(bf16x8*)&u;
#pragma unroll
            for (int tt = 0; tt < 4; ++tt) out[xt][tt] = __builtin_amdgcn_mfma_f32_16x16x32_bf16(af, bfr[tt], out[xt][tt], 0, 0, 0);
        }
    }
}
__device__ __forceinline__ void zero44(f32x4 (&a)[4][4]) {
#pragma unroll
    for (int i = 0; i < 4; ++i)
#pragma unroll
        for (int j = 0; j < 4; ++j) a[i][j] = (f32x4){0.f, 0.f, 0.f, 0.f};
}
__device__ __forceinline__ void mask44(f32x4 (&a)[4][4], int l15, int g, bool strict) {
#pragma unroll
    for (int jt = 0; jt < 4; ++jt)
#pragma unroll
        for (int tt = 0; tt < 4; ++tt)
#pragma unroll
            for (int r = 0; r < 4; ++r) {
                const int j = 16 * jt + 4 * g + r, t = 16 * tt + l15;
                const bool keep = strict ? (j < t) : (j <= t);
                a[jt][tt][r] = keep ? a[jt][tt][r] : 0.f;
            }
}
__host__ __device__ constexpr int fsub_qp(int J) { return J < 24 ? 10 : 16; }
template <int J> __device__ __forceinline__ void fsub_col(float (&z)[64], const float* AabT, const float4 (&cur)[16]) {
    float4 nxt[16];
    if constexpr (J < 62) {
#pragma unroll
        for (int q = (J + 2) / 4; q < fsub_qp(J); ++q) nxt[q] = *(const float4*)(AabT + (J + 1) * 64 + 4 * q);
    }
    const float zj = z[J];
    constexpr int QV = J == 0 ? 16 : fsub_qp(J - 1);
#pragma unroll
    for (int q = (J + 1) / 4; q < 16; ++q) {
        const float4 c4 = q < QV ? cur[q] : *(const float4*)(AabT + J * 64 + 4 * q);
        if (4 * q + 0 > J) z[4 * q + 0] += c4.x * zj;
        if (4 * q + 1 > J) z[4 * q + 1] += c4.y * zj;
        if (4 * q + 2 > J) z[4 * q + 2] += c4.z * zj;
        if (4 * q + 3 > J) z[4 * q + 3] += c4.w * zj;
    }
#define ZPIN16(a) asm volatile("" : "+v"(z[a]), "+v"(z[a+1]), "+v"(z[a+2]), "+v"(z[a+3]), "+v"(z[a+4]), "+v"(z[a+5]), "+v"(z[a+6]), "+v"(z[a+7]), \
                                    "+v"(z[a+8]), "+v"(z[a+9]), "+v"(z[a+10]), "+v"(z[a+11]), "+v"(z[a+12]), "+v"(z[a+13]), "+v"(z[a+14]), "+v"(z[a+15]) :: "memory")
    if constexpr (J < 15) ZPIN16(0);
    if constexpr (J < 31) ZPIN16(16);
    if constexpr (J < 47) ZPIN16(32);
    ZPIN16(48);
#undef ZPIN16
    if constexpr (J < 62) fsub_col<J + 1>(z, AabT, nxt);
}
__device__ __forceinline__ void s1_diag_inverse(const bf16_t* Abf, bf16_t* TD, int lane) {
    const int bi = lane >> 4, c = lane & 15;
    float z[16];
#pragma unroll
    for (int t = 0; t < 16; ++t) {
        const uint4 u0 = *(const uint4*)(Abf + (16 * bi + t) * CH_ROW + 16 * bi), u1 = *(const uint4*)(Abf + (16 * bi + t) * CH_ROW + 16 * bi + 8);
        const unsigned uw[8] = {u0.x, u0.y, u0.z, u0.w, u1.x, u1.y, u1.z, u1.w};
        float acc_ = (t == c) ? 1.f : 0.f;
#pragma unroll
        for (int j = 0; j < t; ++j) acc_ += ((j & 1) ? bfhi(uw[j >> 1]) : bflo(uw[j >> 1])) * z[j];
        z[t] = acc_;
        TD[(16 * bi + t) * 24 + c] = f2bf(acc_);
    }
}
__device__ __forceinline__ void s1_load_slab(f32x4 (&Rs)[4][2], const bf16_t* X, int cb, int l15, int g) {
#pragma unroll
    for (int i = 0; i < 4; ++i)
#pragma unroll
        for (int ct = 0; ct < 2; ++ct)
#pragma unroll
            for (int r = 0; r < 4; ++r) Rs[i][ct][r] = bflo((unsigned)X[(16 * i + 4 * g + r) * CH_ROW + cb + 16 * ct + l15]);
}
__device__ __forceinline__ void s1_x2_slab(f32x4 (&Rs)[4][2], const bf16_t* Kbf, const bf16_t* VT, int vb, int l15, int g) {
#pragma unroll
    for (int i = 0; i < 4; ++i) { Rs[i][0] = (f32x4){0.f, 0.f, 0.f, 0.f}; Rs[i][1] = (f32x4){0.f, 0.f, 0.f, 0.f}; }
#pragma unroll
    for (int ks = 0; ks < 2; ++ks) {
        const bf16x8 v0 = *(const bf16x8*)(VT + (vb + l15) * CH_ROW + 32 * ks + 8 * g), v1 = *(const bf16x8*)(VT + (vb + 16 + l15) * CH_ROW + 32 * ks + 8 * g);
#pragma unroll
        for (int i = 0; i < 4; ++i) {
            const bf16x8 kf = *(const bf16x8*)(Kbf + (16 * i + l15) * CH_ROW + 32 * ks + 8 * g);
            Rs[i][0] = __builtin_amdgcn_mfma_f32_16x16x32_bf16(kf, v0, Rs[i][0], 0, 0, 0);
            Rs[i][1] = __builtin_amdgcn_mfma_f32_16x16x32_bf16(kf, v1, Rs[i][1], 0, 0, 0);
        }
    }
}
__device__ __forceinline__ void s1_slab_solve(f32x4 (&Rs)[4][2], const bf16_t* Abf, const bf16_t* TD, bf16_t* XT, int l15, int g) {
#pragma unroll
    for (int i = 0; i < 4; ++i) {
        f32x4 X0 = Rs[i][0], X1 = Rs[i][1];
#pragma unroll
        for (int j = 0; j < i; ++j) {
            const uint2 av = *(const uint2*)(Abf + (16 * i + l15) * CH_ROW + 16 * j + 4 * g);
            uint4 ua; ua.x = av.x; ua.y = av.y; ua.z = 0u; ua.w = 0u;
            uint4 ub0, ub1; ub0.x = pack2(Rs[j][0][0], Rs[j][0][1]); ub0.y = pack2(Rs[j][0][2], Rs[j][0][3]); ub0.z = 0u; ub0.w = 0u;
            ub1.x = pack2(Rs[j][1][0], Rs[j][1][1]); ub1.y = pack2(Rs[j][1][2], Rs[j][1][3]); ub1.z = 0u; ub1.w = 0u;
            X0 = __builtin_amdgcn_mfma_f32_16x16x32_bf16(*(bf16x8*)&ua, *(bf16x8*)&ub0, X0, 0, 0, 0);
            X1 = __builtin_amdgcn_mfma_f32_16x16x32_bf16(*(bf16x8*)&ua, *(bf16x8*)&ub1, X1, 0, 0, 0);
        }
        const uint2 tv = *(const uint2*)(TD + (16 * i + l15) * 24 + 4 * g);
        uint4 ut; ut.x = tv.x; ut.y = tv.y; ut.z = 0u; ut.w = 0u;
        uint4 ux0, ux1; ux0.x = pack2(X0[0], X0[1]); ux0.y = pack2(X0[2], X0[3]); ux0.z = 0u; ux0.w = 0u;
        ux1.x = pack2(X1[0], X1[1]); ux1.y = pack2(X1[2], X1[3]); ux1.z = 0u; ux1.w = 0u;
        const f32x4 zz = (f32x4){0.f, 0.f, 0.f, 0.f};
        Rs[i][0] = __builtin_amdgcn_mfma_f32_16x16x32_bf16(*(bf16x8*)&ut, *(bf16x8*)&ux0, zz, 0, 0, 0);
        Rs[i][1] = __builtin_amdgcn_mfma_f32_16x16x32_bf16(*(bf16x8*)&ut, *(bf16x8*)&ux1, zz, 0, 0, 0);
    }
#pragma unroll
    for (int i = 0; i < 4; ++i)
#pragma unroll
        for (int ct = 0; ct < 2; ++ct) { uint2 o; o.x = pack2(Rs[i][ct][0], Rs[i][ct][1]); o.y = pack2(Rs[i][ct][2], Rs[i][ct][3]); *(uint2*)(XT + (16 * ct + l15) * CH_ROW + 16 * i + 4 * g) = o; }
}
__device__ __forceinline__ void ph_s1(const Ctx cx, PRef p, char* lds) {
    const int wave = (__builtin_amdgcn_readfirstlane(cx.tid >> 6) + 2 * (cx.bid & 1)) & 3;
    for (int pairi = cx.bid >> 1; pairi < 32 * NCHUNK; pairi += cx.nb >> 1) {
        int lz = 0; asm volatile("" : "+v"(lz));
        char* ldsb = lds + lz;
        bf16_t* At = (bf16_t*)(ldsb + L_AT); bf16_t* Bt = (bf16_t*)(ldsb + L_BT); bf16_t* Kt = (bf16_t*)(ldsb + L_KT); bf16_t* Rt = (bf16_t*)(ldsb + L_RT);
        bf16_t* BhT = (bf16_t*)(ldsb + L_BH); bf16_t* KhT = (bf16_t*)(ldsb + L_KH); bf16_t* VT = (bf16_t*)(ldsb + L_VT);
        float* Aab = (float*)(ldsb + L_AAB); float* pcl = (float*)(ldsb + L_PC); float* X2 = (float*)(ldsb + L_X2);
        bf16_t* UT = (bf16_t*)(ldsb + L_UT); bf16_t* WT = (bf16_t*)(ldsb + L_WT);
        int tid = cx.tid; asm volatile("" : "+v"(tid));
        const int lane = tid & 63, l15 = lane & 15, g = lane >> 4;
        const int bh_ = pairi / NCHUNK, cc_ = pairi % NCHUNK, dir = cx.bid & 1;
        const int chain = bh_ * 2 + dir, n = dir ? (cc_ < 4 ? 3 - cc_ : 135 - cc_) : cc_, task = chain * NCHUNK + n;
        const int h = (chain >> 1) & 15, b = chain >> 5;
        int rbase, sgn; chunk_rows(b, dir, n, rbase, sgn);
        const float* Wd = dir ? p.W1 : p.W0; const bf16_t* ADd = dir ? p.AD1 : p.AD0;
        {
            const int kq = lane & 15, gq = lane >> 4;
            f32x4 wv[4], kkv[4]; uint2 adv[4], kvv[4], rvv[4], vvv[4];
#pragma unroll
            for (int i = 0; i < 4; ++i) {
                const size_t off = (size_t)(rbase + sgn * (16 * wave + 4 * gq + i)) * DM + h * 64 + 4 * kq;
                wv[i] = *(const f32x4*)(Wd + off); kkv[i] = *(const f32x4*)(p.KK + off);
                adv[i] = *(const uint2*)(ADd + off); kvv[i] = *(const uint2*)(p.K + off); rvv[i] = *(const uint2*)(p.R + off); vvv[i] = *(const uint2*)(p.V + off);
            }
            f32x4 lp[4];
            lp[0] = wv[0]; lp[1] = lp[0] * wv[1]; lp[2] = lp[1] * wv[2]; lp[3] = lp[2] * wv[3];
            f32x4 eg = (f32x4){1.f, 1.f, 1.f, 1.f}, wt = (f32x4){1.f, 1.f, 1.f, 1.f};
#pragma unroll
            for (int g2 = 0; g2 < 4; ++g2)
#pragma unroll
                for (int c = 0; c < 4; ++c) {
                    const float tv = __int_as_float(shidx(__float_as_int(lp[3][c]), kq + 16 * g2));
                    eg[c] = (g2 < gq) ? eg[c] * tv : eg[c]; wt[c] *= tv;
                }
            if (gq == 0) *(f32x4*)(Aab + wave * 64 + 4 * kq) = wt;
            __syncthreads();
            f32x4 prefix = eg, pC = (f32x4){1.f, 1.f, 1.f, 1.f};
#pragma unroll
            for (int w2 = 0; w2 < 4; ++w2) { const f32x4 tv = *(const f32x4*)(Aab + w2 * 64 + 4 * kq); if (w2 < wave) prefix = prefix * tv; pC = pC * tv; }
            if (wave == 0 && gq == 0) *(f32x4*)(pcl + 4 * kq) = pC;
            const f32x4 ka = *(const f32x4*)(p.rw_ka + h * 64 + 4 * kq);
            float bh[4][4], kh[4][4];
#pragma unroll
            for (int i = 0; i < 4; ++i) {
                const int t = 16 * wave + 4 * gq + i;
                const float adf[4] = {bflo(adv[i].x), bfhi(adv[i].x), bflo(adv[i].y), bfhi(adv[i].y)};
                const float kvf[4] = {bflo(kvv[i].x), bfhi(kvv[i].x), bflo(kvv[i].y), bfhi(kvv[i].y)};
                const float rvf[4] = {bflo(rvv[i].x), bfhi(rvv[i].x), bflo(rvv[i].y), bfhi(rvv[i].y)};
                float at[4], bt[4], kt[4], rt[4];
#pragma unroll
                for (int c = 0; c < 4; ++c) {
                    const float pt = prefix[c] * lp[i][c], pprev = i ? prefix[c] * lp[i ? i - 1 : 0][c] : prefix[c];
                    const float ip = __builtin_amdgcn_rcpf(pt);
                    at[c] = -kkv[i][c] * pprev; bt[c] = kkv[i][c] * adf[c] * ip; kt[c] = kvf[c] * (1.f + (adf[c] - 1.f) * ka[c]) * ip; rt[c] = rvf[c] * pt;
                    bh[i][c] = bt[c] * pC[c]; kh[i][c] = kt[c] * pC[c];
                }
                uint2 o;
                o.x = pack2(at[0], at[1]); o.y = pack2(at[2], at[3]); *(uint2*)(At + t * CH_ROW + 4 * kq) = o;
                o.x = pack2(bt[0], bt[1]); o.y = pack2(bt[2], bt[3]); *(uint2*)(Bt + t * CH_ROW + 4 * kq) = o;
                o.x = pack2(kt[0], kt[1]); o.y = pack2(kt[2], kt[3]); *(uint2*)(Kt + t * CH_ROW + 4 * kq) = o;
                o.x = pack2(rt[0], rt[1]); o.y = pack2(rt[2], rt[3]); *(uint2*)(Rt + t * CH_ROW + 4 * kq) = o;
            }
#pragma unroll
            for (int c = 0; c < 4; ++c) {
                const int col = 16 * wave + 4 * gq;
                uint2 o;
                o.x = pack2(bh[0][c], bh[1][c]); o.y = pack2(bh[2][c], bh[3][c]); *(uint2*)(BhT + (4 * kq + c) * CH_ROW + col) = o;
                o.x = pack2(kh[0][c], kh[1][c]); o.y = pack2(kh[2][c], kh[3][c]); *(uint2*)(KhT + (4 * kq + c) * CH_ROW + col) = o;
                const unsigned v0 = (c & 1) ? (((c >> 1) ? vvv[0].y : vvv[0].x) >> 16) : (((c >> 1) ? vvv[0].y : vvv[0].x) & 0xffffu);
                const unsigned v1 = (c & 1) ? (((c >> 1) ? vvv[1].y : vvv[1].x) >> 16) : (((c >> 1) ? vvv[1].y : vvv[1].x) & 0xffffu);
                const unsigned v2 = (c & 1) ? (((c >> 1) ? vvv[2].y : vvv[2].x) >> 16) : (((c >> 1) ? vvv[2].y : vvv[2].x) & 0xffffu);
                const unsigned v3 = (c & 1) ? (((c >> 1) ? vvv[3].y : vvv[3].x) >> 16) : (((c >> 1) ? vvv[3].y : vvv[3].x) & 0xffffu);
                o.x = v0 | (v1 << 16); o.y = v2 | (v3 << 16); *(uint2*)(VT + (4 * kq + c) * CH_ROW + col) = o;
            }
        }
        __syncthreads();
        const size_t tb = (size_t)task * 4096;
        bf16_t* Abf = (bf16_t*)(ldsb + L_AAB);
        bf16_t* TD = (bf16_t*)(ldsb + L_AAB + 9216);
        bf16_t* Kbf = Bt;
        if (wave == 0) {
            f32x4 Rs[4][2];
            {
                f32x4 accP[4][4]; zero44(accP);
                mm64(accP, Bt, At, l15, g); mask44(accP, l15, g, true);
#pragma unroll
                for (int xt = 0; xt < 4; ++xt)
#pragma unroll
                    for (int yt = 0; yt < 4; ++yt) { uint2 o; o.x = pack2(accP[xt][yt][0], accP[xt][yt][1]); o.y = pack2(accP[xt][yt][2], accP[xt][yt][3]); *(uint2*)(Abf + (16 * yt + l15) * CH_ROW + 16 * xt + 4 * g) = o; }
            }
            s1_diag_inverse(Abf, TD, lane);
            __syncthreads();
            s1_load_slab(Rs, At, 0, l15, g);
            __syncthreads();
            s1_slab_solve(Rs, Abf, TD, WT, l15, g);
            __syncthreads();
            {
                f32x4 accM[4][4]; zero44(accM);
                mm64(accM, WT, BhT, l15, g);
#pragma unroll
                for (int kpt = 0; kpt < 4; ++kpt)
#pragma unroll
                    for (int kt = 0; kt < 4; ++kt) {
                        const int k = 16 * kt + l15;
                        const float pc = pcl[k];
                        float v[4];
#pragma unroll
                        for (int r = 0; r < 4; ++r) v[r] = accM[kpt][kt][r] + ((16 * kpt + 4 * g + r) == k ? pc : 0.f);
                        uint2 o; o.x = pack2(v[0], v[1]); o.y = pack2(v[2], v[3]);
                        *(uint2*)(p.CM + tb + k * 64 + 32 * (kpt >> 1) + 8 * g + 4 * (kpt & 1)) = o;
                    }
            }
            __syncthreads();
        } else if (wave == 1) {
            f32x4 Rs[4][2];
            {
                f32x4 accA[4][4]; zero44(accA);
                mm64(accA, Kt, At, l15, g); mask44(accA, l15, g, true);
                __syncthreads();
#pragma unroll
                for (int xt = 0; xt < 4; ++xt)
#pragma unroll
                    for (int yt = 0; yt < 4; ++yt) { uint2 o; o.x = pack2(accA[xt][yt][0], accA[xt][yt][1]); o.y = pack2(accA[xt][yt][2], accA[xt][yt][3]); *(uint2*)(Kbf + (16 * yt + l15) * CH_ROW + 16 * xt + 4 * g) = o; }
            }
            s1_load_slab(Rs, At, 32, l15, g);
            __syncthreads();
            s1_slab_solve(Rs, Abf, TD, WT + 32 * CH_ROW, l15, g);
            __syncthreads();
            __syncthreads();
        } else if (wave == 2) {
            f32x4 accP[4][4], accQ[4][4];
            zero44(accP); zero44(accQ);
            mm64(accP, Kt, Rt, l15, g); mask44(accP, l15, g, false);
            mm64_accB(accQ, VT, accP, l15, g);
            zero44(accP);
            mm64(accP, Bt, Rt, l15, g); mask44(accP, l15, g, false);
            __syncthreads();
            __syncthreads();
            {
                f32x4 Rs[4][2];
                s1_x2_slab(Rs, Kbf, VT, 0, l15, g);
                s1_slab_solve(Rs, Abf, TD, UT, l15, g);
            }
            __syncthreads();
            mm64_accB(accQ, UT, accP, l15, g);
#pragma unroll
            for (int vt = 0; vt < 4; ++vt)
#pragma unroll
                for (int tt = 0; tt < 4; ++tt) {
                    uint2 o; o.x = pack2(accQ[vt][tt][0], accQ[vt][tt][1]); o.y = pack2(accQ[vt][tt][2], accQ[vt][tt][3]);
                    *(uint2*)(p.CY + tb + (16 * tt + l15) * 64 + 16 * vt + 4 * g) = o;
                }
            zero44(accQ);
            mm64_accB(accQ, WT, accP, l15, g);
#pragma unroll
            for (int kt = 0; kt < 4; ++kt)
#pragma unroll
                for (int tt = 0; tt < 4; ++tt) {
                    const uint2 rr = *(const uint2*)(Rt + (16 * tt + l15) * CH_ROW + 16 * kt + 4 * g);
                    uint2 o; o.x = pack2(accQ[kt][tt][0] + bflo(rr.x), accQ[kt][tt][1] + bfhi(rr.x)); o.y = pack2(accQ[kt][tt][2] + bflo(rr.y), accQ[kt][tt][3] + bfhi(rr.y));
                    *(uint2*)(p.CR + tb + (16 * tt + l15) * 64 + 16 * kt + 4 * g) = o;
                }
            __syncthreads();
        } else {
            f32x4 accP[4][4];
            zero44(accP);
            mm64(accP, KhT, VT, l15, g);
            __syncthreads();
            __syncthreads();
            {
                f32x4 Rs[4][2];
                s1_x2_slab(Rs, Kbf, VT, 32, l15, g);
                s1_slab_solve(Rs, Abf, TD, UT + 32 * CH_ROW, l15, g);
            }
            __syncthreads();
            mm64(accP, BhT, UT, l15, g);
#pragma unroll
            for (int kt = 0; kt < 4; ++kt)
#pragma unroll
                for (int vt = 0; vt < 4; ++vt) {
                    uint2 o; o.x = pack2(accP[kt][vt][0], accP[kt][vt][1]); o.y = pack2(accP[kt][vt][2], accP[kt][vt][3]);
                    *(uint2*)(p.CN + tb + (16 * vt + l15) * 64 + 16 * kt + 4 * g) = o;
                }
            __syncthreads();
        }
    }
}
#define S2_PF 4
__device__ __forceinline__ void s2_body(const Ctx cx, PRef p) {
    const int lane = cx.tid & 63, l15 = lane & 15, g = lane >> 4;
    const int item = cx.bid, chain = item >> 2, vs = (item & 3) * 16;
    const bf16_t* Mb = p.CM + (size_t)chain * NCHUNK * 4096;
    const bf16_t* Nb = p.CN + (size_t)chain * NCHUNK * 4096 + (vs + l15) * 64 + 4 * g;
    bf16_t* Sb = p.CS + (size_t)chain * NCHUNK * 4096 + (vs + l15) * 64 + 4 * g;
    f32x4 sacc[4];
#pragma unroll
    for (int kt = 0; kt < 4; ++kt) sacc[kt] = (f32x4){0.f, 0.f, 0.f, 0.f};
    uint4 mreg[S2_PF][8]; uint2 nreg[S2_PF][4];
    auto ldstep = [&](int slot, int n) {
#pragma unroll
        for (int kt = 0; kt < 4; ++kt) {
            mreg[slot][2 * kt] = *(const uint4*)(Mb + (size_t)n * 4096 + (16 * kt + l15) * 64 + 8 * g);
            mreg[slot][2 * kt + 1] = *(const uint4*)(Mb + (size_t)n * 4096 + (16 * kt + l15) * 64 + 32 + 8 * g);
            nreg[slot][kt] = *(const uint2*)(Nb + (size_t)n * 4096 + 16 * kt);
        }
    };
#pragma unroll
    for (int s2 = 0; s2 < S2_PF; ++s2) ldstep(s2, s2);
    for (int n0 = 0; n0 < NCHUNK; n0 += S2_PF) {
#pragma unroll
        for (int s2 = 0; s2 < S2_PF; ++s2) {
            const int n = n0 + s2;
#pragma unroll
            for (int kt = 0; kt < 4; ++kt) { uint2 o; o.x = pack2(sacc[kt][0], sacc[kt][1]); o.y = pack2(sacc[kt][2], sacc[kt][3]); *(uint2*)(Sb + (size_t)n * 4096 + 16 * kt) = o; }
            const bf16x8 sb0 = pack8(sacc[0], sacc[1]), sb1 = pack8(sacc[2], sacc[3]);
#pragma unroll
            for (int kt = 0; kt < 4; ++kt) {
                f32x4 a; a[0] = bflo(nreg[s2][kt].x); a[1] = bfhi(nreg[s2][kt].x); a[2] = bflo(nreg[s2][kt].y); a[3] = bfhi(nreg[s2][kt].y);
                a = __builtin_amdgcn_mfma_f32_16x16x32_bf16(*(bf16x8*)&mreg[s2][2 * kt], sb0, a, 0, 0, 0);
                a = __builtin_amdgcn_mfma_f32_16x16x32_bf16(*(bf16x8*)&mreg[s2][2 * kt + 1], sb1, a, 0, 0, 0);
                sacc[kt] = a;
            }
            if (n + S2_PF < NCHUNK) ldstep(s2, n + S2_PF);
        }
    }
}
#define S2R_SLOTS 8
#define S2R_AHEAD 7
__device__ __forceinline__ void s2_ring(const Ctx px, PRef p, char* lds) {
    const int wv = __builtin_amdgcn_readfirstlane(px.tid >> 6), lane = px.tid & 63, l15 = lane & 15, g = lane >> 4;
    const int chain = px.bid;
    const bf16_t* Mb = p.CM + (size_t)chain * NCHUNK * 4096;
    const bf16_t* Nb = p.CN + (size_t)chain * NCHUNK * 4096;
    if (wv >= 4) {
        const int lw = wv - 4;
        unsigned so[2];
#pragma unroll
        for (int i = 0; i < 2; ++i) { const int sl = lw * 128 + i * 64 + lane, row = sl >> 3, cp = sl & 7; so[i] = (unsigned)(row * 64 + ((cp ^ (row & 7)) * 8)); }
        auto issue = [&](int n) {
            char* slot = lds + (n & (S2R_SLOTS - 1)) * 16384 + lw * 2048;
            glds16(Mb + (size_t)n * 4096 + so[0], slot); glds16(Mb + (size_t)n * 4096 + so[1], slot + 1024);
            glds16(Nb + (size_t)n * 4096 + so[0], slot + 8192); glds16(Nb + (size_t)n * 4096 + so[1], slot + 8192 + 1024);
        };
        for (int n = 0; n < S2R_AHEAD; ++n) issue(n);
        asm volatile("s_waitcnt vmcnt(24)" ::: "memory");
        __builtin_amdgcn_s_barrier();
        for (int n = 0; n < NCHUNK; ++n) {
            if (n + S2R_AHEAD < NCHUNK) { issue(n + S2R_AHEAD); asm volatile("s_waitcnt vmcnt(24)" ::: "memory"); }
            else asm volatile("s_waitcnt vmcnt(0)" ::: "memory");
            __builtin_amdgcn_s_barrier();
        }
    } else {
        const int vs = wv * 16;
        bf16_t* Sb = p.CS + (size_t)chain * NCHUNK * 4096 + (vs + l15) * 64 + 4 * g;
        f32x4 sacc[4];
#pragma unroll
        for (int kt = 0; kt < 4; ++kt) sacc[kt] = (f32x4){0.f, 0.f, 0.f, 0.f};
        __builtin_amdgcn_s_barrier();
        for (int n = 0; n < NCHUNK; ++n) {
            const char* slot = lds + (n & (S2R_SLOTS - 1)) * 16384;
            bf16x8 mf[8]; uint2 nf[4];
#pragma unroll
            for (int kt = 0; kt < 4; ++kt) {
                const int row = 16 * kt + l15;
                mf[2 * kt] = *(const bf16x8*)(slot + row * 128 + ((g ^ (row & 7)) << 4));
                mf[2 * kt + 1] = *(const bf16x8*)(slot + row * 128 + (((4 + g) ^ (row & 7)) << 4));
                const int nrow = vs + l15;
                nf[kt] = *(const uint2*)(slot + 8192 + nrow * 128 + (((2 * kt + (g >> 1)) ^ (nrow & 7)) << 4) + (g & 1) * 8);
            }
#pragma unroll
            for (int kt = 0; kt < 4; ++kt) { uint2 o; o.x = pack2(sacc[kt][0], sacc[kt][1]); o.y = pack2(sacc[kt][2], sacc[kt][3]); *(uint2*)(Sb + (size_t)n * 4096 + 16 * kt) = o; }
            const bf16x8 sb0 = pack8(sacc[0], sacc[1]), sb1 = pack8(sacc[2], sacc[3]);
#pragma unroll
            for (int kt = 0; kt < 4; ++kt) {
                f32x4 a2; a2[0] = bflo(nf[kt].x); a2[1] = bfhi(nf[kt].x); a2[2] = bflo(nf[kt].y); a2[3] = bfhi(nf[kt].y);
                a2 = __builtin_amdgcn_mfma_f32_16x16x32_bf16(mf[2 * kt], sb0, a2, 0, 0, 0);
                a2 = __builtin_amdgcn_mfma_f32_16x16x32_bf16(mf[2 * kt + 1], sb1, a2, 0, 0, 0);
                sacc[kt] = a2;
            }
            asm volatile("s_waitcnt lgkmcnt(0)" ::: "memory");
            __builtin_amdgcn_s_barrier();
        }
    }
}
__device__ __forceinline__ void ph_s2(const Ctx px, const Ctx cx, PRef p, char* ldsv, char* ldsq) {
    if (px.bid < 64) {
        s2_ring(px, p, ldsq);
    } else {
        conv_small(cx, p, ldsv, 960, 1856, cx.bid - 128, cx.nb - 128);
        conv_moe(cx, p, ldsv, cx.bid - 128, cx.nb - 128);
    }
}
__device__ __forceinline__ void ph_s3o(const Ctx cx, PRef p) {
    const int lane = cx.tid & 63, tt = cx.tid >> 6, l15 = lane & 15, g = lane >> 4;
    for (int task = cx.bid; task < 32 * NCHUNK; task += cx.nb) {
        const int bh = task / NCHUNK, cc = task % NCHUNK, h = bh & 15, b = bh >> 4;
        const int t = 16 * tt + l15;
        const size_t tbf = ((size_t)(bh * 2) * NCHUNK + cc) * 4096;
        const size_t tbb = ((size_t)(bh * 2 + 1) * NCHUNK + (cc < 4 ? 3 - cc : 135 - cc)) * 4096;
        const int tb_ = 63 - t;
        const bf16x8 rf0 = *(const bf16x8*)(p.CR + tbf + t * 64 + 8 * g), rf1 = *(const bf16x8*)(p.CR + tbf + t * 64 + 32 + 8 * g);
        const bf16x8 rb0 = *(const bf16x8*)(p.CR + tbb + tb_ * 64 + 8 * g), rb1 = *(const bf16x8*)(p.CR + tbb + tb_ * 64 + 32 + 8 * g);
        const int row = cc < 4 ? ROWS_LAT + b * LCTX + 64 * cc + t : b * TLAT + 64 * (cc - 4) + t;
        const size_t off = (size_t)row * DM + h * 64 + 4 * g;
        float4 rkw4[4], lg4[4], lb4[4];
#pragma unroll
        for (int vt = 0; vt < 4; ++vt) { rkw4[vt] = *(const float4*)(p.rw_rk + h * 64 + 16 * vt + 4 * g); lg4[vt] = *(const float4*)(p.rw_lnx_g + h * 64 + 16 * vt + 4 * g); lb4[vt] = *(const float4*)(p.rw_lnx_b + h * 64 + 16 * vt + 4 * g); }
        uint2 ur4[4], uk4[4], uv4[4], ug4[4];
#pragma unroll
        for (int vt = 0; vt < 4; ++vt) { ur4[vt] = *(const uint2*)(p.R + off + 16 * vt); uk4[vt] = *(const uint2*)(p.K + off + 16 * vt); uv4[vt] = *(const uint2*)(p.V + off + 16 * vt); ug4[vt] = *(const uint2*)(p.G + off + 16 * vt); }
        f32x4 y[4];
#pragma unroll
        for (int vt = 0; vt < 4; ++vt) {
            const bf16x8 sf0 = *(const bf16x8*)(p.CS + tbf + (16 * vt + l15) * 64 + 8 * g), sf1 = *(const bf16x8*)(p.CS + tbf + (16 * vt + l15) * 64 + 32 + 8 * g);
            const bf16x8 sb0 = *(const bf16x8*)(p.CS + tbb + (16 * vt + l15) * 64 + 8 * g), sb1 = *(const bf16x8*)(p.CS + tbb + (16 * vt + l15) * 64 + 32 + 8 * g);
            const uint2 yf = *(const uint2*)(p.CY + tbf + t * 64 + 16 * vt + 4 * g), yb = *(const uint2*)(p.CY + tbb + tb_ * 64 + 16 * vt + 4 * g);
            f32x4 a; a[0] = bflo(yf.x) + bflo(yb.x); a[1] = bfhi(yf.x) + bfhi(yb.x); a[2] = bflo(yf.y) + bflo(yb.y); a[3] = bfhi(yf.y) + bfhi(yb.y);
            a = __builtin_amdgcn_mfma_f32_16x16x32_bf16(sf0, rf0, a, 0, 0, 0);
            a = __builtin_amdgcn_mfma_f32_16x16x32_bf16(sf1, rf1, a, 0, 0, 0);
            a = __builtin_amdgcn_mfma_f32_16x16x32_bf16(sb0, rb0, a, 0, 0, 0);
            a = __builtin_amdgcn_mfma_f32_16x16x32_bf16(sb1, rb1, a, 0, 0, 0);
            y[vt] = a;
        }
        float s = 0.f;
#pragma unroll
        for (int vt = 0; vt < 4; ++vt) s += (y[vt][0] + y[vt][1]) + (y[vt][2] + y[vt][3]);
        s += shx(s, 16, lane); s += shx(s, 32, lane);
        const float mu = s * (1.f / 64.f);
        float q2 = 0.f, rk = 0.f;
        float rr[4][4], vv[4][4], gg[4][4];
#pragma unroll
        for (int vt = 0; vt < 4; ++vt) {
            const uint2 ur = ur4[vt], uk = uk4[vt], uv = uv4[vt], ug = ug4[vt];
            const float4 rkw = rkw4[vt];
            rr[vt][0] = bflo(ur.x); rr[vt][1] = bfhi(ur.x); rr[vt][2] = bflo(ur.y); rr[vt][3] = bfhi(ur.y);
            vv[vt][0] = bflo(uv.x); vv[vt][1] = bfhi(uv.x); vv[vt][2] = bflo(uv.y); vv[vt][3] = bfhi(uv.y);
            gg[vt][0] = bflo(ug.x); gg[vt][1] = bfhi(ug.x); gg[vt][2] = bflo(ug.y); gg[vt][3] = bfhi(ug.y);
            rk += rr[vt][0] * bflo(uk.x) * rkw.x + rr[vt][1] * bfhi(uk.x) * rkw.y + rr[vt][2] * bflo(uk.y) * rkw.z + rr[vt][3] * bfhi(uk.y) * rkw.w;
#pragma unroll
            for (int r = 0; r < 4; ++r) { const float d = y[vt][r] - mu; q2 += d * d; }
        }
        q2 += shx(q2, 16, lane); q2 += shx(q2, 32, lane); rk += shx(rk, 16, lane); rk += shx(rk, 32, lane);
        const float rstd = __builtin_amdgcn_rsqf(q2 * (1.f / 64.f) + 64e-5f);
#pragma unroll
        for (int vt = 0; vt < 4; ++vt) {
            const float4 lg = lg4[vt], lb = lb4[vt];
            const float z0 = ((y[vt][0] - mu) * rstd * lg.x + lb.x + rk * vv[vt][0]) * gg[vt][0];
            const float z1 = ((y[vt][1] - mu) * rstd * lg.y + lb.y + rk * vv[vt][1]) * gg[vt][1];
            const float z2 = ((y[vt][2] - mu) * rstd * lg.z + lb.z + rk * vv[vt][2]) * gg[vt][2];
            const float z3 = ((y[vt][3] - mu) * rstd * lg.w + lb.w + rk * vv[vt][3]) * gg[vt][3];
            uint2 o; o.x = pack2(z0, z1); o.y = pack2(z2, z3);
            *(uint2*)(p.G + off + 16 * vt) = o;
        }
    }
}
__device__ __forceinline__ void ph_oproj(const Ctx cx, PRef p, char* lds, const bf16_t* A_, const bf16_t* Wt, const float* xl, const float* xc, const float* modl, int mt_lo, int mtiles) {
    for (int tile = cx.bid; tile < mtiles * 8; tile += cx.nb) {
        const int mt = mt_lo + (tile >> 3), n0 = (tile & 7) * 128, m0 = mt * 128;
        const bf16_t* A = A_ + (size_t)m0 * DM + G3_CH8;
        const bf16_t* B = Wt + (size_t)n0 * 1024 + G3_CH8;
        EpiResid epi; epi.out = p.PRE; epi.xl = xl; epi.xc = xc; epi.modl = modl; epi.m0 = m0; epi.n0 = n0;
        gemm3_tile(cx, A + (size_t)G3_ROW(0) * DM, A + (size_t)G3_ROW(1) * DM,
                   B + (size_t)G3_ROW(0) * 1024, B + (size_t)G3_ROW(1) * 1024, 1024, epi, lds);
    }
}
__device__ __forceinline__ void ph_ln_router(const Ctx cx, PRef p, int layer, int nrows) {
    const int lane_ = cx.tid & 63, gw = (cx.bid * NTHR + cx.tid) >> 6, nw = (cx.nb * NTHR) >> 6;
    const float* lg = p.ln1_g + layer * DM; const float* lb = p.ln1_b + layer * DM;
    const float* rw = p.router_w + (size_t)layer * DM * 16;
    const bool b5 = lane_ & 32, b4 = lane_ & 16, b3 = lane_ & 8, b2 = lane_ & 4;
    const int myidx = (b5 ? 8 : 0) + (b4 ? 4 : 0) + (b3 ? 2 : 0) + (b2 ? 1 : 0);
    const int nmain = (nrows / (nw * 4)) * (nw * 4);
    const int ntail = nrows - nmain;
    for (int it = gw; it < nmain / 4 + ntail; it += nw) {
        const int rstep = it < nmain / 4 ? 1 : 0;
        const int r0 = rstep ? it * 4 : nmain + (it - nmain / 4);
        int lane = lane_; asm volatile("" : "+v"(lane));
        float mu[4], rstd[4];
        float4 v[4][4];
        {
#pragma unroll
            for (int rr = 0; rr < 4; ++rr) {
                const float* pr = p.PRE + (size_t)(r0 + rr * rstep) * DM;
                float s = 0.f;
#pragma unroll
                for (int i = 0; i < 4; ++i) { v[rr][i] = *(const float4*)(pr + i * 256 + lane * 4); s += (v[rr][i].x + v[rr][i].y) + (v[rr][i].z + v[rr][i].w); }
                mu[rr] = s;
            }
#pragma unroll
            for (int rr = 0; rr < 4; ++rr) mu[rr] = wsum(mu[rr]) * (1.f / 1024.f);
#pragma unroll
            for (int rr = 0; rr < 4; ++rr) {
                float q = 0.f;
#pragma unroll
                for (int i = 0; i < 4; ++i) { const float a = v[rr][i].x - mu[rr], b = v[rr][i].y - mu[rr], c = v[rr][i].z - mu[rr], d = v[rr][i].w - mu[rr]; q += (a * a + b * b) + (c * c + d * d); }
                rstd[rr] = q;
            }
#pragma unroll
            for (int rr = 0; rr < 4; ++rr) rstd[rr] = __builtin_amdgcn_rsqf(wsum(rstd[rr]) * (1.f / 1024.f) + 1e-5f);
        }
        const float* mv = p.modv + (size_t)(layer * 3 + mod_of_row(r0)) * 6144;
        float lgt[4][16];
#pragma unroll
        for (int rr = 0; rr < 4; ++rr)
#pragma unroll
            for (int e = 0; e < 16; ++e) lgt[rr][e] = 0.f;
        float4 wq0, wq1, wq2, wq3;
        { const float* rp = rw + (size_t)(lane * 4) * 16; wq0 = *(const float4*)(rp); wq1 = *(const float4*)(rp + 4); wq2 = *(const float4*)(rp + 8); wq3 = *(const float4*)(rp + 12); }
#pragma unroll
        for (int i = 0; i < 4; ++i) {
            const int col = i * 256 + lane * 4;
            const float4 g4 = *(const float4*)(lg + col), b4v = *(const float4*)(lb + col);
            const float4 sh = *(const float4*)(mv + 3 * 1024 + col), sc = *(const float4*)(mv + 4 * 1024 + col);
            float hh[4][4];
#pragma unroll
            for (int rr = 0; rr < 4; ++rr) {
                const float4 vv = v[rr][i];
                float4 x1;
                x1.x = (vv.x - mu[rr]) * rstd[rr] * g4.x + b4v.x; x1.y = (vv.y - mu[rr]) * rstd[rr] * g4.y + b4v.y;
                x1.z = (vv.z - mu[rr]) * rstd[rr] * g4.z + b4v.z; x1.w = (vv.w - mu[rr]) * rstd[rr] * g4.w + b4v.w;
                *(float4*)(p.X1 + (size_t)(r0 + rr * rstep) * DM + col) = x1;
                hh[rr][0] = x1.x * (1.f + sc.x) + sh.x; hh[rr][1] = x1.y * (1.f + sc.y) + sh.y; hh[rr][2] = x1.z * (1.f + sc.z) + sh.z; hh[rr][3] = x1.w * (1.f + sc.w) + sh.w;
                uint2 o; o.x = pack2(hh[rr][0], hh[rr][1]); o.y = pack2(hh[rr][2], hh[rr][3]);
                *(uint2*)(p.H2 + (size_t)(r0 + rr * rstep) * DM + col) = o;
            }
#pragma unroll
            for (int c = 0; c < 4; ++c) {
                float4 n0 = wq0, n1 = wq1, n2 = wq2, n3 = wq3;
                if (i * 4 + c + 1 < 16) {
                    const int ncol = (c == 3 ? (i + 1) * 256 + lane * 4 : col + c + 1);
                    const float* rp = rw + (size_t)ncol * 16;
                    n0 = *(const float4*)(rp); n1 = *(const float4*)(rp + 4); n2 = *(const float4*)(rp + 8); n3 = *(const float4*)(rp + 12);
                }
                const float4 w0 = wq0, w1 = wq1, w2 = wq2, w3 = wq3;
#pragma unroll
                for (int rr = 0; rr < 4; ++rr) {
                    const float hv = hh[rr][c];
                    lgt[rr][0] += hv * w0.x; lgt[rr][1] += hv * w0.y; lgt[rr][2] += hv * w0.z; lgt[rr][3] += hv * w0.w;
                    lgt[rr][4] += hv * w1.x; lgt[rr][5] += hv * w1.y; lgt[rr][6] += hv * w1.z; lgt[rr][7] += hv * w1.w;
                    lgt[rr][8] += hv * w2.x; lgt[rr][9] += hv * w2.y; lgt[rr][10] += hv * w2.z; lgt[rr][11] += hv * w2.w;
                    lgt[rr][12] += hv * w3.x; lgt[rr][13] += hv * w3.y; lgt[rr][14] += hv * w3.z; lgt[rr][15] += hv * w3.w;
                }
                if (c & 1) {
#define LPIN(rr) asm volatile("" : "+v"(lgt[rr][0]), "+v"(lgt[rr][1]), "+v"(lgt[rr][2]), "+v"(lgt[rr][3]), "+v"(lgt[rr][4]), "+v"(lgt[rr][5]), "+v"(lgt[rr][6]), "+v"(lgt[rr][7]), \
                                   "+v"(lgt[rr][8]), "+v"(lgt[rr][9]), "+v"(lgt[rr][10]), "+v"(lgt[rr][11]), "+v"(lgt[rr][12]), "+v"(lgt[rr][13]), "+v"(lgt[rr][14]), "+v"(lgt[rr][15]) :: "memory")
                    LPIN(0); LPIN(1); LPIN(2); LPIN(3);
#undef LPIN
                }
                wq0 = n0; wq1 = n1; wq2 = n2; wq3 = n3;
            }
        }
#pragma unroll
        for (int rr = 0; rr < 4; ++rr) {
            float a8[8], a4[4], a2[2], a1;
#pragma unroll
            for (int i = 0; i < 8; ++i) { const float snd = b5 ? lgt[rr][i] : lgt[rr][i + 8]; const float kp = b5 ? lgt[rr][i + 8] : lgt[rr][i]; a8[i] = kp + shx(snd, 32, lane); }
#pragma unroll
            for (int i = 0; i < 4; ++i) { const float snd = b4 ? a8[i] : a8[i + 4]; const float kp = b4 ? a8[i + 4] : a8[i]; a4[i] = kp + shx(snd, 16, lane); }
#pragma unroll
            for (int i = 0; i < 2; ++i) { const float snd = b3 ? a4[i] : a4[i + 2]; const float kp = b3 ? a4[i + 2] : a4[i]; a2[i] = kp + shx(snd, 8, lane); }
            { const float snd = b2 ? a2[0] : a2[1]; const float kp = b2 ? a2[1] : a2[0]; a1 = kp + shx(snd, 4, lane); }
            a1 += shx(a1, 2, lane); a1 += shx(a1, 1, lane);
            float mx = a1;
            mx = fmaxf(mx, shx(mx, 32, lane)); mx = fmaxf(mx, shx(mx, 16, lane)); mx = fmaxf(mx, shx(mx, 8, lane)); mx = fmaxf(mx, shx(mx, 4, lane));
            const float ex = __expf(a1 - mx);
            float se = ex;
            se += shx(se, 32, lane); se += shx(se, 16, lane); se += shx(se, 8, lane); se += shx(se, 4, lane);
            if ((lane & 3) == 0) { p.afft[(size_t)myidx * ROWS + r0 + rr * rstep] = ex / se; p.inv[(size_t)(r0 + rr * rstep) * 16 + myidx] = -1; }
        }
    }
}
template <int CH>
__device__ __forceinline__ void topk_list(const Ctx cx, PRef p, int e, int rowbase, int cap, int slotbase, unsigned* sh) {
    const int tid = cx.tid, lane = tid & 63, wave = tid >> 6;
    const float* src = p.afft + (size_t)e * ROWS + rowbase + tid * CH;
    unsigned key[CH];
    if (CH >= 4) {
#pragma unroll
        for (int j = 0; j < CH / 4; ++j) { const uint4 u = *(const uint4*)(src + 4 * j); key[4 * j] = u.x; key[4 * j + 1] = u.y; key[4 * j + 2] = u.z; key[4 * j + 3] = u.w; }
    } else {
#pragma unroll
        for (int j = 0; j < CH; ++j) key[j] = __float_as_uint(src[j]);
    }
    unsigned prefix = 0u;
    for (int bit = 30; bit >= 0; --bit) {
        const unsigned cand = prefix | (1u << bit);
        int c = 0;
#pragma unroll
        for (int j = 0; j < CH; ++j) c += (key[j] >= cand) ? 1 : 0;
#pragma unroll
        for (int o = 32; o > 0; o >>= 1) c += shxi(c, o, lane);
        const int slot = (30 - bit) & 1;
        if (lane == 0) sh[slot * 4 + wave] = (unsigned)c;
        __syncthreads();
        const int tot = (int)(sh[slot * 4] + sh[slot * 4 + 1] + sh[slot * 4 + 2] + sh[slot * 4 + 3]);
        if (tot >= cap) prefix = cand;
    }
    __syncthreads();
    const unsigned thr = prefix;
    int cg = 0, ce = 0;
#pragma unroll
    for (int j = 0; j < CH; ++j) { cg += key[j] > thr; ce += key[j] == thr; }
    unsigned pk = (unsigned)cg | ((unsigned)ce << 16);
    unsigned incl = pk;
#pragma unroll
    for (int o = 1; o < 64; o <<= 1) { const unsigned n = (unsigned)shidx((int)incl, (lane - o) & 63); if (lane >= o) incl += n; }
    if (lane == 63) sh[8 + wave] = incl;
    __syncthreads();
    unsigned wbase = 0u, total = 0u;
#pragma unroll
    for (int w = 0; w < 4; ++w) { const unsigned v = sh[8 + w]; if (w < wave) wbase += v; total += v; }
    const unsigned excl = wbase + incl - pk;
    const int tot_gt = (int)(total & 0xffffu);
    const int need_eq = cap - tot_gt;
    int eq_rank = (int)(excl >> 16);
    int gt_before = (int)(excl & 0xffffu);
#pragma unroll
    for (int j = 0; j < CH; ++j) {
        const bool isg = key[j] > thr, ise = key[j] == thr;
        const bool sel = isg || (ise && eq_rank < need_eq);
        if (sel) {
            const int slot = slotbase + gt_before + (eq_rank < need_eq ? eq_rank : need_eq);
            const int row = rowbase + tid * CH + j;
            p.idx[e * MPAD0 + slot] = row;
            p.gate[e * MPAD0 + slot] = __uint_as_float(key[j]);
            p.inv[(size_t)row * 16 + e] = slot;
        }
        gt_before += isg; eq_rank += ise;
    }
    __syncthreads();
}
__device__ __forceinline__ void ph_topk(const Ctx cx, PRef p, int layer, char* lds) {
    unsigned* sh = (unsigned*)lds;
    const int nlists = layer == 0 ? 64 : 32;
    for (int li = cx.bid; li < nlists; li += cx.nb) {
        const int s = li >> 4, e = li & 15;
        if (s < 2) topk_list<32>(cx, p, e, s * TLAT, 1024, s * 1024, sh);
        else {
            topk_list<1>(cx, p, e, ROWS_LAT + (s - 2) * LCTX, 32, 2048 + (s - 2) * 32, sh);
            if (s == 3 && cx.tid < 64) { p.idx[e * MPAD0 + 2112 + cx.tid] = -1; p.gate[e * MPAD0 + 2112 + cx.tid] = 0.f; }
        }
    }
}
__device__ __forceinline__ void ph_moe_up(const Ctx cx, PRef p, int layer, char* lds) {
    if (layer != 0) return;
    for (int tile = cx.bid; tile < 16 * 32; tile += cx.nb) {
        const int e = tile >> 5, nt = tile & 31, m0 = 2048, j0 = nt * 64;
        const bf16_t* ar[2]; const bf16_t* br[2];
        const bf16_t* We = p.CW + (size_t)(layer * 16 + e) * 3 * 2097152;
#pragma unroll
        for (int i = 0; i < 2; ++i) {
            const int r = G3_ROW(i);
            int src = p.idx[e * MPAD0 + m0 + r]; if (src < 0) src = 0;
            ar[i] = p.H2 + (size_t)src * DM + G3_CH8;
            const int j = j0 + (r >> 6) * 32 + ((r >> 4) & 1) * 16 + (r & 15);
            br[i] = We + (size_t)((r >> 5) & 1) * 2097152 + (size_t)j * 1024 + G3_CH8;
        }
        EpiSwiGLU epi; epi.out = p.HMID + (size_t)e * MPAD0 * 2048; epi.m0 = m0; epi.j0 = j0;
        gemm3_tile(cx, ar[0], ar[1], br[0], br[1], 1024, epi, lds);
    }
}
__device__ __forceinline__ void ph_moe_down(const Ctx cx, PRef p, int layer, char* lds) {
    if (layer != 0) return;
    for (int tile = cx.bid; tile < 16 * 8; tile += cx.nb) {
        const int e = tile >> 3, nt = tile & 7, m0 = 2048, n0 = nt * 128;
        const bf16_t* A = p.HMID + ((size_t)e * MPAD0 + m0) * 2048 + G3_CH8;
        const bf16_t* B = p.CW + ((size_t)(layer * 16 + e) * 3 + 2) * 2097152 + (size_t)n0 * 2048 + G3_CH8;
        EpiDown epi; epi.out = p.YE + (size_t)e * MPAD0 * DM; epi.gate = p.gate + e * MPAD0; epi.m0 = m0; epi.n0 = n0;
        gemm3_tile(cx, A + (size_t)G3_ROW(0) * 2048, A + (size_t)G3_ROW(1) * 2048,
                   B + (size_t)G3_ROW(0) * 2048, B + (size_t)G3_ROW(1) * 2048, 2048, epi, lds);
    }
}
__device__ __forceinline__ void ph_combine(const Ctx cx, PRef p, int layer, int nrows) {
    const int lane = cx.tid & 63, gw = (cx.bid * NTHR + cx.tid) >> 6, nw = (cx.nb * NTHR) >> 6;
    const float* lg = p.ln2_g + layer * DM; const float* lb = p.ln2_b + layer * DM;
    int inv_next = (gw < nrows && lane < 16) ? p.inv[(size_t)gw * 16 + lane] : -1;
    for (int row = gw; row < nrows; row += nw) {
        const float* mv = p.modv + (size_t)(layer * 3 + mod_of_row(row)) * 6144;
        float4 m[4];
#pragma unroll
        for (int i = 0; i < 4; ++i) m[i] = make_float4(0.f, 0.f, 0.f, 0.f);
        const int myinv = inv_next;
        float4 x1r[4], g5r[4];
#pragma unroll
        for (int i = 0; i < 4; ++i) { const int col = i * 256 + lane * 4; x1r[i] = *(const float4*)(p.X1 + (size_t)row * DM + col); g5r[i] = *(const float4*)(mv + 5 * 1024 + col); }
        inv_next = (row + nw < nrows && lane < 16) ? p.inv[(size_t)(row + nw) * 16 + lane] : -1;
        unsigned vm = (unsigned)(__builtin_amdgcn_ballot_w64(myinv >= 0) & 0xffffull);
        while (vm) {
            int ek[4]; float wk[4];
#pragma unroll
            for (int k = 0; k < 4; ++k) { if (vm) { ek[k] = __builtin_ctz(vm); vm &= vm - 1u; wk[k] = 1.f; } else { ek[k] = ek[0]; wk[k] = 0.f; } }
            uint2 y[4][4];
#pragma unroll
            for (int k = 0; k < 4; ++k) {
                const int sl = shidx(myinv, ek[k]);
                const bf16_t* yr = p.YE + ((size_t)ek[k] * MPAD0 + sl) * DM;
#pragma unroll
                for (int i = 0; i < 4; ++i) y[k][i] = *(const uint2*)(yr + i * 256 + lane * 4);
            }
#pragma unroll
            for (int k = 0; k < 4; ++k)
#pragma unroll
                for (int i = 0; i < 4; ++i) { m[i].x += wk[k] * bflo(y[k][i].x); m[i].y += wk[k] * bfhi(y[k][i].x); m[i].z += wk[k] * bflo(y[k][i].y); m[i].w += wk[k] * bfhi(y[k][i].y); }
        }
        float4 v[4]; float s = 0.f;
#pragma unroll
        for (int i = 0; i < 4; ++i) {
            const int col = i * 256 + lane * 4;
            const float4 x1 = x1r[i], g5 = g5r[i];
            v[i].x = ALPHA_F * x1.x + g5.x * m[i].x; v[i].y = ALPHA_F * x1.y + g5.y * m[i].y; v[i].z = ALPHA_F * x1.z + g5.z * m[i].z; v[i].w = ALPHA_F * x1.w + g5.w * m[i].w;
            s += (v[i].x + v[i].y) + (v[i].z + v[i].w);
        }
        const float mu = wsum(s) * (1.f / 1024.f);
        float q = 0.f;
#pragma unroll
        for (int i = 0; i < 4; ++i) { const float a = v[i].x - mu, b = v[i].y - mu, c = v[i].z - mu, d = v[i].w - mu; q += (a * a + b * b) + (c * c + d * d); }
        const float rstd = __builtin_amdgcn_rsqf(wsum(q) * (1.f / 1024.f) + 1e-5f);
        const float* mv1 = p.modv + (size_t)(3 + mod_of_row(row)) * 6144;
#pragma unroll
        for (int i = 0; i < 4; ++i) {
            const int col = i * 256 + lane * 4;
            const float4 g4 = *(const float4*)(lg + col), b4 = *(const float4*)(lb + col);
            float4 x2;
            x2.x = (v[i].x - mu) * rstd * g4.x + b4.x; x2.y = (v[i].y - mu) * rstd * g4.y + b4.y;
            x2.z = (v[i].z - mu) * rstd * g4.z + b4.z; x2.w = (v[i].w - mu) * rstd * g4.w + b4.w;
            if (layer == 0) {
                *(float4*)(p.X1 + (size_t)row * DM + col) = x2;
                const float4 sh = *(const float4*)(mv1 + col), sc = *(const float4*)(mv1 + 1024 + col);
                uint2 o; o.x = pack2(x2.x * (1.f + sc.x) + sh.x, x2.y * (1.f + sc.y) + sh.y); o.y = pack2(x2.z * (1.f + sc.z) + sh.z, x2.w * (1.f + sc.w) + sh.w);
                *(uint2*)(p.HB + (size_t)row * DM + col) = o;
            } else {
                *(float4*)(p.out + (size_t)row * DM + col) = x2;
            }
        }
    }
}
__device__ __forceinline__ void ph_qkv(const Ctx cx, PRef p, char* lds) {
    for (int tile = cx.bid; tile < 16; tile += cx.nb) {
        const int mt = 128 + (tile >> 2), n0 = (8 + (tile & 3)) * 128, m0 = mt * 128;
        const bf16_t* A = p.HB + (size_t)m0 * DM + G3_CH8;
        const bf16_t* B = p.wqkvT + (size_t)n0 * 1024 + G3_CH8;
        EpiQKV epi; epi.p = &p; epi.m0 = m0; epi.n0 = n0;
        gemm3_tile(cx, A + (size_t)G3_ROW(0) * DM, A + (size_t)G3_ROW(1) * DM,
                   B + (size_t)G3_ROW(0) * 1024, B + (size_t)G3_ROW(1) * 1024, 1024, epi, lds);
    }
}
#define AT_ROW 72
__device__ __forceinline__ void ph_attn(const Ctx cx, PRef p, char* lds) {
    const int tid = cx.tid, lane = tid & 63, wave = tid >> 6, qi = lane & 15, g = lane >> 4;
    bf16_t* Ks = (bf16_t*)lds;
    bf16_t* Vs = Ks + 64 * AT_ROW;
    const float LOG2E = 1.4426950408889634f;
    for (int item = cx.bid; item < 2 * 128 * 4; item += cx.nb) {
        const int hk = item & 3, qb = (item >> 2) & 127, b = item >> 9;
        const int hq = hk * 4 + wave, q0 = qb * 64;
        bf16x8 qf[4][2];
#pragma unroll
        for (int qs = 0; qs < 4; ++qs)
#pragma unroll
            for (int ks = 0; ks < 2; ++ks)
                qf[qs][ks] = *(const bf16x8*)(p.Q + (size_t)(b * TLAT + q0 + qs * 16 + qi) * DM + hq * 64 + ks * 32 + 8 * g);
        f32x4 o[4][4];
#pragma unroll
        for (int i = 0; i < 4; ++i)
#pragma unroll
            for (int j = 0; j < 4; ++j) o[i][j] = (f32x4){0.f, 0.f, 0.f, 0.f};
        const float sink = p.at_sink[hq] * LOG2E;
        float mrow[4], lrow[4];
#pragma unroll
        for (int qs = 0; qs < 4; ++qs) { mrow[qs] = sink; lrow[qs] = (g == 0) ? 1.f : 0.f; }
        uint4 kr0, kr1, vr0, vr1;
        kr0 = kr1 = vr0 = vr1 = make_uint4(0u, 0u, 0u, 0u);
#define AT_GEOM(tile_, isctx_, ts_, skip_) const bool isctx_ = (tile_) < 4; const int ts_ = isctx_ ? (tile_) * 64 : q0 - 128 + ((tile_) - 4) * 64; const bool skip_ = !isctx_ && (ts_ < 0 || ts_ >= TLAT)
#define AT_LOAD(tile_) do { AT_GEOM(tile_, ic_, tl_, sk_); if (!sk_) { \
            const bf16_t* kbase = ic_ ? p.KA + (size_t)(ROWS_LAT + b * LCTX + tl_) * 256 + hk * 64 : p.KA + (size_t)(b * TLAT + tl_) * 256 + hk * 64; \
            const bf16_t* vbase = ic_ ? p.VTC + (size_t)(b * 4 + hk) * 64 * LCTX + tl_ : p.VTL + (size_t)(b * 4 + hk) * 64 * TLAT + tl_; \
            const int ldv = ic_ ? LCTX : TLAT; \
            const int r0_ = tid >> 3, r1_ = (tid + 256) >> 3, c8_ = (tid & 7) * 8; \
            kr0 = *(const uint4*)(kbase + (size_t)r0_ * 256 + c8_); vr0 = *(const uint4*)(vbase + (size_t)r0_ * ldv + c8_); \
            kr1 = *(const uint4*)(kbase + (size_t)r1_ * 256 + c8_); vr1 = *(const uint4*)(vbase + (size_t)r1_ * ldv + c8_); } } while (0)
        AT_LOAD(0);
        for (int tile = 0; tile < 9; ++tile) {
            AT_GEOM(tile, isctx, ts, skip);
            __syncthreads();
            if (!skip) {
                const int r0_ = tid >> 3, r1_ = (tid + 256) >> 3, c8_ = (tid & 7) * 8;
                *(uint4*)(Ks + r0_ * AT_ROW + c8_) = kr0; *(uint4*)(Vs + r0_ * AT_ROW + c8_) = vr0;
                *(uint4*)(Ks + r1_ * AT_ROW + c8_) = kr1; *(uint4*)(Vs + r1_ * AT_ROW + c8_) = vr1;
            }
            if (tile + 1 < 9) AT_LOAD(tile + 1);
            __syncthreads();
            if (!skip)
#pragma unroll
            for (int qh = 0; qh < 2; ++qh) {
                f32x4 s[4][2];
#pragma unroll
                for (int kt = 0; kt < 4; ++kt) {
                    const bf16x8 k0 = *(const bf16x8*)(Ks + (kt * 16 + qi) * AT_ROW + 8 * g);
                    const bf16x8 k1 = *(const bf16x8*)(Ks + (kt * 16 + qi) * AT_ROW + 32 + 8 * g);
#pragma unroll
                    for (int q2 = 0; q2 < 2; ++q2) {
                        f32x4 a = (f32x4){0.f, 0.f, 0.f, 0.f};
                        a = __builtin_amdgcn_mfma_f32_16x16x32_bf16(k0, qf[2 * qh + q2][0], a, 0, 0, 0);
                        a = __builtin_amdgcn_mfma_f32_16x16x32_bf16(k1, qf[2 * qh + q2][1], a, 0, 0, 0);
                        s[kt][q2] = a;
                    }
                }
                __builtin_amdgcn_sched_barrier(0);
#pragma unroll
                for (int q2 = 0; q2 < 2; ++q2) {
                    const int qs = 2 * qh + q2;
                    const int qp = q0 + qs * 16 + qi;
                    float tmax = -1e30f;
#pragma unroll
                    for (int kt = 0; kt < 4; ++kt)
#pragma unroll
                        for (int r = 0; r < 4; ++r) {
                            float v = s[kt][q2][r] * LOG2E;
                            if (!isctx) { const int kp = ts + kt * 16 + 4 * g + r; const int dd = qp - kp; if (dd > 128 || dd < -128) v = -1e30f; }
                            s[kt][q2][r] = v; tmax = fmaxf(tmax, v);
                        }
                    tmax = fmaxf(tmax, shx(tmax, 16, lane)); tmax = fmaxf(tmax, shx(tmax, 32, lane));
                    const float mn = fmaxf(mrow[qs], tmax);
                    const float alpha = __builtin_amdgcn_exp2f(mrow[qs] - mn);
                    mrow[qs] = mn;
                    float ls = 0.f;
#pragma unroll
                    for (int kt = 0; kt < 4; ++kt)
#pragma unroll
                        for (int r = 0; r < 4; ++r) { const float pv = __builtin_amdgcn_exp2f(s[kt][q2][r] - mn); s[kt][q2][r] = pv; ls += pv; }
                    lrow[qs] = lrow[qs] * alpha + ls;
#pragma unroll
                    for (int dt = 0; dt < 4; ++dt) o[dt][qs] = o[dt][qs] * alpha;
                }
                __builtin_amdgcn_sched_barrier(0);
#pragma unroll
                for (int kk = 0; kk < 2; ++kk) {
                    bf16x8 pf[2];
#pragma unroll
                    for (int q2 = 0; q2 < 2; ++q2) {
                        uint4 u;
                        u.x = pack2(s[2 * kk][q2][0], s[2 * kk][q2][1]); u.y = pack2(s[2 * kk][q2][2], s[2 * kk][q2][3]);
                        u.z = pack2(s[2 * kk + 1][q2][0], s[2 * kk + 1][q2][1]); u.w = pack2(s[2 * kk + 1][q2][2], s[2 * kk + 1][q2][3]);
                        pf[q2] = *(bf16x8*)&u;
                    }
#pragma unroll
                    for (int dt = 0; dt < 4; ++dt) {
                        const bf16_t* vr = Vs + (dt * 16 + qi) * AT_ROW + 32 * kk + 4 * g;
                        uint4 u; const uint2 lo = *(const uint2*)(vr), hi = *(const uint2*)(vr + 16);
                        u.x = lo.x; u.y = lo.y; u.z = hi.x; u.w = hi.y;
                        const bf16x8 vf = *(bf16x8*)&u;
#pragma unroll
                        for (int q2 = 0; q2 < 2; ++q2) o[dt][2 * qh + q2] = __builtin_amdgcn_mfma_f32_16x16x32_bf16(vf, pf[q2], o[dt][2 * qh + q2], 0, 0, 0);
                    }
                }
            }
        }
#pragma unroll
        for (int qs = 0; qs < 4; ++qs) {
            float l = lrow[qs]; l += shx(l, 16, lane); l += shx(l, 32, lane);
            const float il = __builtin_amdgcn_rcpf(l);
            bf16_t* op = p.O + (size_t)(b * TLAT + q0 + qs * 16 + qi) * DM + hq * 64 + 4 * g;
#pragma unroll
            for (int dt = 0; dt < 4; ++dt) {
                uint2 u; u.x = pack2(o[dt][qs][0] * il, o[dt][qs][1] * il); u.y = pack2(o[dt][qs][2] * il, o[dt][qs][3] * il);
                *(uint2*)(op + dt * 16) = u;
            }
        }
    }
}

#define N_PHASES 23
#define VLDS (S1_LDS_BYTES)
__global__ void __launch_bounds__(2 * NTHR, 2) mk_forward(Params p_by_value) {
    __shared__ __attribute__((aligned(16))) char lds[2 * VLDS + 64];
    volatile unsigned* bst = (volatile unsigned*)(lds + 2 * VLDS);
    PPtr pp = (PPtr)__builtin_amdgcn_kernarg_segment_ptr();
    const int ph_lo = pp->ph_lo, ph_hi = pp->ph_hi;
    const int wave_s = __builtin_amdgcn_readfirstlane((int)threadIdx.x >> 6);
    const bool multi = ph_hi > ph_lo;
    if (multi) {
        if (threadIdx.x == 0) { bst[0] = 0u; bst[1] = 0u; }
        __syncthreads();
        (void)xcd_barrier_post(pp->bar, bst);
    }
    bool dup_done = false; (void)dup_done;
    for (int ph = ph_lo; ph <= ph_hi; ++ph) {
#ifdef ONLY_PH
        if (ph != ONLY_PH) continue;
#endif
        if (ph == 4 || ph == 8) continue;
        PPtr q = pp; asm volatile("" : "+s"(q));
        PRef p = *q;
#define LDSP (lds + (wave_s >> 2) * VLDS + fresh_zero())
#define MKPX(name) Ctx name; name.tid = wave_s * 64 + fresh_lane(); name.bid = blockIdx.x; name.nb = gridDim.x; asm volatile("" : "+v"(name.tid), "+s"(name.bid), "+s"(name.nb))
#define MKCX(name) Ctx name; name.tid = (wave_s & 3) * 64 + fresh_lane(); name.bid = blockIdx.x * 2 + (wave_s >> 2); name.nb = gridDim.x * 2; asm volatile("" : "+v"(name.tid), "+s"(name.bid), "+s"(name.nb)); int lz2_ = 0; asm volatile("" : "+v"(lz2_)); char* ldsy = lds + (wave_s >> 2) * VLDS + lz2_
        switch (ph) {
            case 0: { MKCX(cx);  ph_ada(cx, p, LDSP); } break;
            case 1: { MKCX(cx);  ph_pre0(cx, p); } break;
            case 2: { MKPX(px);  { ProbRKV pr; pr.p = q; pr.K = 1024; pr.c = px.bid; pr.G = px.nb; { int z8 = 0; asm volatile("" : "+v"(z8)); gemm8(px, lds + z8, pr); } MKCX(cy); ph_g1(cy, p, ldsy); } } break;
            case 3: { MKCX(cx);  ph_g2(cx, p, LDSP); } break;
            case 4: { MKCX(cx);  ph_prep(cx, p); } break;
            case 5: { MKCX(cx);  ph_s1(cx, p, LDSP); } break;
            case 6: { MKPX(px); MKCX(cx);  ph_s2(px, cx, p, LDSP, lds + fresh_zero()); } break;
            case 7: { MKCX(cx);  ph_s3o(cx, p); } break;
            case 9: case 17: {
                const bool l1 = ph == 17; MKPX(px);
                {
                    ProbOproj pr; pr.A = l1 ? p.O : p.G; pr.Wt = l1 ? p.atwoT : p.woT; pr.out = p.PRE; pr.xl = l1 ? p.X1 : p.x; pr.modl = l1 ? p.modv + 3 * 6144 : p.modv; pr.K = 1024; pr.c = px.bid; pr.G = px.nb;
                    { int z8 = 0; asm volatile("" : "+v"(z8)); gemm8(px, lds + z8, pr); }
                }
                if (!l1) { MKCX(cy); ph_oproj(cy, p, ldsy, p.G, p.woT, p.x, p.ctx, p.modv, 128, 4); }
            } break;
            case 10: case 18: { MKCX(cx); ph_ln_router(cx, p, ph == 18 ? 1 : 0, ph == 18 ? ROWS_LAT : ROWS); } break;
            case 11: case 19: { MKCX(cx); ph_topk(cx, p, ph == 19 ? 1 : 0, LDSP); } break;
            case 12: case 20: { MKPX(px); { ProbUp pr; pr.p = q; pr.K = 1024; pr.c = px.bid; pr.G = px.nb; pr.layer = ph == 20 ? 1 : 0; { int z8 = 0; asm volatile("" : "+v"(z8)); gemm8(px, lds + z8, pr); } MKCX(cy); ph_moe_up(cy, p, ph == 20 ? 1 : 0, ldsy); } } break;
            case 13: case 21: { MKPX(px); { ProbDown pr; pr.p = q; pr.K = 2048; pr.c = px.bid; pr.G = px.nb; pr.layer = ph == 21 ? 1 : 0; { int z8 = 0; asm volatile("" : "+v"(z8)); gemm8(px, lds + z8, pr); } MKCX(cy); ph_moe_down(cy, p, ph == 21 ? 1 : 0, ldsy); } } break;
            case 14: case 22: { MKCX(cx); ph_combine(cx, p, ph == 22 ? 1 : 0, ph == 22 ? ROWS_LAT : ROWS); } break;
            case 15: { MKPX(px);  { ProbQKV pr; pr.p = q; pr.K = 1024; pr.c = px.bid; pr.G = px.nb; { int z8 = 0; asm volatile("" : "+v"(z8)); gemm8(px, lds + z8, pr); } MKCX(cy); ph_qkv(cy, p, ldsy); } } break;
            case 16: { MKCX(cx);  ph_attn(cx, p, LDSP); } break;
        }
#ifdef DUP_MASK
        if (((DUP_MASK >> ph) & 1u) && !dup_done) { dup_done = true; --ph; } else dup_done = false;
        if (ph + 1 <= ph_hi && (ph < ph_hi)) {
#else
        if (ph < ph_hi) {
#endif
            if (ph == ph_lo && q->bar == nullptr) cg::this_grid().sync();
            { XcdBarrier xb2; xb2.bar = q->bar; xb2.x = xb_xcc_id(); int lz3 = 0; asm volatile("" : "+v"(lz3)); xb2.st = (volatile unsigned*)(lds + 2 * VLDS + lz3); asm volatile("" : "+s"(xb2.x)); xcd_barrier(xb2); }
        }
    }
}

extern "C" void kernel_launch(void* const* d_in, const int* in_sizes, int n_in, void* d_out, int out_size, void* d_ws, size_t ws_size, hipStream_t stream) {
    Params p{};
    const float** f = (const float**)d_in;
    p.x = f[0]; p.c = f[1]; p.ctx = f[2]; p.c_ctx = f[3]; p.ada_w = f[4]; p.ada_b = f[5]; p.ln1_g = f[6]; p.ln1_b = f[7]; p.ln2_g = f[8]; p.ln2_b = f[9];
    p.rw_mu = f[10]; p.rw_wr = f[11]; p.rw_wk = f[12]; p.rw_wv = f[13]; p.rw_w0 = f[14]; p.rw_w1 = f[15]; p.rw_w2 = f[16]; p.rw_a0 = f[17]; p.rw_a1 = f[18]; p.rw_a2 = f[19];
    p.rw_g1 = f[20]; p.rw_g2 = f[21]; p.rw_kk = f[22]; p.rw_ka = f[23]; p.rw_rk = f[24]; p.rw_lnx_g = f[25]; p.rw_lnx_b = f[26]; p.rw_wo = f[27];
    p.at_wqkv = f[28]; p.at_wo = f[29]; p.at_sink = f[30]; p.router_w = f[31]; p.moe_w_gate = f[32]; p.moe_w_up = f[33]; p.moe_w_down = f[34];
    p.out = (float*)d_out;
    char* ws = (char*)d_ws; size_t off = 0;
    auto take = [&](size_t bytes) { char* r = ws + off; off += (bytes + 255) & ~(size_t)255; return r; };
    const size_t U = (size_t)ROWS * DM * 2;
    p.bar = (unsigned*)take(16384);
    p.modv = (float*)take(2 * 3 * 6144 * 4);
    p.modp = (float*)take((size_t)16 * 2 * 3 * 6144 * 4);
    p.rope = (float*)take(128 * 16 * 2 * 4);
    p.afft = (float*)take((size_t)16 * ROWS * 4);
    p.inv = (int*)take((size_t)ROWS * 16 * 4);
    p.idx = (int*)take(16 * MPAD0 * 4);
    p.gate = (float*)take(16 * MPAD0 * 4);
    p.wrT = (bf16_t*)take(2097152); p.wkT = (bf16_t*)take(2097152); p.wvT = (bf16_t*)take(2097152); p.woT = (bf16_t*)take(2097152);
    p.l1T = (bf16_t*)take(384 * 1024 * 2); p.g2T = (bf16_t*)take(1024 * 128 * 2); p.w2T = (bf16_t*)take(2 * 65536 * 2); p.a2T = (bf16_t*)take(2 * 65536 * 2);
    p.wqkvT = (bf16_t*)take(1536 * 1024 * 2); p.atwoT = (bf16_t*)take(2097152);
    char* base = take(30 * U);
    char* RA = base, *RB = base + 12 * U, *RC = base + 20 * U, *RD = base + 23 * U, *RE = base + 25 * U, *RF = base + 26 * U;
    p.XM = (bf16_t*)RA;
    p.W0 = (float*)RA; p.W1 = (float*)(RA + 2 * U); p.AD0 = (bf16_t*)(RA + 4 * U); p.AD1 = (bf16_t*)(RA + 5 * U); p.KK = (float*)(RA + 6 * U);
    p.CW = (bf16_t*)RA;
    p.CM = (bf16_t*)RB; p.CN = (bf16_t*)(RB + 2 * U); p.CR = (bf16_t*)(RB + 4 * U); p.CY = (bf16_t*)(RB + 6 * U);
    p.HMID = (bf16_t*)RB; p.YE = (bf16_t*)(RB + (size_t)16 * MPAD0 * 2048 * 2);
    p.R = (bf16_t*)RC; p.K = (bf16_t*)(RC + U); p.V = (bf16_t*)(RC + 2 * U);
    p.Q = (bf16_t*)RC; p.O = (bf16_t*)(RC + (size_t)ROWS_LAT * DM * 2); p.KA = (bf16_t*)(RC + (size_t)2 * ROWS_LAT * DM * 2);
    p.VTL = p.KA + (size_t)ROWS * 256; p.VTC = p.VTL + (size_t)2 * 4 * 64 * TLAT;
    p.LH = (bf16_t*)RD; p.CS = (bf16_t*)RD; p.H2 = (bf16_t*)RD; p.HB = (bf16_t*)(RD + U);
    p.G = (bf16_t*)RE;
    p.Y0 = (float*)RF; p.Y1 = (float*)(RF + 2 * U); p.PRE = (float*)RF; p.X1 = (float*)(RF + 2 * U);
    p.XXB = nullptr;
    if (off > ws_size) fprintf(stderr, "workspace too small: need %zu have %zu\n", off, ws_size);

    static int grid_blocks = 0;
    if (!grid_blocks) {
        int dev = 0, cus = 0, per_cu = 0;
        hipGetDevice(&dev);
        hipDeviceGetAttribute(&cus, hipDeviceAttributeMultiprocessorCount, dev);
        hipOccupancyMaxActiveBlocksPerMultiprocessor(&per_cu, mk_forward, 2 * NTHR, 0);
        if (per_cu > 1) per_cu = 1;
        if (per_cu < 1) per_cu = 1;
        grid_blocks = cus * per_cu;
    }
#if MK_SINGLE
    hipMemsetAsync(p.bar, 0, 16384, stream);
    p.ph_lo = 0; p.ph_hi = N_PHASES - 1;
    void* args[] = {&p};
    hipError_t e = hipLaunchCooperativeKernel((void*)mk_forward, dim3(grid_blocks), dim3(2 * NTHR), args, 0, stream);
    if (e != hipSuccess) fprintf(stderr, "cooperative launch failed: %s (grid %d)\n", hipGetErrorString(e), grid_blocks);
#else
    for (int ph = 0; ph < N_PHASES; ++ph) {
        p.ph_lo = ph; p.ph_hi = ph;
        hipLaunchKernelGGL(mk_forward, dim3(grid_blocks), dim3(2 * NTHR), 0, stream, p);
    }
#endif
}
```

```cpp
#include <hip/hip_runtime.h>
#include <hip/hip_cooperative_groups.h>
#include <cstdio>
#include <cstdint>
namespace cg = cooperative_groups;

#ifndef MK_SINGLE
#define MK_SINGLE 1
#endif

typedef short bf16x8 __attribute__((ext_vector_type(8)));
typedef float f32x4 __attribute__((ext_vector_type(4)));
typedef unsigned short bf16_t;

#define DM 1024
#define TLAT 8192
#define LCTX 256
#define ROWS_LAT 16384
#define ROWS_CTX 512
#define ROWS 16896
#define NTHR 256
#define ALPHA_F 1.41421356237f
#define MPAD0 2176
#define MPAD1 2048

struct Params {
    const float *x, *c, *ctx, *c_ctx, *ada_w, *ada_b, *ln1_g, *ln1_b, *ln2_g, *ln2_b;
    const float *rw_mu, *rw_wr, *rw_wk, *rw_wv, *rw_w0, *rw_w1, *rw_w2, *rw_a0, *rw_a1, *rw_a2, *rw_g1, *rw_g2;
    const float *rw_kk, *rw_ka, *rw_rk, *rw_lnx_g, *rw_lnx_b, *rw_wo;
    const float *at_wqkv, *at_wo, *at_sink, *router_w, *moe_w_gate, *moe_w_up, *moe_w_down;
    float* out;
    unsigned* bar;
    float* modv;
    float* modp;
    float* rope;
    float* afft;
    int* inv;
    int* idx;
    float* gate;
    float* X1;
    float* PRE;
    bf16_t* HB;
    bf16_t* XXB;
    bf16_t* H2;
    bf16_t *R, *K, *V;
    float *KK, *W0, *W1;
    bf16_t *AD0, *AD1;
    bf16_t *CM, *CN, *CR, *CY, *CS;
    bf16_t* G;
    bf16_t* LH;
    float *Y0, *Y1;
    bf16_t* HMID;
    bf16_t* YE;
    bf16_t *Q, *KA, *VTL, *VTC, *O;
    bf16_t* XM;
    bf16_t *wrT, *wkT, *wvT, *woT, *l1T, *g2T, *w2T, *a2T, *wqkvT, *atwoT;
    bf16_t* CW;
    int ph_lo, ph_hi;
};

struct Ctx { int tid, bid, nb; };
typedef const __attribute__((address_space(4))) Params& PRef;
typedef const __attribute__((address_space(4))) Params* PPtr;
__device__ __forceinline__ unsigned short f2bf(float f) { return __builtin_bit_cast(unsigned short, (__bf16)f); }
__device__ __forceinline__ unsigned pack2(float lo, float hi) { typedef __bf16 bf2_t __attribute__((ext_vector_type(2))); bf2_t v; v[0] = (__bf16)lo; v[1] = (__bf16)hi; return __builtin_bit_cast(unsigned, v); }
__device__ __forceinline__ float bflo(unsigned u) { return __uint_as_float(u << 16); }
__device__ __forceinline__ float bfhi(unsigned u) { return __uint_as_float(u & 0xffff0000u); }
__device__ __forceinline__ float sigmoidf_(float v) { return __builtin_amdgcn_rcpf(1.f + __expf(-v)); }
__device__ __forceinline__ float shx(float v, int o, int lane) { return __int_as_float(__builtin_amdgcn_ds_bpermute((lane ^ o) << 2, __float_as_int(v))); }
__device__ __forceinline__ int shxi(int v, int o, int lane) { return __builtin_amdgcn_ds_bpermute((lane ^ o) << 2, v); }
__device__ __forceinline__ int shidx(int v, int src) { return __builtin_amdgcn_ds_bpermute(src << 2, v); }
__device__ __forceinline__ float wsum_l(float v, int lane) {
#pragma unroll
    for (int o = 32; o > 0; o >>= 1) v += shx(v, o, lane);
    return v;
}
#define wsum(v) wsum_l((v), lane)
__device__ __forceinline__ int mod_of_row(int row) { return row < ROWS_LAT ? (row >> 13) : 2; }
__device__ __forceinline__ const float* xin_row(PRef p, int row) {
    return row < ROWS_LAT ? p.x + (size_t)row * DM : p.ctx + (size_t)(row - ROWS_LAT) * DM;
}

#define XB_TMO      128
#define XB_XCNT(j)  (256  + 64 * (j))
#define XB_XSUB(j)  (1280 + 64 * (j))
#define XB_XGEN(j)  (2304 + 64 * (j))
#define XB_TOP      3328
#define XB_TOPGEN   3392
#define XCD_BAR_WORDS 3456
#define XB_SPIN_CAP (1u << 22)
#define LAS __attribute__((address_space(3)))
__device__ __forceinline__ unsigned xb_ld(unsigned* p)              { return __hip_atomic_load(p, __ATOMIC_RELAXED, __HIP_MEMORY_SCOPE_AGENT); }
__device__ __forceinline__ unsigned xb_add(unsigned* p, unsigned v) { return __hip_atomic_fetch_add(p, v, __ATOMIC_RELAXED, __HIP_MEMORY_SCOPE_AGENT); }
__device__ __forceinline__ unsigned xb_xcc_id() { return (unsigned)__builtin_amdgcn_s_getreg((3 << 11) | 20) & 0xFu; }
#define XB_SPIN(cond, bar) do { unsigned _sp = 0; while (cond) { __builtin_amdgcn_s_sleep(1); \
    if ((++_sp & 255u) == 0u) { if (xb_ld(&(bar)[XB_TMO])) break; if (_sp > XB_SPIN_CAP) { atomicAdd(&(bar)[XB_TMO], 1u); break; } } } } while (0)
struct XcdBarrier { unsigned* bar; unsigned x; volatile unsigned* st; };
__device__ __forceinline__ XcdBarrier xcd_barrier_post(unsigned* bar, volatile unsigned* st) {
    XcdBarrier b; b.bar = bar; b.x = xb_xcc_id(); b.st = st;
    if (threadIdx.x == 0) (void)xb_add(&bar[XB_XCNT(b.x)], 1u);
    return b;
}
__device__ __forceinline__ void xcd_barrier_complete(unsigned* bar, unsigned x, unsigned& nloc, unsigned& nx) {
    const unsigned G = gridDim.x * gridDim.y * gridDim.z;
    unsigned sum, cnt, mine, sp = 0u;
    for (;;) {
        sum = 0u; cnt = 0u; mine = 0u;
#pragma unroll
        for (unsigned j = 0; j < 16; ++j) { const unsigned c = xb_ld(&bar[XB_XCNT(j)]); sum += c; cnt += (c > 0u) ? 1u : 0u; }
        mine = xb_ld(&bar[XB_XCNT(x)]);
        if (sum == G) break;
        __builtin_amdgcn_s_sleep(1);
        if ((++sp & 255u) == 0u) { if (xb_ld(&bar[XB_TMO])) break; if (sp > XB_SPIN_CAP) { atomicAdd(&bar[XB_TMO], 1u); break; } }
    }
    nloc = mine > 0u ? mine : 1u; nx = cnt > 0u ? cnt : 1u;
}
__device__ __forceinline__ void xcd_barrier(const XcdBarrier& b) {
    asm volatile("s_waitcnt vmcnt(0)" ::: "memory");
    __syncthreads();
    if (threadIdx.x == 0) {
        unsigned* bar = b.bar;
        __builtin_amdgcn_s_waitcnt(0);
        unsigned nloc = b.st[0], nx = b.st[1];
        if (nloc == 0u) { xcd_barrier_complete(bar, b.x, nloc, nx); b.st[0] = nloc; b.st[1] = nx; }
        const unsigned old = xb_add(&bar[XB_XSUB(b.x)], 1u);
        const unsigned gen = old / nloc;
        if (old + 1u == (gen + 1u) * nloc) {
            __builtin_amdgcn_fence(__ATOMIC_RELEASE, "agent");
            asm volatile("s_waitcnt vmcnt(0)" ::: "memory");
            const unsigned og = xb_add(&bar[XB_TOP], 1u);
            const unsigned tg = og / nx;
            if (og + 1u == (tg + 1u) * nx) xb_add(&bar[XB_TOPGEN], 1u);
            else XB_SPIN(xb_ld(&bar[XB_TOPGEN]) == tg, bar);
            __builtin_amdgcn_fence(__ATOMIC_ACQUIRE, "agent");
            xb_add(&bar[XB_XGEN(b.x)], 1u);
            asm volatile("s_waitcnt vmcnt(0)" ::: "memory");
        } else {
            XB_SPIN(xb_ld(&bar[XB_XGEN(b.x)]) == gen, bar);
            __builtin_amdgcn_fence(__ATOMIC_ACQUIRE, "agent");
            asm volatile("s_waitcnt vmcnt(0)" ::: "memory");
        }
    }
    __syncthreads();
}

#define G_BK 32
#define G_LDSROW 40
#define G_BUFB (128 * G_LDSROW * 2)
#define G_LDS_BYTES (4 * G_BUFB)

struct ALBf16 {
    struct Raw { uint4 a, b; };
    const bf16_t* rowp;
    __device__ __forceinline__ Raw ld(int k) const { Raw r; r.a = *(const uint4*)(rowp + k); r.b = *(const uint4*)(rowp + k + 8); return r; }
    __device__ __forceinline__ void cvt(const Raw& r, int k, uint4& lo, uint4& hi) const { lo = r.a; hi = r.b; }
};
struct ALMix {
    struct Raw { uint4 h0, h1, x0, x1; };
    const bf16_t *hp, *xp; const float* mu;
    __device__ __forceinline__ Raw ld(int k) const { Raw r; r.h0 = *(const uint4*)(hp + k); r.h1 = *(const uint4*)(hp + k + 8); r.x0 = *(const uint4*)(xp + k); r.x1 = *(const uint4*)(xp + k + 8); return r; }
    __device__ __forceinline__ unsigned mix2(unsigned h, unsigned x, float m0, float m1) const { return pack2(bflo(h) + bflo(x) * m0, bfhi(h) + bfhi(x) * m1); }
    __device__ __forceinline__ void cvt(const Raw& r, int k, uint4& lo, uint4& hi) const {
        const float4 m0 = *(const float4*)(mu + k), m1 = *(const float4*)(mu + k + 4), m2 = *(const float4*)(mu + k + 8), m3 = *(const float4*)(mu + k + 12);
        lo.x = mix2(r.h0.x, r.x0.x, m0.x, m0.y); lo.y = mix2(r.h0.y, r.x0.y, m0.z, m0.w); lo.z = mix2(r.h0.z, r.x0.z, m1.x, m1.y); lo.w = mix2(r.h0.w, r.x0.w, m1.z, m1.w);
        hi.x = mix2(r.h1.x, r.x1.x, m2.x, m2.y); hi.y = mix2(r.h1.y, r.x1.y, m2.z, m2.w); hi.z = mix2(r.h1.z, r.x1.z, m3.x, m3.y); hi.w = mix2(r.h1.w, r.x1.w, m3.z, m3.w);
    }
};

template <class AL, class EPI>
__device__ __forceinline__ void gemm_tile(const Ctx cx, const AL& al, const float* bp  , int ldb, int K, const EPI& epi, char* lds) {
    const int tid = cx.tid, lane = tid & 63, wid = tid >> 6, wr = wid >> 1, wc = wid & 1, fr = lane & 15, fq = lane >> 4;
    const int arow = tid >> 1, akq = (tid & 1) * 16;
    const int bn4 = (tid & 31) * 4, bk4 = (tid >> 5) * 4;
    f32x4 acc[4][4];
#pragma unroll
    for (int i = 0; i < 4; ++i)
#pragma unroll
        for (int j = 0; j < 4; ++j) acc[i][j] = (f32x4){0.f, 0.f, 0.f, 0.f};
    const int nk = K / G_BK;
    typename AL::Raw ra; float4 rb0, rb1, rb2, rb3;
    auto ldB = [&](int k0) {
        const float* q = bp + (size_t)(k0 + bk4) * ldb;
        rb0 = *(const float4*)(q); rb1 = *(const float4*)(q + ldb); rb2 = *(const float4*)(q + 2 * (size_t)ldb); rb3 = *(const float4*)(q + 3 * (size_t)ldb);
    };
    auto stage = [&](int buf, int k0) {
        char* As = lds + buf * 2 * G_BUFB; char* Bs = As + G_BUFB;
        uint4 lo, hi; al.cvt(ra, k0 + akq, lo, hi);
        *(uint4*)(As + arow * (G_LDSROW * 2) + akq * 2) = lo;
        *(uint4*)(As + arow * (G_LDSROW * 2) + akq * 2 + 16) = hi;
        uint2 w;
        w.x = pack2(rb0.x, rb1.x); w.y = pack2(rb2.x, rb3.x); *(uint2*)(Bs + (bn4 + 0) * (G_LDSROW * 2) + bk4 * 2) = w;
        w.x = pack2(rb0.y, rb1.y); w.y = pack2(rb2.y, rb3.y); *(uint2*)(Bs + (bn4 + 1) * (G_LDSROW * 2) + bk4 * 2) = w;
        w.x = pack2(rb0.z, rb1.z); w.y = pack2(rb2.z, rb3.z); *(uint2*)(Bs + (bn4 + 2) * (G_LDSROW * 2) + bk4 * 2) = w;
        w.x = pack2(rb0.w, rb1.w); w.y = pack2(rb2.w, rb3.w); *(uint2*)(Bs + (bn4 + 3) * (G_LDSROW * 2) + bk4 * 2) = w;
    };
    ra = al.ld(akq); ldB(0);
    stage(0, 0);
    __syncthreads();
    for (int kt = 0; kt < nk; ++kt) {
        const bool more = (kt + 1 < nk);
        if (more) { ra = al.ld((kt + 1) * G_BK + akq); ldB((kt + 1) * G_BK); }
        const char* As = lds + (kt & 1) * 2 * G_BUFB; const char* Bs = As + G_BUFB;
        bf16x8 af[4], bfr[4];
#pragma unroll
        for (int i = 0; i < 4; ++i) {
            af[i] = *(const bf16x8*)(As + (wr * 64 + i * 16 + fr) * (G_LDSROW * 2) + fq * 16);
            bfr[i] = *(const bf16x8*)(Bs + (wc * 64 + i * 16 + fr) * (G_LDSROW * 2) + fq * 16);
        }
#pragma unroll
        for (int i = 0; i < 4; ++i)
#pragma unroll
            for (int j = 0; j < 4; ++j) acc[i][j] = __builtin_amdgcn_mfma_f32_16x16x32_bf16(bfr[j], af[i], acc[i][j], 0, 0, 0);
        if (more) stage((kt + 1) & 1, (kt + 1) * G_BK);
        __syncthreads();
    }
    epi(acc, wr, wc, fr, fq);
}

#define G2_STAGE 32768
__device__ __forceinline__ void glds16(const bf16_t* g, char* l) {
    __builtin_amdgcn_global_load_lds((const unsigned*)g, (__attribute__((address_space(3))) unsigned*)l, 16, 0, 0);
}
template <class EPI>
__device__ __forceinline__ void gemm2_tile(const Ctx cx, const bf16_t* a0, const bf16_t* a1, const bf16_t* a2, const bf16_t* a3,
                                           const bf16_t* b0, const bf16_t* b1, const bf16_t* b2, const bf16_t* b3, int K, const EPI& epi, char* lds) {
    const int tid = cx.tid, lane = tid & 63, wid = __builtin_amdgcn_readfirstlane(tid >> 6), wr = wid >> 1, wc = wid & 1, fr = lane & 15, fq = lane >> 4;
    f32x4 acc[4][4];
#pragma unroll
    for (int i = 0; i < 4; ++i)
#pragma unroll
        for (int j = 0; j < 4; ++j) acc[i][j] = (f32x4){0.f, 0.f, 0.f, 0.f};
    const int nk = K >> 6;
    auto issue = [&](int kt, int st) {
        char* sa = lds + st * G2_STAGE + wid * 1024;
        const int ko = kt * 64;
        glds16(a0 + ko, sa); glds16(a1 + ko, sa + 4096); glds16(a2 + ko, sa + 8192); glds16(a3 + ko, sa + 12288);
        glds16(b0 + ko, sa + 16384); glds16(b1 + ko, sa + 20480); glds16(b2 + ko, sa + 24576); glds16(b3 + ko, sa + 28672);
    };
    issue(0, 0);
    asm volatile("s_waitcnt vmcnt(0)" ::: "memory");
    __builtin_amdgcn_s_barrier();
    for (int kt = 0; kt < nk; ++kt) {
        if (kt + 1 < nk) issue(kt + 1, (kt + 1) & 1);
        const char* As = lds + (kt & 1) * G2_STAGE; const char* Bs = As + 16384;
#pragma unroll
        for (int ks = 0; ks < 2; ++ks) {
            const int co = ((ks * 4 + fq) ^ (fr & 7)) << 4;
            bf16x8 af[4], bfr[4];
#pragma unroll
            for (int i = 0; i < 4; ++i) {
                af[i] = *(const bf16x8*)(As + (wr * 64 + i * 16 + fr) * 128 + co);
                bfr[i] = *(const bf16x8*)(Bs + (wc * 64 + i * 16 + fr) * 128 + co);
            }
#pragma unroll
            for (int i = 0; i < 4; ++i)
#pragma unroll
                for (int j = 0; j < 4; ++j) acc[i][j] = __builtin_amdgcn_mfma_f32_16x16x32_bf16(bfr[j], af[i], acc[i][j], 0, 0, 0);
        }
        asm volatile("s_waitcnt vmcnt(0) lgkmcnt(0)" ::: "memory");
        __builtin_amdgcn_s_barrier();
    }
    epi(acc, wr, wc, fr, fq);
}
#define G3_STAGE 16384
#define G3_H(q) ((0x1320 >> (4 * (q))) & 3)
#define G3_ROW(i) ((i) * 64 + (cx.tid >> 2))
#define G3_CH8 ((((cx.tid) & 3) ^ G3_H(((cx.tid) >> 4) & 3)) * 8)
struct G3Next { bool has; const bf16_t *a0, *a1, *b0, *b1; int K; };
template <class EPI>
__device__ __forceinline__ void gemm3_tile(const Ctx cx, const bf16_t* a0, const bf16_t* a1, const bf16_t* b0, const bf16_t* b1, int K, const EPI& epi, char* lds, bool pre = false, G3Next nx = G3Next{false, nullptr, nullptr, nullptr, nullptr, 0}) {
    const int tid = cx.tid, lane = tid & 63, wid = __builtin_amdgcn_readfirstlane(tid >> 6), wr = wid >> 1, wc = wid & 1, fr = lane & 15, fq = lane >> 4;
    f32x4 acc[4][4];
#pragma unroll
    for (int i = 0; i < 4; ++i)
#pragma unroll
        for (int j = 0; j < 4; ++j) acc[i][j] = (f32x4){0.f, 0.f, 0.f, 0.f};
    const int nk = K >> 5;
    auto issue = [&](int kt) {
        char* sa = lds + (kt & 3) * G3_STAGE + wid * 1024;
        const int ko = kt * 32;
        glds16(a0 + ko, sa); glds16(a1 + ko, sa + 4096); glds16(b0 + ko, sa + 8192); glds16(b1 + ko, sa + 12288);
    };
    if (!pre) { issue(0); if (nk > 1) issue(1); if (nk > 2) issue(2); }
    else asm volatile("s_waitcnt vmcnt(0)" ::: "memory");
    const int co = (fq ^ G3_H((fr >> 2) & 3)) << 4;
    for (int kt = 0; kt < nk; ++kt) {
        if (kt + 2 < nk) asm volatile("s_waitcnt vmcnt(8)" ::: "memory");
        else if (kt + 1 < nk) asm volatile("s_waitcnt vmcnt(4)" ::: "memory");
        else asm volatile("s_waitcnt vmcnt(0)" ::: "memory");
        asm volatile("s_waitcnt lgkmcnt(0)" ::: "memory");
        __builtin_amdgcn_s_barrier();
        if (kt + 3 < nk) issue(kt + 3);
        const char* As = lds + (kt & 3) * G3_STAGE; const char* Bs = As + 8192;
        bf16x8 af[4], bfr[4];
#pragma unroll
        for (int i = 0; i < 4; ++i) {
            af[i] = *(const bf16x8*)(As + (wr * 64 + i * 16 + fr) * 64 + co);
            bfr[i] = *(const bf16x8*)(Bs + (wc * 64 + i * 16 + fr) * 64 + co);
        }
#pragma unroll
        for (int i = 0; i < 4; ++i)
#pragma unroll
            for (int j = 0; j < 4; ++j) acc[i][j] = __builtin_amdgcn_mfma_f32_16x16x32_bf16(bfr[j], af[i], acc[i][j], 0, 0, 0);
    }
    asm volatile("s_waitcnt lgkmcnt(0)" ::: "memory");
    __builtin_amdgcn_s_barrier();
    if (nx.has) {
        const int nkn = nx.K >> 5;
#pragma unroll
        for (int st = 0; st < 3; ++st) if (st < nkn) {
            char* sa = lds + st * G3_STAGE + wid * 1024; const int ko = st * 32;
            glds16(nx.a0 + ko, sa); glds16(nx.a1 + ko, sa + 4096); glds16(nx.b0 + ko, sa + 8192); glds16(nx.b1 + ko, sa + 12288);
        }
    }
    epi(acc, wr, wc, fr, fq);
}
#define G8_HTB 16384
typedef __attribute__((address_space(3))) unsigned char* G8LP;
__device__ __forceinline__ int g8_lds_byte(int r, int c) { const int st = (r >> 4) * 2 + (c >> 5), rr = r & 15, cc = c & 31, ob = rr * 64 + cc * 2; return st * 1024 + (ob ^ (((ob >> 9) & 1) << 5)); }
__device__ __forceinline__ void g8_stage_rc(int b, int& R, int& C) { const int st = b / 1024, sb = b % 1024, swz = sb ^ (((sb >> 9) & 1) << 5); R = (st >> 1) * 16 + swz / 64; C = (st & 1) * 32 + (swz % 64) / 2; }
struct Unit8 { int pm, pn, e; };
__device__ __forceinline__ int fresh_zero() { int z = 0; asm volatile("" : "+v"(z)); return z; }
__device__ __forceinline__ int fresh_lane() { int l; asm volatile("v_mbcnt_lo_u32_b32 %0, -1, 0\n\tv_mbcnt_hi_u32_b32 %0, -1, %0" : "=v"(l)); return l; }
template <class P>
__device__ __forceinline__ void gemm8(const Ctx px, char* ldsg, const P& prob) {
    G8LP lds = (G8LP)ldsg;
    const int tid = px.tid, wid = __builtin_amdgcn_readfirstlane(tid >> 6), lane = tid & 63, wr = wid >> 2, wc = wid & 3, fr = lane & 15, fq = lane >> 4;
    const int nt = prob.K / 64;
    int R0, C0, R1, C1; g8_stage_rc(tid * 16, R0, C0); g8_stage_rc(tid * 16 + 8192, R1, C1);
    Unit8 cur, nxt; int ui = 0;
    if (!prob.next(0, cur)) return;
    unsigned cA[2][2], cB[2][2], nA[2][2], nB[2][2];
#define G8_OFFS(u, oa, ob) do { _Pragma("unroll") for (int h_ = 0; h_ < 2; ++h_) { \
        oa[h_][0] = prob.offA(u, h_ * 128 + R0) + (unsigned)C0 * 2u; oa[h_][1] = prob.offA(u, h_ * 128 + R1) + (unsigned)C1 * 2u; \
        ob[h_][0] = prob.offB(u, h_ * 128 + R0) + (unsigned)C0 * 2u; ob[h_][1] = prob.offB(u, h_ * 128 + R1) + (unsigned)C1 * 2u; } } while (0)
    G8_OFFS(cur, cA, cB);
    const char* bAc = prob.baseA(cur); const char* bBc = prob.baseB(cur);
    const unsigned ldsw = (unsigned)wid * 1024u;
    const int aoff = g8_lds_byte(wr * 64 + fr, fq * 8), boff = g8_lds_byte(wc * 32 + fr, fq * 8);
#define G8_SA(b, h) (((b) * 2 + (h)) * G8_HTB)
#define G8_SB(b, h) ((4 + (b) * 2 + (h)) * G8_HTB)
#define G8_STAGE(bufoff, gbase, voff, kb) do { _Pragma("unroll") for (int _i = 0; _i < 2; ++_i) \
        __builtin_amdgcn_global_load_lds((const unsigned*)((gbase) + (size_t)((voff)[_i] + (unsigned)(kb))), (__attribute__((address_space(3))) unsigned*)(lds + (bufoff) + ldsw + _i * 8192), 16, 0, 0); } while (0)
#define G8_LDA(dst, b, h) do { _Pragma("unroll") for (int m = 0; m < 4; ++m) _Pragma("unroll") for (int k = 0; k < 2; ++k) dst[m][k] = *(const __attribute__((address_space(3))) bf16x8*)(lds + G8_SA(b, h) + aoff + m * 2048 + k * 1024); } while (0)
#define G8_LDB(dst, b, h) do { _Pragma("unroll") for (int n = 0; n < 2; ++n) _Pragma("unroll") for (int k = 0; k < 2; ++k) dst[n][k] = *(const __attribute__((address_space(3))) bf16x8*)(lds + G8_SB(b, h) + boff + n * 2048 + k * 1024); } while (0)
#define G8_MMA(ai, bj, At, Bt) do { __builtin_amdgcn_s_setprio(1); _Pragma("unroll") for (int m = 0; m < 4; ++m) _Pragma("unroll") for (int n = 0; n < 2; ++n) _Pragma("unroll") for (int k = 0; k < 2; ++k) \
        acc[ai][bj][m][n] = __builtin_amdgcn_mfma_f32_16x16x32_bf16(Bt[n][k], At[m][k], acc[ai][bj][m][n], 0, 0, 0); __builtin_amdgcn_s_setprio(0); } while (0)
#define G8_WAIT_V(n) asm volatile("s_waitcnt vmcnt(" #n ")" ::: "memory")
#define G8_WAIT_L(n) asm volatile("s_waitcnt lgkmcnt(" #n ")" ::: "memory")
#define G8_BAR __builtin_amdgcn_s_barrier()
#define G8_SCHED __builtin_amdgcn_sched_barrier(0)
    f32x4 acc[2][2][4][2];
#pragma unroll
    for (int a = 0; a < 2; ++a)
#pragma unroll
        for (int b = 0; b < 2; ++b)
#pragma unroll
            for (int m = 0; m < 4; ++m)
#pragma unroll
                for (int n = 0; n < 2; ++n) acc[a][b][m][n] = (f32x4){0.f, 0.f, 0.f, 0.f};
    bf16x8 At[4][2], B0[2][2], B1[2][2];
    G8_STAGE(G8_SB(0, 0), bBc, cB[0], 0); G8_STAGE(G8_SA(0, 0), bAc, cA[0], 0); G8_STAGE(G8_SB(0, 1), bBc, cB[1], 0); G8_STAGE(G8_SA(0, 1), bAc, cA[1], 0);
    if (wr == 1) G8_BAR;
    G8_WAIT_V(4); G8_BAR;
    G8_STAGE(G8_SB(1, 0), bBc, cB[0], 128); G8_STAGE(G8_SA(1, 0), bAc, cA[0], 128); G8_STAGE(G8_SB(1, 1), bBc, cB[1], 128);
    G8_WAIT_V(6); G8_BAR;
    for (;;) {
        const bool has_next = prob.next(ui + 1, nxt);
        const char* bAn = bAc; const char* bBn = bBc;
        if (has_next) { G8_OFFS(nxt, nA, nB); bAn = prob.baseA(nxt); bBn = prob.baseB(nxt); }
        else {
#pragma unroll
            for (int h_ = 0; h_ < 2; ++h_) { nA[h_][0] = cA[h_][0]; nA[h_][1] = cA[h_][1]; nB[h_][0] = cB[h_][0]; nB[h_][1] = cB[h_][1]; }
        }
        for (int t = 0; t < nt; t += 2) {
            const bool last = (t == nt - 2);
            const unsigned k1 = (unsigned)(t + 1) * 128u;
            const char* a2b = last ? bAn : bAc; const char* b2b = last ? bBn : bBc;
            const unsigned k2 = last ? 0u : (unsigned)(t + 2) * 128u, k3 = k2 + 128u;
            unsigned a2o0[2], a2o1[2], b2o0[2], b2o1[2];
            a2o0[0] = last ? nA[0][0] : cA[0][0]; a2o0[1] = last ? nA[0][1] : cA[0][1]; a2o1[0] = last ? nA[1][0] : cA[1][0]; a2o1[1] = last ? nA[1][1] : cA[1][1];
            b2o0[0] = last ? nB[0][0] : cB[0][0]; b2o0[1] = last ? nB[0][1] : cB[0][1]; b2o1[0] = last ? nB[1][0] : cB[1][0]; b2o1[1] = last ? nB[1][1] : cB[1][1];
            G8_LDB(B0, 0, 0); G8_SCHED; G8_LDA(At, 0, 0); G8_STAGE(G8_SA(1, 1), bAc, cA[1], k1);
            G8_WAIT_L(8); G8_BAR; G8_WAIT_L(0); G8_MMA(0, 0, At, B0); G8_BAR; G8_SCHED;
            G8_LDB(B1, 0, 1); G8_STAGE(G8_SB(0, 0), b2b, b2o0, k2);
            G8_BAR; G8_WAIT_L(0); G8_MMA(0, 1, At, B1); G8_BAR;
            G8_LDA(At, 0, 1); G8_STAGE(G8_SA(0, 0), a2b, a2o0, k2);
            G8_BAR; G8_WAIT_L(0); G8_MMA(1, 0, At, B0); G8_BAR; G8_SCHED;
            G8_STAGE(G8_SB(0, 1), b2b, b2o1, k2);
            G8_WAIT_V(6); G8_BAR; G8_MMA(1, 1, At, B1); G8_BAR;
            G8_LDB(B0, 1, 0); G8_SCHED; G8_LDA(At, 1, 0); G8_STAGE(G8_SA(0, 1), a2b, a2o1, k2);
            G8_WAIT_L(8); G8_BAR; G8_WAIT_L(0); G8_MMA(0, 0, At, B0); G8_BAR; G8_SCHED;
            G8_LDB(B1, 1, 1); G8_STAGE(G8_SB(1, 0), b2b, b2o0, k3);
            G8_BAR; G8_WAIT_L(0); G8_MMA(0, 1, At, B1); G8_BAR;
            G8_LDA(At, 1, 1); G8_STAGE(G8_SA(1, 0), a2b, a2o0, k3);
            G8_BAR; G8_WAIT_L(0); G8_MMA(1, 0, At, B0); G8_BAR; G8_SCHED;
            G8_STAGE(G8_SB(1, 1), b2b, b2o1, k3);
            G8_WAIT_V(6); G8_BAR; G8_MMA(1, 1, At, B1); G8_BAR;
        }
        { const int le = fresh_lane(); prob.epi(acc, cur, wr, wc, le & 15, le >> 4); }
        if (!has_next) break;
#pragma unroll
        for (int a = 0; a < 2; ++a)
#pragma unroll
            for (int b = 0; b < 2; ++b)
#pragma unroll
                for (int m = 0; m < 4; ++m)
#pragma unroll
                    for (int n = 0; n < 2; ++n) acc[a][b][m][n] = (f32x4){0.f, 0.f, 0.f, 0.f};
        cur = nxt; bAc = bAn; bBc = bBn; ++ui;
#pragma unroll
        for (int h_ = 0; h_ < 2; ++h_) { cA[h_][0] = nA[h_][0]; cA[h_][1] = nA[h_][1]; cB[h_][0] = nB[h_][0]; cB[h_][1] = nB[h_][1]; }
    }
    G8_WAIT_V(0);
    if (wr == 0) G8_BAR;
    G8_BAR;
#undef G8_OFFS
#undef G8_SA
#undef G8_SB
#undef G8_STAGE
#undef G8_LDA
#undef G8_LDB
#undef G8_MMA
#undef G8_WAIT_V
#undef G8_WAIT_L
#undef G8_BAR
#undef G8_SCHED
}
struct ProbOproj {
    const bf16_t* A; const bf16_t* Wt; float* out; const float* xl; const float* modl; int K; int c, G;
    __device__ __forceinline__ bool next(int i, Unit8& u) const { const int L = i * G + c; if (L >= 256) return false; const int x = L & 7, j = L >> 3; u.pn = j >> 3; u.pm = 8 * x + (j & 7); u.e = 0; return true; }
    __device__ __forceinline__ const char* baseA(const Unit8& u) const { return (const char*)(A + (size_t)u.pm * 256 * DM); }
    __device__ __forceinline__ const char* baseB(const Unit8& u) const { return (const char*)(Wt + (size_t)u.pn * 256 * 1024); }
    __device__ __forceinline__ unsigned offA(const Unit8&, int row) const { return (unsigned)row * (DM * 2); }
    __device__ __forceinline__ unsigned offB(const Unit8&, int rho) const { return (unsigned)rho * 2048u; }
    __device__ __forceinline__ void epi(const f32x4 (&acc)[2][2][4][2], const Unit8& u, int wr, int wc, int fr, int fq) const {
#pragma unroll
        for (int ai = 0; ai < 2; ++ai)
#pragma unroll
            for (int m = 0; m < 4; ++m) {
                const int row = u.pm * 256 + ai * 128 + wr * 64 + m * 16 + fr;
                const float* xr = xl + (size_t)row * DM;
                const float* gt = modl + (size_t)(row >> 13) * 6144 + 2 * 1024;
#pragma unroll
                for (int bj = 0; bj < 2; ++bj)
#pragma unroll
                    for (int n = 0; n < 2; ++n) {
                        const int col = u.pn * 256 + bj * 128 + wc * 32 + n * 16 + 4 * fq;
                        const f32x4 xv = *(const f32x4*)(xr + col), gv = *(const f32x4*)(gt + col);
                        f32x4 o;
#pragma unroll
                        for (int r = 0; r < 4; ++r) o[r] = ALPHA_F * xv[r] + gv[r] * acc[ai][bj][m][n][r];
                        *(f32x4*)(out + (size_t)row * DM + col) = o;
                    }
            }
    }
};
struct ProbRKV {
    PPtr p; int K; int c, G;
    __device__ __forceinline__ bool next(int i, Unit8& u) const { const int L = i * G + c; if (L >= 768) return false; const int cc = L & 255, x = cc & 7, j = cc >> 3; u.pn = (L >> 8) * 4 + (j >> 3); u.pm = 8 * x + (j & 7); u.e = 0; return true; }
    __device__ __forceinline__ const char* baseA(const Unit8& u) const { const int g = u.pn >> 2; const int msel = g == 0 ? 0 : (g == 1 ? 2 : 3); return (const char*)(p->XM + ((size_t)msel * ROWS + (size_t)u.pm * 256) * DM); }
    __device__ __forceinline__ const char* baseB(const Unit8& u) const { const int g = u.pn >> 2; const bf16_t* w = g == 0 ? p->wrT : (g == 1 ? p->wkT : p->wvT); return (const char*)(w + (size_t)(u.pn & 3) * 256 * 1024); }
    __device__ __forceinline__ unsigned offA(const Unit8&, int row) const { return (unsigned)row * 2048u; }
    __device__ __forceinline__ unsigned offB(const Unit8&, int rho) const { const int bj = rho >> 7, wc = (rho >> 5) & 3, w = rho & 31; return (unsigned)(64 * wc + 32 * bj + w) * 2048u; }
    __device__ __forceinline__ void epi(const f32x4 (&acc)[2][2][4][2], const Unit8& u, int wr, int wc, int fr, int fq) const {
        const int g = u.pn >> 2, lane = fr + 16 * fq;
        const int cb = (u.pn & 3) * 256 + 64 * wc + 4 * fq;
        bf16_t* out = g == 0 ? p->R : (g == 1 ? p->K : p->V);
#pragma unroll
        for (int ai = 0; ai < 2; ++ai)
#pragma unroll
            for (int m = 0; m < 4; ++m) {
                const int row = u.pm * 256 + ai * 128 + wr * 64 + m * 16 + fr;
                if (g != 1) {
#pragma unroll
                    for (int bj = 0; bj < 2; ++bj)
#pragma unroll
                        for (int n = 0; n < 2; ++n) {
                            uint2 o; o.x = pack2(acc[ai][bj][m][n][0], acc[ai][bj][m][n][1]); o.y = pack2(acc[ai][bj][m][n][2], acc[ai][bj][m][n][3]);
                            *(uint2*)(out + (size_t)row * DM + cb + 32 * bj + 16 * n) = o;
                        }
                } else {
                    f32x4 kv[2][2]; float ss = 0.f;
#pragma unroll
                    for (int bj = 0; bj < 2; ++bj)
#pragma unroll
                        for (int n = 0; n < 2; ++n) {
                            const int col = cb + 32 * bj + 16 * n;
                            const f32x4 kw = *(const f32x4*)(p->rw_kk + col);
                            uint2 o; o.x = pack2(acc[ai][bj][m][n][0], acc[ai][bj][m][n][1]); o.y = pack2(acc[ai][bj][m][n][2], acc[ai][bj][m][n][3]);
                            *(uint2*)(out + (size_t)row * DM + col) = o;
                            f32x4 t; t[0] = bflo(o.x) * kw[0]; t[1] = bfhi(o.x) * kw[1]; t[2] = bflo(o.y) * kw[2]; t[3] = bfhi(o.y) * kw[3];
                            kv[bj][n] = t; ss += (t[0] * t[0] + t[1] * t[1]) + (t[2] * t[2] + t[3] * t[3]);
                        }
                    ss += shx(ss, 16, lane); ss += shx(ss, 32, lane);
                    const float inv = fminf(__builtin_amdgcn_rsqf(ss), 1e12f);
#pragma unroll
                    for (int bj = 0; bj < 2; ++bj)
#pragma unroll
                        for (int n = 0; n < 2; ++n) *(f32x4*)(p->KK + (size_t)row * DM + cb + 32 * bj + 16 * n) = kv[bj][n] * inv;
                }
            }
    }
};
struct ProbQKV {
    PPtr p; int K; int c, G;
    __device__ __forceinline__ bool next(int i, Unit8& u) const { const int L = i * G + c; if (L >= 384) return false; const int cc = L & 255, x = cc & 7, j = cc >> 3; u.pn = (L >> 8) * 4 + (j >> 3); u.pm = 8 * x + (j & 7); u.e = 0; return true; }
    __device__ __forceinline__ const char* baseA(const Unit8& u) const { return (const char*)(p->HB + (size_t)u.pm * 256 * DM); }
    __device__ __forceinline__ const char* baseB(const Unit8& u) const { return (const char*)(p->wqkvT + (size_t)u.pn * 256 * 1024); }
    __device__ __forceinline__ unsigned offA(const Unit8&, int row) const { return (unsigned)row * 2048u; }
    __device__ __forceinline__ unsigned offB(const Unit8&, int rho) const { const int bj = rho >> 7, wc = (rho >> 5) & 3, w = rho & 31; return (unsigned)(64 * wc + 32 * bj + w) * 2048u; }
    __device__ __forceinline__ void epi(const f32x4 (&acc)[2][2][4][2], const Unit8& u, int wr, int wc, int fr, int fq) const {
        const int hs = u.pn * 4 + wc;
#pragma unroll
        for (int ai = 0; ai < 2; ++ai)
#pragma unroll
            for (int m = 0; m < 4; ++m) {
                const int row = u.pm * 256 + ai * 128 + wr * 64 + m * 16 + fr;
                const int t = row & (TLAT - 1), b = row >> 13;
                if (hs < 20) {
                    f32x4 v0 = acc[ai][0][m][0], v1 = acc[ai][0][m][1], v2 = acc[ai][1][m][0], v3 = acc[ai][1][m][1];
                    const int rp = t >> 6, cp = t & 63;
#pragma unroll
                    for (int r = 0; r < 4; ++r) {
                        const int fi = 4 * fq + r;
                        const float2 cr = *(const float2*)(p->rope + 2 * (rp * 16 + fi)), cc = *(const float2*)(p->rope + 2 * (cp * 16 + fi));
                        const float a = v0[r], bb = v1[r]; v0[r] = a * cr.x - bb * cr.y; v1[r] = bb * cr.x + a * cr.y;
                        const float c2 = v2[r], d2 = v3[r]; v2[r] = c2 * cc.x - d2 * cc.y; v3[r] = d2 * cc.x + c2 * cc.y;
                    }
                    const float sc = hs < 16 ? 0.125f : 1.f;
                    bf16_t* dst = hs < 16 ? p->Q + (size_t)row * DM + hs * 64 + 4 * fq : p->KA + (size_t)row * 256 + (hs - 16) * 64 + 4 * fq;
                    uint2 o;
                    o.x = pack2(v0[0] * sc, v0[1] * sc); o.y = pack2(v0[2] * sc, v0[3] * sc); *(uint2*)(dst) = o;
                    o.x = pack2(v1[0] * sc, v1[1] * sc); o.y = pack2(v1[2] * sc, v1[3] * sc); *(uint2*)(dst + 16) = o;
                    o.x = pack2(v2[0] * sc, v2[1] * sc); o.y = pack2(v2[2] * sc, v2[3] * sc); *(uint2*)(dst + 32) = o;
                    o.x = pack2(v3[0] * sc, v3[1] * sc); o.y = pack2(v3[2] * sc, v3[3] * sc); *(uint2*)(dst + 48) = o;
                } else {
                    bf16_t* vt = p->VTL + (size_t)(b * 4 + (hs - 20)) * 64 * TLAT + t;
#pragma unroll
                    for (int bj = 0; bj < 2; ++bj)
#pragma unroll
                        for (int n = 0; n < 2; ++n)
#pragma unroll
                            for (int r = 0; r < 4; ++r) vt[(size_t)(32 * bj + 16 * n + 4 * fq + r) * TLAT] = f2bf(acc[ai][bj][m][n][r]);
                }
            }
    }
};
struct ProbUp {
    PPtr p; int K; int c, G; int layer;
    __device__ __forceinline__ bool next(int i, Unit8& u) const { const int L = i * G + c; if (L >= 2048) return false; const int cc = L & 255, x = cc & 7, j = cc >> 3; u.e = (L >> 8) * 2 + (x >> 2); u.pn = 4 * (x & 3) + (j & 3); u.pm = j >> 2; return true; }
    __device__ __forceinline__ const char* baseA(const Unit8&) const { return (const char*)p->H2; }
    __device__ __forceinline__ const char* baseB(const Unit8& u) const { return (const char*)(p->CW + (size_t)(layer * 16 + u.e) * 3 * 2097152); }
    __device__ __forceinline__ unsigned offA(const Unit8& u, int row) const { const int src = p->idx[u.e * MPAD0 + u.pm * 256 + row]; return (unsigned)src * 2048u; }
    __device__ __forceinline__ unsigned offB(const Unit8& u, int rho) const { const int bj = rho >> 7, wc = (rho >> 5) & 3, n = (rho >> 4) & 1, cc = rho & 15; return (unsigned)n * 4194304u + (unsigned)(128 * u.pn + 64 * bj + 16 * wc + cc) * 2048u; }
    __device__ __forceinline__ void epi(const f32x4 (&acc)[2][2][4][2], const Unit8& u, int wr, int wc, int fr, int fq) const {
        bf16_t* out = p->HMID + (size_t)u.e * MPAD0 * 2048;
#pragma unroll
        for (int ai = 0; ai < 2; ++ai)
#pragma unroll
            for (int m = 0; m < 4; ++m) {
                const int slot = u.pm * 256 + ai * 128 + wr * 64 + m * 16 + fr;
#pragma unroll
                for (int bj = 0; bj < 2; ++bj) {
                    float v[4];
#pragma unroll
                    for (int r = 0; r < 4; ++r) { const float a = acc[ai][bj][m][0][r], uu = acc[ai][bj][m][1][r]; v[r] = a * sigmoidf_(a) * uu; }
                    uint2 o; o.x = pack2(v[0], v[1]); o.y = pack2(v[2], v[3]);
                    *(uint2*)(out + (size_t)slot * 2048 + 128 * u.pn + 64 * bj + 16 * wc + 4 * fq) = o;
                }
            }
    }
};
struct ProbDown {
    PPtr p; int K; int c, G; int layer;
    __device__ __forceinline__ bool next(int i, Unit8& u) const { const int L = i * G + c; if (L >= 512) return false; const int cc = L & 255, x = cc & 7, j = cc >> 3; u.e = (L >> 8) * 8 + x; u.pn = j & 3; u.pm = j >> 2; return true; }
    __device__ __forceinline__ const char* baseA(const Unit8& u) const { return (const char*)(p->HMID + ((size_t)u.e * MPAD0 + (size_t)u.pm * 256) * 2048); }
    __device__ __forceinline__ const char* baseB(const Unit8& u) const { return (const char*)(p->CW + ((size_t)(layer * 16 + u.e) * 3 + 2) * 2097152 + (size_t)u.pn * 256 * 2048); }
    __device__ __forceinline__ unsigned offA(const Unit8&, int row) const { return (unsigned)row * 4096u; }
    __device__ __forceinline__ unsigned offB(const Unit8&, int rho) const { return (unsigned)rho * 4096u; }
    __device__ __forceinline__ void epi(const f32x4 (&acc)[2][2][4][2], const Unit8& u, int wr, int wc, int fr, int fq) const {
        bf16_t* out = p->YE + (size_t)u.e * MPAD0 * DM;
#pragma unroll
        for (int ai = 0; ai < 2; ++ai)
#pragma unroll
            for (int m = 0; m < 4; ++m) {
                const int slot = u.pm * 256 + ai * 128 + wr * 64 + m * 16 + fr;
                const float g = p->gate[u.e * MPAD0 + slot];
#pragma unroll
                for (int bj = 0; bj < 2; ++bj)
#pragma unroll
                    for (int n = 0; n < 2; ++n) {
                        uint2 o; o.x = pack2(acc[ai][bj][m][n][0] * g, acc[ai][bj][m][n][1] * g); o.y = pack2(acc[ai][bj][m][n][2] * g, acc[ai][bj][m][n][3] * g);
                        *(uint2*)(out + (size_t)slot * DM + u.pn * 256 + bj * 128 + wc * 32 + n * 16 + 4 * fq) = o;
                    }
            }
    }
};
__device__ __forceinline__ void conv_tile(const Ctx cx, const float* src, int ldn, bf16_t* dst, int ldk, int k0, int n0, char* lds, bool valid) {
    bf16_t* T = (bf16_t*)lds;
    const int tid = cx.tid;
    {
        const int k4 = (tid >> 4) * 4, n4 = (tid & 15) * 4;
        const float* q = src + (size_t)(k0 + k4) * ldn + n0 + n4;
        float4 r0 = make_float4(0.f, 0.f, 0.f, 0.f), r1 = r0, r2 = r0, r3 = r0;
        if (valid) { r0 = *(const float4*)q; r1 = *(const float4*)(q + ldn); r2 = *(const float4*)(q + 2 * (size_t)ldn); r3 = *(const float4*)(q + 3 * (size_t)ldn); }
        uint2 w;
        w.x = pack2(r0.x, r1.x); w.y = pack2(r2.x, r3.x); *(uint2*)(T + (n4 + 0) * 72 + k4) = w;
        w.x = pack2(r0.y, r1.y); w.y = pack2(r2.y, r3.y); *(uint2*)(T + (n4 + 1) * 72 + k4) = w;
        w.x = pack2(r0.z, r1.z); w.y = pack2(r2.z, r3.z); *(uint2*)(T + (n4 + 2) * 72 + k4) = w;
        w.x = pack2(r0.w, r1.w); w.y = pack2(r2.w, r3.w); *(uint2*)(T + (n4 + 3) * 72 + k4) = w;
    }
    __syncthreads();
    {
        const int n = tid >> 2, kc = (tid & 3) * 16;
        const uint4 u0 = *(const uint4*)(T + n * 72 + kc), u1 = *(const uint4*)(T + n * 72 + kc + 8);
        bf16_t* d = dst + (size_t)(n0 + n) * ldk + k0 + kc;
        if (valid) { *(uint4*)d = u0; *(uint4*)(d + 8) = u1; }
    }
    __syncthreads();
}
struct Conv4Regs { float4 r[4][4]; };
__device__ __forceinline__ void conv4_load(const Ctx cx, Conv4Regs& R, const float* src, int ldn, int k0, int n0, bool valid) {
    const int tid = cx.tid, k4 = (tid >> 4) * 4, n4 = (tid & 15) * 4;
#pragma unroll
    for (int s4 = 0; s4 < 4; ++s4) {
        const float* q = src + (size_t)(k0 + k4) * ldn + n0 + 64 * s4 + n4;
        if (valid) { R.r[s4][0] = *(const float4*)q; R.r[s4][1] = *(const float4*)(q + ldn); R.r[s4][2] = *(const float4*)(q + 2 * (size_t)ldn); R.r[s4][3] = *(const float4*)(q + 3 * (size_t)ldn); }
        else { R.r[s4][0] = R.r[s4][1] = R.r[s4][2] = R.r[s4][3] = make_float4(0.f, 0.f, 0.f, 0.f); }
    }
}
__device__ __forceinline__ void conv4_finish(const Ctx cx, const Conv4Regs& R, bf16_t* dst, int ldk, int k0, int n0, char* lds, bool valid) {
    const int tid = cx.tid, k4 = (tid >> 4) * 4, n4 = (tid & 15) * 4;
#pragma unroll
    for (int s4 = 0; s4 < 4; ++s4) {
        bf16_t* T = (bf16_t*)lds + s4 * (64 * 72);
        uint2 w;
        w.x = pack2(R.r[s4][0].x, R.r[s4][1].x); w.y = pack2(R.r[s4][2].x, R.r[s4][3].x); *(uint2*)(T + (n4 + 0) * 72 + k4) = w;
        w.x = pack2(R.r[s4][0].y, R.r[s4][1].y); w.y = pack2(R.r[s4][2].y, R.r[s4][3].y); *(uint2*)(T + (n4 + 1) * 72 + k4) = w;
        w.x = pack2(R.r[s4][0].z, R.r[s4][1].z); w.y = pack2(R.r[s4][2].z, R.r[s4][3].z); *(uint2*)(T + (n4 + 2) * 72 + k4) = w;
        w.x = pack2(R.r[s4][0].w, R.r[s4][1].w); w.y = pack2(R.r[s4][2].w, R.r[s4][3].w); *(uint2*)(T + (n4 + 3) * 72 + k4) = w;
    }
    __syncthreads();
    {
        const int n = tid >> 2, kc = (tid & 3) * 16;
#pragma unroll
        for (int s4 = 0; s4 < 4; ++s4) {
            const bf16_t* T = (const bf16_t*)lds + s4 * (64 * 72);
            const uint4 u0 = *(const uint4*)(T + n * 72 + kc), u1 = *(const uint4*)(T + n * 72 + kc + 8);
            bf16_t* d = dst + (size_t)(n0 + 64 * s4 + n) * ldk + k0 + kc;
            if (valid) { *(uint4*)d = u0; *(uint4*)(d + 8) = u1; }
        }
    }
    __syncthreads();
}
__device__ __forceinline__ void conv_tile_w(int lane, const float* src, int ldn, bf16_t* dst, int ldk, int k0, int n0, bf16_t* T) {
    const int n4 = (lane & 15) * 4, kq = lane >> 4;
    float4 r[4][4];
#pragma unroll
    for (int i = 0; i < 4; ++i) {
        const float* q = src + (size_t)(k0 + (kq + 4 * i) * 4) * ldn + n0 + n4;
        r[i][0] = *(const float4*)q; r[i][1] = *(const float4*)(q + ldn); r[i][2] = *(const float4*)(q + 2 * (size_t)ldn); r[i][3] = *(const float4*)(q + 3 * (size_t)ldn);
    }
#pragma unroll
    for (int i = 0; i < 4; ++i) {
        const int k4 = (kq + 4 * i) * 4;
        uint2 w;
        w.x = pack2(r[i][0].x, r[i][1].x); w.y = pack2(r[i][2].x, r[i][3].x); *(uint2*)(T + (n4 + 0) * 72 + k4) = w;
        w.x = pack2(r[i][0].y, r[i][1].y); w.y = pack2(r[i][2].y, r[i][3].y); *(uint2*)(T + (n4 + 1) * 72 + k4) = w;
        w.x = pack2(r[i][0].z, r[i][1].z); w.y = pack2(r[i][2].z, r[i][3].z); *(uint2*)(T + (n4 + 2) * 72 + k4) = w;
        w.x = pack2(r[i][0].w, r[i][1].w); w.y = pack2(r[i][2].w, r[i][3].w); *(uint2*)(T + (n4 + 3) * 72 + k4) = w;
    }
    asm volatile("s_waitcnt lgkmcnt(0)" ::: "memory");
    bf16_t* d = dst + (size_t)(n0 + lane) * ldk + k0;
#pragma unroll
    for (int j = 0; j < 8; ++j) { const uint4 u = *(const uint4*)(T + lane * 72 + 8 * j); *(uint4*)(d + 8 * j) = u; }
    asm volatile("s_waitcnt lgkmcnt(0)" ::: "memory");
}
__device__ __forceinline__ void conv_moe_w(PRef p, int lane, int cw, int ncw, bf16_t* T) {
    for (int t = cw; t < 2 * 16 * 3 * 512; t += ncw) {
        const int le = t / 1536, rem = t % 1536, mat = rem >> 9, tl = rem & 511;
        const float* src = (mat == 0 ? p.moe_w_gate : (mat == 1 ? p.moe_w_up : p.moe_w_down)) + (size_t)le * 2097152;
        bf16_t* dst = p.CW + ((size_t)le * 3 + mat) * 2097152;
        const int K = mat == 2 ? 2048 : 1024, N = mat == 2 ? 1024 : 2048;
        const int nn = N >> 6, nt = tl % nn, kt = tl / nn;
        conv_tile_w(lane, src, N, dst, K, kt * 64, nt * 64, T);
    }
}
__device__ __forceinline__ void conv_small(const Ctx cx, PRef p, char* lds, int t_lo, int t_hi, int cid, int cnb) {
    const int ntl = t_hi - t_lo;
    const int trips = (ntl - (cid & ~1) + cnb - 1) / cnb;
    for (int it = 0; it < trips; ++it) {
        const int t0 = cid + it * cnb; const bool valid = t0 < ntl; const int t = t_lo + (valid ? t0 : 0);
        const float* src; bf16_t* dst; int K, N, tl;
        if (t < 768) { const int w = t >> 8; tl = t & 255; src = w == 0 ? p.rw_wr : (w == 1 ? p.rw_wk : p.rw_wv); dst = w == 0 ? p.wrT : (w == 1 ? p.wkT : p.wvT); K = 1024; N = 1024; }
        else if (t < 800) { tl = t - 768; src = p.rw_g1; dst = p.l1T; K = 1024; N = 128; }
        else if (t < 832) { const int d = (t - 800) >> 4; tl = (t - 800) & 15; src = p.rw_w1 + (size_t)d * 65536; dst = p.l1T + (size_t)(128 + 64 * d) * 1024; K = 1024; N = 64; }
        else if (t < 864) { const int d = (t - 832) >> 4; tl = (t - 832) & 15; src = p.rw_a1 + (size_t)d * 65536; dst = p.l1T + (size_t)(256 + 64 * d) * 1024; K = 1024; N = 64; }
        else if (t < 896) { tl = t - 864; src = p.rw_g2; dst = p.g2T; K = 128; N = 1024; }
        else if (t < 928) { const int d = (t - 896) >> 4; tl = (t - 896) & 15; src = p.rw_w2 + (size_t)d * 65536; dst = p.w2T + (size_t)d * 65536; K = 64; N = 1024; }
        else if (t < 960) { const int d = (t - 928) >> 4; tl = (t - 928) & 15; src = p.rw_a2 + (size_t)d * 65536; dst = p.a2T + (size_t)d * 65536; K = 64; N = 1024; }
        else if (t < 1216) { tl = t - 960; src = p.rw_wo; dst = p.woT; K = 1024; N = 1024; }
        else if (t < 1600) { tl = t - 1216; src = p.at_wqkv; dst = p.wqkvT; K = 1024; N = 1536; }
        else { tl = t - 1600; src = p.at_wo; dst = p.atwoT; K = 1024; N = 1024; }
        const int nn = N >> 6, nt = tl % nn, kt = tl / nn;
        conv_tile(cx, src, N, dst, K, kt * 64, nt * 64, lds, valid);
    }
}
__device__ __forceinline__ void conv_moe(const Ctx cx, PRef p, char* lds, int cid, int cnb) {
    const int NTL = 2 * 16 * 3 * 128;
    const int trips = (NTL - (cid & ~1) + cnb - 1) / cnb;
#define CONV_DESC(t0_, valid_, src_, dst_, K_, N_, k0_, n0_) \
        const bool valid_ = (t0_) < NTL; const int tq_##valid_ = valid_ ? (t0_) : 0; \
        const int le_##valid_ = tq_##valid_ / 384, rem_##valid_ = tq_##valid_ % 384, mat_##valid_ = rem_##valid_ >> 7, tl_##valid_ = rem_##valid_ & 127; \
        const float* src_ = (mat_##valid_ == 0 ? p.moe_w_gate : (mat_##valid_ == 1 ? p.moe_w_up : p.moe_w_down)) + (size_t)le_##valid_ * 2097152; \
        bf16_t* dst_ = p.CW + ((size_t)le_##valid_ * 3 + mat_##valid_) * 2097152; \
        const int K_ = mat_##valid_ == 2 ? 2048 : 1024, N_ = mat_##valid_ == 2 ? 1024 : 2048; \
        const int k0_ = (tl_##valid_ / (N_ >> 8)) * 64, n0_ = (tl_##valid_ % (N_ >> 8)) * 256
    Conv4Regs Ra, Rb;
    { CONV_DESC(cid, v0, s0, d0, K0, N0, k00, n00); (void)d0; (void)K0; conv4_load(cx, Ra, s0, N0, k00, n00, v0); }
    for (int it = 0; it < trips; it += 2) {
        { CONV_DESC(cid + (it + 1) * cnb, v1, s1, d1, K1, N1, k01, n01); (void)d1; (void)K1; conv4_load(cx, Rb, s1, N1, k01, n01, v1 && (it + 1 < trips)); }
        { CONV_DESC(cid + it * cnb, v2, s2, d2, K2, N2, k02, n02); (void)s2; (void)N2; conv4_finish(cx, Ra, d2, K2, k02, n02, lds, v2); }
        if (it + 1 < trips) {
            { CONV_DESC(cid + (it + 2) * cnb, v3, s3, d3, K3, N3, k03, n03); (void)d3; (void)K3; conv4_load(cx, Ra, s3, N3, k03, n03, v3 && (it + 2 < trips)); }
            { CONV_DESC(cid + (it + 1) * cnb, v4, s4, d4, K4, N4, k04, n04); (void)s4; (void)N4; conv4_finish(cx, Rb, d4, K4, k04, n04, lds, v4); }
        }
    }
#undef CONV_DESC
}
__device__ __forceinline__ void ph_ada(const Ctx cx, PRef p, char* ldsc) {
    float* sv = (float*)ldsc;
    for (int i = cx.tid; i < 3072; i += NTHR) {
        const int s = i >> 10, k = i & 1023;
        const float v = (s < 2) ? p.c[s * 1024 + k] : p.c_ctx[k];
        sv[i] = v / (1.f + __expf(-v));
    }
    __syncthreads();
    const int lane = cx.tid & 63, gw = (cx.bid * NTHR + cx.tid) >> 6, nw = (cx.nb * NTHR) >> 6;
    for (int item = gw; item < 3072; item += nw) {
        const int ks = item & 15, ch = (item >> 4) % 96, l = item / (16 * 96), n0 = ch * 64, kb = ks * 64;
        const float* w = p.ada_w + (size_t)l * 1024 * 6144 + n0 + lane;
        float a0 = 0.f, a1 = 0.f, a2 = 0.f;
#pragma unroll 32
        for (int k = 0; k < 64; ++k) {
            const float wv = w[(size_t)(kb + k) * 6144];
            a0 += wv * sv[kb + k]; a1 += wv * sv[1024 + kb + k]; a2 += wv * sv[2048 + kb + k];
        }
        float* mo = p.modp + ((size_t)ks * 6 + l * 3) * 6144 + n0 + lane;
        mo[0] = a0; mo[6144] = a1; mo[2 * 6144] = a2;
    }
    for (int i = cx.bid * NTHR + cx.tid; i < 128 * 16; i += cx.nb * NTHR) {
        const int pos = i >> 4, fi = i & 15;
        const float th = __builtin_amdgcn_exp2f(-(float)fi * (13.287712379549449f / 16.0f));
        const float t2 = th * th;
        float cs = 1.f - t2 * (0.5f - t2 * (1.f / 24.f - t2 * (1.f / 720.f - t2 * (1.f / 40320.f - t2 * (1.f / 3628800.f)))));
        float sn = th * (1.f - t2 * (1.f / 6.f - t2 * (1.f / 120.f - t2 * (1.f / 5040.f - t2 * (1.f / 362880.f - t2 * (1.f / 39916800.f))))));
        float rc = 1.f, rs = 0.f;
#pragma unroll
        for (int bb = 0; bb < 7; ++bb) {
            if ((pos >> bb) & 1) { const float nc = rc * cs - rs * sn, ns = rc * sn + rs * cs; rc = nc; rs = ns; }
            const float c2 = cs * cs - sn * sn, s2 = 2.f * cs * sn; cs = c2; sn = s2;
        }
        p.rope[2 * i] = rc; p.rope[2 * i + 1] = rs;
    }
    __syncthreads();
    conv_small(cx, p, ldsc, 0, 960, cx.bid, cx.nb);
}
__device__ __forceinline__ void ph_pre0(const Ctx cx, PRef p) {
    const int col = cx.tid * 4;
    for (int i = cx.bid * NTHR + cx.tid; i < 2 * 3 * 6144; i += cx.nb * NTHR) {
        float v = p.ada_b[(i / (3 * 6144)) * 6144 + i % 6144];
#pragma unroll
        for (int ks = 0; ks < 16; ++ks) v += p.modp[(size_t)ks * 36864 + i];
        p.modv[i] = v;
    }
    float4 sh0, sh1, sh2, sc0, sc1, sc2;
#define PRE0_RED(S3, SH, SC) do { float4 a = *(const float4*)(p.ada_b + col), b = *(const float4*)(p.ada_b + 1024 + col); \
        _Pragma("unroll") for (int ks = 0; ks < 16; ++ks) { \
            const float4 pa = *(const float4*)(p.modp + (size_t)ks * 36864 + (S3) * 6144 + col), pb = *(const float4*)(p.modp + (size_t)ks * 36864 + (S3) * 6144 + 1024 + col); \
            a.x += pa.x; a.y += pa.y; a.z += pa.z; a.w += pa.w; b.x += pb.x; b.y += pb.y; b.z += pb.z; b.w += pb.w; } \
        SH = a; SC = b; } while (0)
    PRE0_RED(0, sh0, sc0); PRE0_RED(1, sh1, sc1); PRE0_RED(2, sh2, sc2);
#undef PRE0_RED
    for (int r0 = cx.bid * 4; r0 < ROWS; r0 += cx.nb * 4) {
        const int s = mod_of_row(r0);
        const int t0 = r0 < ROWS_LAT ? (r0 & (TLAT - 1)) : ((r0 - ROWS_LAT) & (LCTX - 1));
        const int len = r0 < ROWS_LAT ? TLAT : LCTX;
        const float4 sh = s == 0 ? sh0 : (s == 1 ? sh1 : sh2), sc = s == 0 ? sc0 : (s == 1 ? sc1 : sc2);
        const float* xr = xin_row(p, r0);
        float4 xv[6];
#pragma unroll
        for (int j = 0; j < 6; ++j) {
            const int t = t0 - 1 + j;
            xv[j] = make_float4(0.f, 0.f, 0.f, 0.f);
            if (t >= 0 && t < len) xv[j] = *(const float4*)(xr + (ptrdiff_t)(j - 1) * DM + col);
        }
        float4 mu[6];
#pragma unroll
        for (int m = 0; m < 6; ++m) mu[m] = *(const float4*)(p.rw_mu + m * 1024 + col);
        float hv[6][4];
#pragma unroll
        for (int j = 0; j < 6; ++j) {
            const int t = t0 - 1 + j; const bool in = (t >= 0 && t < len);
            hv[j][0] = in ? xv[j].x * (1.f + sc.x) + sh.x : 0.f; hv[j][1] = in ? xv[j].y * (1.f + sc.y) + sh.y : 0.f;
            hv[j][2] = in ? xv[j].z * (1.f + sc.z) + sh.z : 0.f; hv[j][3] = in ? xv[j].w * (1.f + sc.w) + sh.w : 0.f;
        }
#pragma unroll
        for (int rr = 0; rr < 4; ++rr) {
            float h[4], xx[4];
#pragma unroll
            for (int i = 0; i < 4; ++i) { h[i] = hv[rr + 1][i]; xx[i] = 0.5f * (hv[rr][i] + hv[rr + 2][i]) - h[i]; }
#pragma unroll
            for (int m = 0; m < 6; ++m) {
                uint2 o; o.x = pack2(h[0] + xx[0] * mu[m].x, h[1] + xx[1] * mu[m].y); o.y = pack2(h[2] + xx[2] * mu[m].z, h[3] + xx[3] * mu[m].w);
                *(uint2*)(p.XM + ((size_t)m * ROWS + r0 + rr) * DM + col) = o;
            }
        }
    }
}

struct EpiF32 {
    float* out; int ld, m0, n0;
    __device__ __forceinline__ void operator()(const f32x4 (&acc)[4][4], int wr, int wc, int fr, int fq) const {
#pragma unroll
        for (int i = 0; i < 4; ++i)
#pragma unroll
            for (int j = 0; j < 4; ++j) {
                const int row = m0 + wr * 64 + i * 16 + fr, col = n0 + wc * 64 + j * 16 + 4 * fq;
                *(f32x4*)(out + (size_t)row * ld + col) = acc[i][j];
            }
    }
};
struct EpiBf {
    bf16_t* out; int ld, m0, n0;
    __device__ __forceinline__ void operator()(const f32x4 (&acc)[4][4], int wr, int wc, int fr, int fq) const {
#pragma unroll
        for (int i = 0; i < 4; ++i)
#pragma unroll
            for (int j = 0; j < 4; ++j) {
                const int row = m0 + wr * 64 + i * 16 + fr, col = n0 + wc * 64 + j * 16 + 4 * fq;
                uint2 o; o.x = pack2(acc[i][j][0], acc[i][j][1]); o.y = pack2(acc[i][j][2], acc[i][j][3]);
                *(uint2*)(out + (size_t)row * ld + col) = o;
            }
    }
};
struct EpiK {
    bf16_t* out; float* kk; const float* k_k; int m0, n0;
    __device__ __forceinline__ void operator()(const f32x4 (&acc)[4][4], int wr, int wc, int fr, int fq) const {
        const int lane = fr + 16 * fq;
#pragma unroll
        for (int i = 0; i < 4; ++i) {
            const int row = m0 + wr * 64 + i * 16 + fr;
            f32x4 kv[4]; float ss = 0.f;
#pragma unroll
            for (int j = 0; j < 4; ++j) {
                const int col = n0 + wc * 64 + j * 16 + 4 * fq;
                const f32x4 kw = *(const f32x4*)(k_k + col);
                uint2 o; o.x = pack2(acc[i][j][0], acc[i][j][1]); o.y = pack2(acc[i][j][2], acc[i][j][3]);
                *(uint2*)(out + (size_t)row * DM + col) = o;
                kv[j][0] = bflo(o.x) * kw[0]; kv[j][1] = bfhi(o.x) * kw[1]; kv[j][2] = bflo(o.y) * kw[2]; kv[j][3] = bfhi(o.y) * kw[3];
                ss += (kv[j][0] * kv[j][0] + kv[j][1] * kv[j][1]) + (kv[j][2] * kv[j][2] + kv[j][3] * kv[j][3]);
            }
            ss += shx(ss, 16, lane); ss += shx(ss, 32, lane);
            const float inv = fminf(__builtin_amdgcn_rsqf(ss), 1e12f);
#pragma unroll
            for (int j = 0; j < 4; ++j) {
                const int col = n0 + wc * 64 + j * 16 + 4 * fq;
                *(f32x4*)(kk + (size_t)row * DM + col) = kv[j] * inv;
            }
        }
    }
};
struct EpiLH {
    bf16_t* out; int m0, coff, act;
    __device__ __forceinline__ void operator()(const f32x4 (&acc)[4][4], int wr, int wc, int fr, int fq) const {
#pragma unroll
        for (int i = 0; i < 4; ++i)
#pragma unroll
            for (int j = 0; j < 4; ++j) {
                const int row = m0 + wr * 64 + i * 16 + fr, col = wc * 64 + j * 16 + 4 * fq;
                float v[4];
#pragma unroll
                for (int r = 0; r < 4; ++r) { const float a = acc[i][j][r]; v[r] = act == 0 ? sigmoidf_(a) : (act == 1 ? (1.f - 2.f * __builtin_amdgcn_rcpf(1.f + __expf(2.f * a))) : a); }
                uint2 o; o.x = pack2(v[0], v[1]); o.y = pack2(v[2], v[3]);
                *(uint2*)(out + (size_t)row * 384 + coff + col) = o;
            }
    }
};
struct EpiG2 {
    bf16_t* outb; float* outf; const float* bias; int m0, n0, kind;
    __device__ __forceinline__ void operator()(const f32x4 (&acc)[4][4], int wr, int wc, int fr, int fq) const {
#pragma unroll
        for (int i = 0; i < 4; ++i)
#pragma unroll
            for (int j = 0; j < 4; ++j) {
                const int row = m0 + wr * 64 + i * 16 + fr, col = n0 + wc * 64 + j * 16 + 4 * fq;
                if (kind == 0) {
                    uint2 o; o.x = pack2(acc[i][j][0], acc[i][j][1]); o.y = pack2(acc[i][j][2], acc[i][j][3]);
                    *(uint2*)(outb + (size_t)row * DM + col) = o;
                } else if (kind == 2) {
                    const float4 b = *(const float4*)(bias + col);
                    uint2 o; o.x = pack2(sigmoidf_(b.x + acc[i][j][0]), sigmoidf_(b.y + acc[i][j][1])); o.y = pack2(sigmoidf_(b.z + acc[i][j][2]), sigmoidf_(b.w + acc[i][j][3]));
                    *(uint2*)(outb + (size_t)row * DM + col) = o;
                } else {
                    const float4 b = *(const float4*)(bias + col);
                    const float bv[4] = {b.x, b.y, b.z, b.w};
                    f32x4 o;
#pragma unroll
                    for (int r = 0; r < 4; ++r) {
                        const float s = sigmoidf_(bv[r] + acc[i][j][r]);
                        o[r] = kind == 1 ? __expf(-0.606531f * s) : s;
                    }
                    *(f32x4*)(outf + (size_t)row * DM + col) = o;
                }
            }
    }
};
struct EpiResid {
    float* out; const float* xl; const float* xc; const float* modl; int m0, n0;
    __device__ __forceinline__ void operator()(const f32x4 (&acc)[4][4], int wr, int wc, int fr, int fq) const {
#pragma unroll
        for (int i = 0; i < 4; ++i) {
            const int row = m0 + wr * 64 + i * 16 + fr;
            const float* xr = row < ROWS_LAT ? xl + (size_t)row * DM : xc + (size_t)(row - ROWS_LAT) * DM;
            const float* gt = modl + (size_t)mod_of_row(row) * 6144 + 2 * 1024;
#pragma unroll
            for (int j = 0; j < 4; ++j) {
                const int col = n0 + wc * 64 + j * 16 + 4 * fq;
                const f32x4 xv = *(const f32x4*)(xr + col), gv = *(const f32x4*)(gt + col);
                f32x4 o;
#pragma unroll
                for (int r = 0; r < 4; ++r) o[r] = ALPHA_F * xv[r] + gv[r] * acc[i][j][r];
                *(f32x4*)(out + (size_t)row * DM + col) = o;
            }
        }
    }
};
struct EpiSwiGLU {
    bf16_t* out; int m0, j0;
    __device__ __forceinline__ void operator()(const f32x4 (&acc)[4][4], int wr, int wc, int fr, int fq) const {
#pragma unroll
        for (int i = 0; i < 4; ++i) {
            const int row = m0 + wr * 64 + i * 16 + fr;
#pragma unroll
            for (int j = 0; j < 2; ++j) {
                const int col = j0 + wc * 32 + j * 16 + 4 * fq;
                float v[4];
#pragma unroll
                for (int r = 0; r < 4; ++r) { const float a = acc[i][j][r], u = acc[i][j + 2][r]; v[r] = a * sigmoidf_(a) * u; }
                uint2 o; o.x = pack2(v[0], v[1]); o.y = pack2(v[2], v[3]);
                *(uint2*)(out + (size_t)row * 2048 + col) = o;
            }
        }
    }
};
struct EpiDown {
    bf16_t* out; const float* gate; int m0, n0;
    __device__ __forceinline__ void operator()(const f32x4 (&acc)[4][4], int wr, int wc, int fr, int fq) const {
#pragma unroll
        for (int i = 0; i < 4; ++i) {
            const int row = m0 + wr * 64 + i * 16 + fr;
            const float g = gate[row];
#pragma unroll
            for (int j = 0; j < 4; ++j) {
                const int col = n0 + wc * 64 + j * 16 + 4 * fq;
                uint2 o; o.x = pack2(acc[i][j][0] * g, acc[i][j][1] * g); o.y = pack2(acc[i][j][2] * g, acc[i][j][3] * g);
                *(uint2*)(out + (size_t)row * DM + col) = o;
            }
        }
    }
};
struct EpiQKV {
    PPtr p; int m0, n0;
    __device__ __forceinline__ void operator()(const f32x4 (&acc)[4][4], int wr, int wc, int fr, int fq) const {
        const int hs = (n0 + wc * 64) >> 6;
#pragma unroll
        for (int i = 0; i < 4; ++i) {
            const int row = m0 + wr * 64 + i * 16 + fr;
            const bool lat = row < ROWS_LAT;
            if (hs < 20) {
                f32x4 v0 = acc[i][0], v1 = acc[i][1], v2 = acc[i][2], v3 = acc[i][3];
                if (lat) {
                    const int t = row & (TLAT - 1), rp = t >> 6, cp = t & 63;
#pragma unroll
                    for (int r = 0; r < 4; ++r) {
                        const int fi = 4 * fq + r;
                        const float2 cr = *(const float2*)(p->rope + 2 * (rp * 16 + fi)), cc = *(const float2*)(p->rope + 2 * (cp * 16 + fi));
                        const float a = v0[r], b = v1[r]; v0[r] = a * cr.x - b * cr.y; v1[r] = b * cr.x + a * cr.y;
                        const float c2 = v2[r], d2 = v3[r]; v2[r] = c2 * cc.x - d2 * cc.y; v3[r] = d2 * cc.x + c2 * cc.y;
                    }
                }
                if (hs < 16) {
                    if (lat) {
                        bf16_t* q = p->Q + (size_t)row * DM + hs * 64 + 4 * fq;
                        uint2 o;
                        o.x = pack2(v0[0] * 0.125f, v0[1] * 0.125f); o.y = pack2(v0[2] * 0.125f, v0[3] * 0.125f); *(uint2*)(q) = o;
                        o.x = pack2(v1[0] * 0.125f, v1[1] * 0.125f); o.y = pack2(v1[2] * 0.125f, v1[3] * 0.125f); *(uint2*)(q + 16) = o;
                        o.x = pack2(v2[0] * 0.125f, v2[1] * 0.125f); o.y = pack2(v2[2] * 0.125f, v2[3] * 0.125f); *(uint2*)(q + 32) = o;
                        o.x = pack2(v3[0] * 0.125f, v3[1] * 0.125f); o.y = pack2(v3[2] * 0.125f, v3[3] * 0.125f); *(uint2*)(q + 48) = o;
                    }
                } else {
                    bf16_t* k = p->KA + (size_t)row * 256 + (hs - 16) * 64 + 4 * fq;
                    uint2 o;
                    o.x = pack2(v0[0], v0[1]); o.y = pack2(v0[2], v0[3]); *(uint2*)(k) = o;
                    o.x = pack2(v1[0], v1[1]); o.y = pack2(v1[2], v1[3]); *(uint2*)(k + 16) = o;
                    o.x = pack2(v2[0], v2[1]); o.y = pack2(v2[2], v2[3]); *(uint2*)(k + 32) = o;
                    o.x = pack2(v3[0], v3[1]); o.y = pack2(v3[2], v3[3]); *(uint2*)(k + 48) = o;
                }
            } else {
                const int hk = hs - 20;
                bf16_t* vt; int ldt, t;
                if (lat) { const int b = row >> 13; t = row & (TLAT - 1); vt = p->VTL + (size_t)(b * 4 + hk) * 64 * TLAT; ldt = TLAT; }
                else { const int rr = row - ROWS_LAT, b = rr >> 8; t = rr & (LCTX - 1); vt = p->VTC + (size_t)(b * 4 + hk) * 64 * LCTX; ldt = LCTX; }
#pragma unroll
                for (int j = 0; j < 4; ++j)
#pragma unroll
                    for (int r = 0; r < 4; ++r) vt[(size_t)(j * 16 + 4 * fq + r) * ldt + t] = f2bf(acc[i][j][r]);
            }
        }
    }
};

__device__ __forceinline__ void ph_g1(const Ctx cx, PRef p, char* lds) {
    for (int tile = cx.bid; tile < 96 + 396; tile += cx.nb) {
        int mt, nt;
        if (tile < 96) { mt = 128 + tile / 24; nt = tile % 24; } else { const int t2 = tile - 96; mt = t2 / 3; nt = 24 + t2 % 3; }
        const int m0 = mt * 128;
        int msel, n0; const bf16_t* Bt;
        if (nt < 24) { const int gsel = nt >> 3; n0 = (nt & 7) * 128; msel = gsel == 0 ? 0 : (gsel == 1 ? 2 : 3); Bt = (gsel == 0 ? p.wrT : (gsel == 1 ? p.wkT : p.wvT)) + (size_t)n0 * 1024; }
        else { const int q = nt - 24; n0 = 0; msel = q == 0 ? 5 : (q == 1 ? 1 : 4); Bt = p.l1T + (size_t)q * 128 * 1024; }
        const bf16_t* A = p.XM + ((size_t)msel * ROWS + m0) * DM + G3_CH8;
        const bf16_t* B = Bt + G3_CH8;
        if (nt < 24) {
            const int gsel = nt >> 3;
            if (gsel == 1) {
                EpiK epi; epi.out = p.K; epi.kk = p.KK; epi.k_k = p.rw_kk; epi.m0 = m0; epi.n0 = n0;
                gemm3_tile(cx, A + (size_t)G3_ROW(0) * DM, A + (size_t)G3_ROW(1) * DM,
                           B + (size_t)G3_ROW(0) * 1024, B + (size_t)G3_ROW(1) * 1024, 1024, epi, lds);
            } else {
                EpiBf epi; epi.out = gsel == 0 ? p.R : p.V; epi.ld = DM; epi.m0 = m0; epi.n0 = n0;
                gemm3_tile(cx, A + (size_t)G3_ROW(0) * DM, A + (size_t)G3_ROW(1) * DM,
                           B + (size_t)G3_ROW(0) * 1024, B + (size_t)G3_ROW(1) * 1024, 1024, epi, lds);
            }
        } else {
            const int q = nt - 24;
            EpiLH epi; epi.out = p.LH; epi.m0 = m0; epi.coff = q * 128; epi.act = q;
            gemm3_tile(cx, A + (size_t)G3_ROW(0) * DM, A + (size_t)G3_ROW(1) * DM,
                       B + (size_t)G3_ROW(0) * 1024, B + (size_t)G3_ROW(1) * 1024, 1024, epi, lds);
        }
    }
}
__device__ __forceinline__ void ph_g2(const Ctx cx, PRef p, char* lds) {
#define G2_DESC(tile_, A_, B_, K_, epi_) \
        const int mt_##A_ = (tile_) / 40, rem_##A_ = (tile_) % 40, gsel_##A_ = rem_##A_ >> 3, n0_##A_ = (rem_##A_ & 7) * 128, m0_##A_ = mt_##A_ * 128; \
        const bf16_t* A_; const bf16_t* B_; int K_; EpiG2 epi_; epi_.m0 = m0_##A_; epi_.n0 = n0_##A_; epi_.outb = nullptr; epi_.outf = nullptr; epi_.bias = nullptr; \
        if (gsel_##A_ == 0) { A_ = p.LH; B_ = p.g2T + (size_t)n0_##A_ * 128; K_ = 128; epi_.kind = 0; epi_.outb = p.G; } \
        else if (gsel_##A_ <= 2) { const int d = gsel_##A_ - 1; A_ = p.LH + 128 + 64 * d; B_ = p.w2T + (size_t)d * 65536 + (size_t)n0_##A_ * 64; K_ = 64; epi_.kind = 1; epi_.outf = d ? p.W1 : p.W0; epi_.bias = p.rw_w0 + d * 1024; } \
        else { const int d = gsel_##A_ - 3; A_ = p.LH + 256 + 64 * d; B_ = p.a2T + (size_t)d * 65536 + (size_t)n0_##A_ * 64; K_ = 64; epi_.kind = 2; epi_.outb = d ? p.AD1 : p.AD0; epi_.bias = p.rw_a0 + d * 1024; } \
        A_ += (size_t)m0_##A_ * 384 + G3_CH8; B_ += G3_CH8
    bool pre = false;
    for (int tile = cx.bid; tile < 132 * 40; tile += cx.nb) {
        G2_DESC(tile, A, B, K, epi);
        const int tn = tile + cx.nb; const bool hn = tn < 132 * 40;
        G2_DESC(hn ? tn : tile, An, Bn, Kn, epin); (void)epin;
        G3Next nx; nx.has = hn; nx.a0 = An + (size_t)G3_ROW(0) * 384; nx.a1 = An + (size_t)G3_ROW(1) * 384; nx.b0 = Bn + (size_t)G3_ROW(0) * Kn; nx.b1 = Bn + (size_t)G3_ROW(1) * Kn; nx.K = Kn;
        gemm3_tile(cx, A + (size_t)G3_ROW(0) * 384, A + (size_t)G3_ROW(1) * 384,
                   B + (size_t)G3_ROW(0) * K, B + (size_t)G3_ROW(1) * K, K, epi, lds, pre, nx);
        pre = hn;
    }
#undef G2_DESC
}
__device__ __forceinline__ void ph_prep(const Ctx cx, PRef p) { (void)cx; (void)p; }
#define NCHUNK 132
#define CH_ROW 72
#define L_AT 0
#define L_BT 9216
#define L_KT 18432
#define L_RT 27648
#define L_BH 36864
#define L_KH 46080
#define L_VT 55296
#define L_AAB 64512
#define L_PC 80896
#define L_X2 L_AT
#define L_UT L_KT
#define L_WT L_KH
#define S1_LDS_BYTES (80896 + 256)
__device__ __forceinline__ void chunk_rows(int b, int dir, int n, int& rbase, int& sgn) {
    sgn = dir ? -1 : 1;
    if (n < 4) { const int t0 = 64 * n; rbase = ROWS_LAT + b * LCTX + (dir ? (LCTX - 1 - t0) : t0); }
    else { const int t0 = 64 * (n - 4); rbase = b * TLAT + (dir ? (TLAT - 1 - t0) : t0); }
}
__device__ __forceinline__ bf16x8 pack8(const f32x4& a, const f32x4& b) {
    uint4 u; u.x = pack2(a[0], a[1]); u.y = pack2(a[2], a[3]); u.z = pack2(b[0], b[1]); u.w = pack2(b[2], b[3]);
    return *(bf16x8*)&u;
}
__device__ __forceinline__ void mm64(f32x4 (&acc)[4][4], const bf16_t* X, const bf16_t* Y, int l15, int g) {
    bf16x8 yf[4][2];
#pragma unroll
    for (int yt = 0; yt < 4; ++yt) { yf[yt][0] = *(const bf16x8*)(Y + (16 * yt + l15) * CH_ROW + 8 * g); yf[yt][1] = *(const bf16x8*)(Y + (16 * yt + l15) * CH_ROW + 32 + 8 * g); }
#pragma unroll
    for (int xt = 0; xt < 4; ++xt) {
        const bf16x8 x0 = *(const bf16x8*)(X + (16 * xt + l15) * CH_ROW + 8 * g), x1 = *(const bf16x8*)(X + (16 * xt + l15) * CH_ROW + 32 + 8 * g);
#pragma unroll
        for (int yt = 0; yt < 4; ++yt) {
            acc[xt][yt] = __builtin_amdgcn_mfma_f32_16x16x32_bf16(x0, yf[yt][0], acc[xt][yt], 0, 0, 0);
            acc[xt][yt] = __builtin_amdgcn_mfma_f32_16x16x32_bf16(x1, yf[yt][1], acc[xt][yt], 0, 0, 0);
        }
    }
}
__device__ __forceinline__ void mm64_accB(f32x4 (&out)[4][4], const bf16_t* X, const f32x4 (&acc)[4][4], int l15, int g) {
#pragma unroll
    for (int js = 0; js < 2; ++js) {
        bf16x8 bfr[4];
#pragma unroll
        for (int tt = 0; tt < 4; ++tt) bfr[tt] = pack8(acc[2 * js][tt], acc[2 * js + 1][tt]);
#pragma unroll
        for (int xt = 0; xt < 4; ++xt) {
            const bf16_t* xp = X + (16 * xt + l15) * CH_ROW + 32 * js + 4 * g;
            const uint2 lo = *(const uint2*)xp, hi = *(const uint2*)(xp + 16);
            uint4 u; u.x = lo.x; u.y = lo.y; u.z = hi.x; u.w = hi.y;
            const bf16x8 af = *(bf16x8*)&u;
#pragma unroll
            for (int tt = 0; tt < 4; ++tt) out[xt][tt] = __builtin_amdgcn_mfma_f32_16x16x32_bf16(af, bfr[tt], out[xt][tt], 0, 0, 0);
        }
    }
}
__device__ __forceinline__ void zero44(f32x4 (&a)[4][4]) {
#pragma unroll
    for (int i = 0; i < 4; ++i)
#pragma unroll
        for (int j = 0; j < 4; ++j) a[i][j] = (f32x4){0.f, 0.f, 0.f, 0.f};
}
__device__ __forceinline__ void mask44(f32x4 (&a)[4][4], int l15, int g, bool strict) {
#pragma unroll
    for (int jt = 0; jt < 4; ++jt)
#pragma unroll
        for (int tt = 0; tt < 4; ++tt)
#pragma unroll
            for (int r = 0; r < 4; ++r) {
                const int j = 16 * jt + 4 * g + r, t = 16 * tt + l15;
                const bool keep = strict ? (j < t) : (j <= t);
                a[jt][tt][r] = keep ? a[jt][tt][r] : 0.f;
            }
}
__host__ __device__ constexpr int fsub_qp(int J) { return J < 24 ? 10 : 16; }
template <int J> __device__ __forceinline__ void fsub_col(float (&z)[64], const float* AabT, const float4 (&cur)[16]) {
    float4 nxt[16];
    if constexpr (J < 62) {
#pragma unroll
        for (int q = (J + 2) / 4; q < fsub_qp(J); ++q) nxt[q] = *(const float4*)(AabT + (J + 1) * 64 + 4 * q);
    }
    const float zj = z[J];
    constexpr int QV = J == 0 ? 16 : fsub_qp(J - 1);
#pragma unroll
    for (int q = (J + 1) / 4; q < 16; ++q) {
        const float4 c4 = q < QV ? cur[q] : *(const float4*)(AabT + J * 64 + 4 * q);
        if (4 * q + 0 > J) z[4 * q + 0] += c4.x * zj;
        if (4 * q + 1 > J) z[4 * q + 1] += c4.y * zj;
        if (4 * q + 2 > J) z[4 * q + 2] += c4.z * zj;
        if (4 * q + 3 > J) z[4 * q + 3] += c4.w * zj;
    }
#define ZPIN16(a) asm volatile("" : "+v"(z[a]), "+v"(z[a+1]), "+v"(z[a+2]), "+v"(z[a+3]), "+v"(z[a+4]), "+v"(z[a+5]), "+v"(z[a+6]), "+v"(z[a+7]), \
                                    "+v"(z[a+8]), "+v"(z[a+9]), "+v"(z[a+10]), "+v"(z[a+11]), "+v"(z[a+12]), "+v"(z[a+13]), "+v"(z[a+14]), "+v"(z[a+15]) :: "memory")
    if constexpr (J < 15) ZPIN16(0);
    if constexpr (J < 31) ZPIN16(16);
    if constexpr (J < 47) ZPIN16(32);
    ZPIN16(48);
#undef ZPIN16
    if constexpr (J < 62) fsub_col<J + 1>(z, AabT, nxt);
}
__device__ __forceinline__ void s1_diag_inverse(const bf16_t* Abf, bf16_t* TD, int lane) {
    const int bi = lane >> 4, c = lane & 15;
    float z[16];
#pragma unroll
    for (int t = 0; t < 16; ++t) {
        const uint4 u0 = *(const uint4*)(Abf + (16 * bi + t) * CH_ROW + 16 * bi), u1 = *(const uint4*)(Abf + (16 * bi + t) * CH_ROW + 16 * bi + 8);
        const unsigned uw[8] = {u0.x, u0.y, u0.z, u0.w, u1.x, u1.y, u1.z, u1.w};
        float acc_ = (t == c) ? 1.f : 0.f;
#pragma unroll
        for (int j = 0; j < t; ++j) acc_ += ((j & 1) ? bfhi(uw[j >> 1]) : bflo(uw[j >> 1])) * z[j];
        z[t] = acc_;
        TD[(16 * bi + t) * 24 + c] = f2bf(acc_);
    }
}
__device__ __forceinline__ void s1_load_slab(f32x4 (&Rs)[4][2], const bf16_t* X, int cb, int l15, int g) {
#pragma unroll
    for (int i = 0; i < 4; ++i)
#pragma unroll
        for (int ct = 0; ct < 2; ++ct)
#pragma unroll
            for (int r = 0; r < 4; ++r) Rs[i][ct][r] = bflo((unsigned)X[(16 * i + 4 * g + r) * CH_ROW + cb + 16 * ct + l15]);
}
__device__ __forceinline__ void s1_x2_slab(f32x4 (&Rs)[4][2], const bf16_t* Kbf, const bf16_t* VT, int vb, int l15, int g) {
#pragma unroll
    for (int i = 0; i < 4; ++i) { Rs[i][0] = (f32x4){0.f, 0.f, 0.f, 0.f}; Rs[i][1] = (f32x4){0.f, 0.f, 0.f, 0.f}; }
#pragma unroll
    for (int ks = 0; ks < 2; ++ks) {
        const bf16x8 v0 = *(const bf16x8*)(VT + (vb + l15) * CH_ROW + 32 * ks + 8 * g), v1 = *(const bf16x8*)(VT + (vb + 16 + l15) * CH_ROW + 32 * ks + 8 * g);
#pragma unroll
        for (int i = 0; i < 4; ++i) {
            const bf16x8 kf = *(const bf16x8*)(Kbf + (16 * i + l15) * CH_ROW + 32 * ks + 8 * g);
            Rs[i][0] = __builtin_amdgcn_mfma_f32_16x16x32_bf16(kf, v0, Rs[i][0], 0, 0, 0);
            Rs[i][1] = __builtin_amdgcn_mfma_f32_16x16x32_bf16(kf, v1, Rs[i][1], 0, 0, 0);
        }
    }
}
__device__ __forceinline__ void s1_slab_solve(f32x4 (&Rs)[4][2], const bf16_t* Abf, const bf16_t* TD, bf16_t* XT, int l15, int g) {
#pragma unroll
    for (int i = 0; i < 4; ++i) {
        f32x4 X0 = Rs[i][0], X1 = Rs[i][1];
#pragma unroll
        for (int j = 0; j < i; ++j) {
            const uint2 av = *(const uint2*)(Abf + (16 * i + l15) * CH_ROW + 16 * j + 4 * g);
            uint4 ua; ua.x = av.x; ua.y = av.y; ua.z = 0u; ua.w = 0u;
            uint4 ub0, ub1; ub0.x = pack2(Rs[j][0][0], Rs[j][0][1]); ub0.y = pack2(Rs[j][0][2], Rs[j][0][3]); ub0.z = 0u; ub0.w = 0u;
            ub1.x = pack2(Rs[j][1][0], Rs[j][1][1]); ub1.y = pack2(Rs[j][1][2], Rs[j][1][3]); ub1.z = 0u; ub1.w = 0u;
            X0 = __builtin_amdgcn_mfma_f32_16x16x32_bf16(*(bf16x8*)&ua, *(bf16x8*)&ub0, X0, 0, 0, 0);
            X1 = __builtin_amdgcn_mfma_f32_16x16x32_bf16(*(bf16x8*)&ua, *(bf16x8*)&ub1, X1, 0, 0, 0);
        }
        const uint2 tv = *(const uint2*)(TD + (16 * i + l15) * 24 + 4 * g);
        uint4 ut; ut.x = tv.x; ut.y = tv.y; ut.z = 0u; ut.w = 0u;
        uint4 ux0, ux1; ux0.x = pack2(X0[0], X0[1]); ux0.y = pack2(X0[2], X0[3]); ux0.z = 0u; ux0.w = 0u;
        ux1.x = pack2(X1[0], X1[1]); ux1.y = pack2(X1[2], X1[3]); ux1.z = 0u; ux1.w = 0u;
        const f32x4 zz = (f32x4){0.f, 0.f, 0.f, 0.f};
        Rs[i][0] = __builtin_amdgcn_mfma_f32_16x16x32_bf16(*(bf16x8*)&ut, *(bf16x8*)&ux0, zz, 0, 0, 0);
        Rs[i][1] = __builtin_amdgcn_mfma_f32_16x16x32_bf16(*(bf16x8*)&ut, *(bf16x8*)&ux1, zz, 0, 0, 0);
    }
#pragma unroll
    for (int i = 0; i < 4; ++i)
#pragma unroll
        for (int ct = 0; ct < 2; ++ct) { uint2 o; o.x = pack2(Rs[i][ct][0], Rs[i][ct][1]); o.y = pack2(Rs[i][ct][2], Rs[i][ct][3]); *(uint2*)(XT + (16 * ct + l15) * CH_ROW + 16 * i + 4 * g) = o; }
}
__device__ __forceinline__ void ph_s1(const Ctx cx, PRef p, char* lds) {
    const int wave = (__builtin_amdgcn_readfirstlane(cx.tid >> 6) + 2 * (cx.bid & 1)) & 3;
    for (int pairi = cx.bid >> 1; pairi < 32 * NCHUNK; pairi += cx.nb >> 1) {
        int lz = 0; asm volatile("" : "+v"(lz));
        char* ldsb = lds + lz;
        bf16_t* At = (bf16_t*)(ldsb + L_AT); bf16_t* Bt = (bf16_t*)(ldsb + L_BT); bf16_t* Kt = (bf16_t*)(ldsb + L_KT); bf16_t* Rt = (bf16_t*)(ldsb + L_RT);
        bf16_t* BhT = (bf16_t*)(ldsb + L_BH); bf16_t* KhT = (bf16_t*)(ldsb + L_KH); bf16_t* VT = (bf16_t*)(ldsb + L_VT);
        float* Aab = (float*)(ldsb + L_AAB); float* pcl = (float*)(ldsb + L_PC); float* X2 = (float*)(ldsb + L_X2);
        bf16_t* UT = (bf16_t*)(ldsb + L_UT); bf16_t* WT = (bf16_t*)(ldsb + L_WT);
        int tid = cx.tid; asm volatile("" : "+v"(tid));
        const int lane = tid & 63, l15 = lane & 15, g = lane >> 4;
        const int bh_ = pairi / NCHUNK, cc_ = pairi % NCHUNK, dir = cx.bid & 1;
        const int chain = bh_ * 2 + dir, n = dir ? (cc_ < 4 ? 3 - cc_ : 135 - cc_) : cc_, task = chain * NCHUNK + n;
        const int h = (chain >> 1) & 15, b = chain >> 5;
        int rbase, sgn; chunk_rows(b, dir, n, rbase, sgn);
        const float* Wd = dir ? p.W1 : p.W0; const bf16_t* ADd = dir ? p.AD1 : p.AD0;
        {
            const int kq = lane & 15, gq = lane >> 4;
            f32x4 wv[4], kkv[4]; uint2 adv[4], kvv[4], rvv[4], vvv[4];
#pragma unroll
            for (int i = 0; i < 4; ++i) {
                const size_t off = (size_t)(rbase + sgn * (16 * wave + 4 * gq + i)) * DM + h * 64 + 4 * kq;
                wv[i] = *(const f32x4*)(Wd + off); kkv[i] = *(const f32x4*)(p.KK + off);
                adv[i] = *(const uint2*)(ADd + off); kvv[i] = *(const uint2*)(p.K + off); rvv[i] = *(const uint2*)(p.R + off); vvv[i] = *(const uint2*)(p.V + off);
            }
            f32x4 lp[4];
            lp[0] = wv[0]; lp[1] = lp[0] * wv[1]; lp[2] = lp[1] * wv[2]; lp[3] = lp[2] * wv[3];
            f32x4 eg = (f32x4){1.f, 1.f, 1.f, 1.f}, wt = (f32x4){1.f, 1.f, 1.f, 1.f};
#pragma unroll
            for (int g2 = 0; g2 < 4; ++g2)
#pragma unroll
                for (int c = 0; c < 4; ++c) {
                    const float tv = __int_as_float(shidx(__float_as_int(lp[3][c]), kq + 16 * g2));
                    eg[c] = (g2 < gq) ? eg[c] * tv : eg[c]; wt[c] *= tv;
                }
            if (gq == 0) *(f32x4*)(Aab + wave * 64 + 4 * kq) = wt;
            __syncthreads();
            f32x4 prefix = eg, pC = (f32x4){1.f, 1.f, 1.f, 1.f};
#pragma unroll
            for (int w2 = 0; w2 < 4; ++w2) { const f32x4 tv = *(const f32x4*)(Aab + w2 * 64 + 4 * kq); if (w2 < wave) prefix = prefix * tv; pC = pC * tv; }
            if (wave == 0 && gq == 0) *(f32x4*)(pcl + 4 * kq) = pC;
            const f32x4 ka = *(const f32x4*)(p.rw_ka + h * 64 + 4 * kq);
            float bh[4][4], kh[4][4];
#pragma unroll
            for (int i = 0; i < 4; ++i) {
                const int t = 16 * wave + 4 * gq + i;
                const float adf[4] = {bflo(adv[i].x), bfhi(adv[i].x), bflo(adv[i].y), bfhi(adv[i].y)};
                const float kvf[4] = {bflo(kvv[i].x), bfhi(kvv[i].x), bflo(kvv[i].y), bfhi(kvv[i].y)};
                const float rvf[4] = {bflo(rvv[i].x), bfhi(rvv[i].x), bflo(rvv[i].y), bfhi(rvv[i].y)};
                float at[4], bt[4], kt[4], rt[4];
#pragma unroll
                for (int c = 0; c < 4; ++c) {
                    const float pt = prefix[c] * lp[i][c], pprev = i ? prefix[c] * lp[i ? i - 1 : 0][c] : prefix[c];
                    const float ip = __builtin_amdgcn_rcpf(pt);
                    at[c] = -kkv[i][c] * pprev; bt[c] = kkv[i][c] * adf[c] * ip; kt[c] = kvf[c] * (1.f + (adf[c] - 1.f) * ka[c]) * ip; rt[c] = rvf[c] * pt;
                    bh[i][c] = bt[c] * pC[c]; kh[i][c] = kt[c] * pC[c];
                }
                uint2 o;
                o.x = pack2(at[0], at[1]); o.y = pack2(at[2], at[3]); *(uint2*)(At + t * CH_ROW + 4 * kq) = o;
                o.x = pack2(bt[0], bt[1]); o.y = pack2(bt[2], bt[3]); *(uint2*)(Bt + t * CH_ROW + 4 * kq) = o;
                o.x = pack2(kt[0], kt[1]); o.y = pack2(kt[2], kt[3]); *(uint2*)(Kt + t * CH_ROW + 4 * kq) = o;
                o.x = pack2(rt[0], rt[1]); o.y = pack2(rt[2], rt[3]); *(uint2*)(Rt + t * CH_ROW + 4 * kq) = o;
            }
#pragma unroll
            for (int c = 0; c < 4; ++c) {
                const int col = 16 * wave + 4 * gq;
                uint2 o;
                o.x = pack2(bh[0][c], bh[1][c]); o.y = pack2(bh[2][c], bh[3][c]); *(uint2*)(BhT + (4 * kq + c) * CH_ROW + col) = o;
                o.x = pack2(kh[0][c], kh[1][c]); o.y = pack2(kh[2][c], kh[3][c]); *(uint2*)(KhT + (4 * kq + c) * CH_ROW + col) = o;
                const unsigned v0 = (c & 1) ? (((c >> 1) ? vvv[0].y : vvv[0].x) >> 16) : (((c >> 1) ? vvv[0].y : vvv[0].x) & 0xffffu);
                const unsigned v1 = (c & 1) ? (((c >> 1) ? vvv[1].y : vvv[1].x) >> 16) : (((c >> 1) ? vvv[1].y : vvv[1].x) & 0xffffu);
                const unsigned v2 = (c & 1) ? (((c >> 1) ? vvv[2].y : vvv[2].x) >> 16) : (((c >> 1) ? vvv[2].y : vvv[2].x) & 0xffffu);
                const unsigned v3 = (c & 1) ? (((c >> 1) ? vvv[3].y : vvv[3].x) >> 16) : (((c >> 1) ? vvv[3].y : vvv[3].x) & 0xffffu);
                o.x = v0 | (v1 << 16); o.y = v2 | (v3 << 16); *(uint2*)(VT + (4 * kq + c) * CH_ROW + col) = o;
            }
        }
        __syncthreads();
        const size_t tb = (size_t)task * 4096;
        bf16_t* Abf = (bf16_t*)(ldsb + L_AAB);
        bf16_t* TD = (bf16_t*)(ldsb + L_AAB + 9216);
        bf16_t* Kbf = Bt;
        if (wave == 0) {
            f32x4 Rs[4][2];
            {
                f32x4 accP[4][4]; zero44(accP);
                mm64(accP, Bt, At, l15, g); mask44(accP, l15, g, true);
#pragma unroll
                for (int xt = 0; xt < 4; ++xt)
#pragma unroll
                    for (int yt = 0; yt < 4; ++yt) { uint2 o; o.x = pack2(accP[xt][yt][0], accP[xt][yt][1]); o.y = pack2(accP[xt][yt][2], accP[xt][yt][3]); *(uint2*)(Abf + (16 * yt + l15) * CH_ROW + 16 * xt + 4 * g) = o; }
            }
            s1_diag_inverse(Abf, TD, lane);
            __syncthreads();
            s1_load_slab(Rs, At, 0, l15, g);
            __syncthreads();
            s1_slab_solve(Rs, Abf, TD, WT, l15, g);
            __syncthreads();
            {
                f32x4 accM[4][4]; zero44(accM);
                mm64(accM, WT, BhT, l15, g);
#pragma unroll
                for (int kpt = 0; kpt < 4; ++kpt)
#pragma unroll
                    for (int kt = 0; kt < 4; ++kt) {
                        const int k = 16 * kt + l15;
                        const float pc = pcl[k];
                        float v[4];
#pragma unroll
                        for (int r = 0; r < 4; ++r) v[r] = accM[kpt][kt][r] + ((16 * kpt + 4 * g + r) == k ? pc : 0.f);
                        uint2 o; o.x = pack2(v[0], v[1]); o.y = pack2(v[2], v[3]);
                        *(uint2*)(p.CM + tb + k * 64 + 32 * (kpt >> 1) + 8 * g + 4 * (kpt & 1)) = o;
                    }
            }
            __syncthreads();
        } else if (wave == 1) {
            f32x4 Rs[4][2];
            {
                f32x4 accA[4][4]; zero44(accA);
                mm64(accA, Kt, At, l15, g); mask44(accA, l15, g, true);
                __syncthreads();
#pragma unroll
                for (int xt = 0; xt < 4; ++xt)
#pragma unroll
                    for (int yt = 0; yt < 4; ++yt) { uint2 o; o.x = pack2(accA[xt][yt][0], accA[xt][yt][1]); o.y = pack2(accA[xt][yt][2], accA[xt][yt][3]); *(uint2*)(Kbf + (16 * yt + l15) * CH_ROW + 16 * xt + 4 * g) = o; }
            }
            s1_load_slab(Rs, At, 32, l15, g);
            __syncthreads();
            s1_slab_solve(Rs, Abf, TD, WT + 32 * CH_ROW, l15, g);
            __syncthreads();
            __syncthreads();
        } else if (wave == 2) {
            f32x4 accP[4][4], accQ[4][4];
            zero44(accP); zero44(accQ);
            mm64(accP, Kt, Rt, l15, g); mask44(accP, l15, g, false);
            mm64_accB(accQ, VT, accP, l15, g);
            zero44(accP);
            mm64(accP, Bt, Rt, l15, g); mask44(accP, l15, g, false);
            __syncthreads();
            __syncthreads();
            {
                f32x4 Rs[4][2];
                s1_x2_slab(Rs, Kbf, VT, 0, l15, g);
                s1_slab_solve(Rs, Abf, TD, UT, l15, g);
            }
            __syncthreads();
            mm64_accB(accQ, UT, accP, l15, g);
#pragma unroll
            for (int vt = 0; vt < 4; ++vt)
#pragma unroll
                for (int tt = 0; tt < 4; ++tt) {
                    uint2 o; o.x = pack2(accQ[vt][tt][0], accQ[vt][tt][1]); o.y = pack2(accQ[vt][tt][2], accQ[vt][tt][3]);
                    *(uint2*)(p.CY + tb + (16 * tt + l15) * 64 + 16 * vt + 4 * g) = o;
                }
            zero44(accQ);
            mm64_accB(accQ, WT, accP, l15, g);
#pragma unroll
            for (int kt = 0; kt < 4; ++kt)
#pragma unroll
                for (int tt = 0; tt < 4; ++tt) {
                    const uint2 rr = *(const uint2*)(Rt + (16 * tt + l15) * CH_ROW + 16 * kt + 4 * g);
                    uint2 o; o.x = pack2(accQ[kt][tt][0] + bflo(rr.x), accQ[kt][tt][1] + bfhi(rr.x)); o.y = pack2(accQ[kt][tt][2] + bflo(rr.y), accQ[kt][tt][3] + bfhi(rr.y));
                    *(uint2*)(p.CR + tb + (16 * tt + l15) * 64 + 16 * kt + 4 * g) = o;
                }
            __syncthreads();
        } else {
            f32x4 accP[4][4];
            zero44(accP);
            mm64(accP, KhT, VT, l15, g);
            __syncthreads();
            __syncthreads();
            {
                f32x4 Rs[4][2];
                s1_x2_slab(Rs, Kbf, VT, 32, l15, g);
                s1_slab_solve(Rs, Abf, TD, UT + 32 * CH_ROW, l15, g);
            }
            __syncthreads();
            mm64(accP, BhT, UT, l15, g);
#pragma unroll
            for (int kt = 0; kt < 4; ++kt)
#pragma unroll
                for (int vt = 0; vt < 4; ++vt) {
                    uint2 o; o.x = pack2(accP[kt][vt][0], accP[kt][vt][1]); o.y = pack2(accP[kt][vt][2], accP[kt][vt][3]);
                    *(uint2*)(p.CN + tb + (16 * vt + l15) * 64 + 16 * kt + 4 * g) = o;
                }
            __syncthreads();
        }
    }
}
#define S2_PF 4
__device__ __forceinline__ void s2_body(const Ctx cx, PRef p) {
    const int lane = cx.tid & 63, l15 = lane & 15, g = lane >> 4;
    const int item = cx.bid, chain = item >> 2, vs = (item & 3) * 16;
    const bf16_t* Mb = p.CM + (size_t)chain * NCHUNK * 4096;
    const bf16_t* Nb = p.CN + (size_t)chain * NCHUNK * 4096 + (vs + l15) * 64 + 4 * g;
    bf16_t* Sb = p.CS + (size_t)chain * NCHUNK * 4096 + (vs + l15) * 64 + 4 * g;
    f32x4 sacc[4];
#pragma unroll
    for (int kt = 0; kt < 4; ++kt) sacc[kt] = (f32x4){0.f, 0.f, 0.f, 0.f};
    uint4 mreg[S2_PF][8]; uint2 nreg[S2_PF][4];
    auto ldstep = [&](int slot, int n) {
#pragma unroll
        for (int kt = 0; kt < 4; ++kt) {
            mreg[slot][2 * kt] = *(const uint4*)(Mb + (size_t)n * 4096 + (16 * kt + l15) * 64 + 8 * g);
            mreg[slot][2 * kt + 1] = *(const uint4*)(Mb + (size_t)n * 4096 + (16 * kt + l15) * 64 + 32 + 8 * g);
            nreg[slot][kt] = *(const uint2*)(Nb + (size_t)n * 4096 + 16 * kt);
        }
    };
#pragma unroll
    for (int s2 = 0; s2 < S2_PF; ++s2) ldstep(s2, s2);
    for (int n0 = 0; n0 < NCHUNK; n0 += S2_PF) {
#pragma unroll
        for (int s2 = 0; s2 < S2_PF; ++s2) {
            const int n = n0 + s2;
#pragma unroll
            for (int kt = 0; kt < 4; ++kt) { uint2 o; o.x = pack2(sacc[kt][0], sacc[kt][1]); o.y = pack2(sacc[kt][2], sacc[kt][3]); *(uint2*)(Sb + (size_t)n * 4096 + 16 * kt) = o; }
            const bf16x8 sb0 = pack8(sacc[0], sacc[1]), sb1 = pack8(sacc[2], sacc[3]);
#pragma unroll
            for (int kt = 0; kt < 4; ++kt) {
                f32x4 a; a[0] = bflo(nreg[s2][kt].x); a[1] = bfhi(nreg[s2][kt].x); a[2] = bflo(nreg[s2][kt].y); a[3] = bfhi(nreg[s2][kt].y);
                a = __builtin_amdgcn_mfma_f32_16x16x32_bf16(*(bf16x8*)&mreg[s2][2 * kt], sb0, a, 0, 0, 0);
                a = __builtin_amdgcn_mfma_f32_16x16x32_bf16(*(bf16x8*)&mreg[s2][2 * kt + 1], sb1, a, 0, 0, 0);
                sacc[kt] = a;
            }
            if (n + S2_PF < NCHUNK) ldstep(s2, n + S2_PF);
        }
    }
}
#define S2R_SLOTS 8
#define S2R_AHEAD 7
__device__ __forceinline__ void s2_ring(const Ctx px, PRef p, char* lds) {
    const int wv = __builtin_amdgcn_readfirstlane(px.tid >> 6), lane = px.tid & 63, l15 = lane & 15, g = lane >> 4;
    const int chain = px.bid;
    const bf16_t* Mb = p.CM + (size_t)chain * NCHUNK * 4096;
    const bf16_t* Nb = p.CN + (size_t)chain * NCHUNK * 4096;
    if (wv >= 4) {
        const int lw = wv - 4;
        unsigned so[2];
#pragma unroll
        for (int i = 0; i < 2; ++i) { const int sl = lw * 128 + i * 64 + lane, row = sl >> 3, cp = sl & 7; so[i] = (unsigned)(row * 64 + ((cp ^ (row & 7)) * 8)); }
        auto issue = [&](int n) {
            char* slot = lds + (n & (S2R_SLOTS - 1)) * 16384 + lw * 2048;
            glds16(Mb + (size_t)n * 4096 + so[0], slot); glds16(Mb + (size_t)n * 4096 + so[1], slot + 1024);
            glds16(Nb + (size_t)n * 4096 + so[0], slot + 8192); glds16(Nb + (size_t)n * 4096 + so[1], slot + 8192 + 1024);
        };
        for (int n = 0; n < S2R_AHEAD; ++n) issue(n);
        asm volatile("s_waitcnt vmcnt(24)" ::: "memory");
        __builtin_amdgcn_s_barrier();
        for (int n = 0; n < NCHUNK; ++n) {
            if (n + S2R_AHEAD < NCHUNK) { issue(n + S2R_AHEAD); asm volatile("s_waitcnt vmcnt(24)" ::: "memory"); }
            else asm volatile("s_waitcnt vmcnt(0)" ::: "memory");
            __builtin_amdgcn_s_barrier();
        }
    } else {
        const int vs = wv * 16;
        bf16_t* Sb = p.CS + (size_t)chain * NCHUNK * 4096 + (vs + l15) * 64 + 4 * g;
        f32x4 sacc[4];
#pragma unroll
        for (int kt = 0; kt < 4; ++kt) sacc[kt] = (f32x4){0.f, 0.f, 0.f, 0.f};
        __builtin_amdgcn_s_barrier();
        for (int n = 0; n < NCHUNK; ++n) {
            const char* slot = lds + (n & (S2R_SLOTS - 1)) * 16384;
            bf16x8 mf[8]; uint2 nf[4];
#pragma unroll
            for (int kt = 0; kt < 4; ++kt) {
                const int row = 16 * kt + l15;
                mf[2 * kt] = *(const bf16x8*)(slot + row * 128 + ((g ^ (row & 7)) << 4));
                mf[2 * kt + 1] = *(const bf16x8*)(slot + row * 128 + (((4 + g) ^ (row & 7)) << 4));
                const int nrow = vs + l15;
                nf[kt] = *(const uint2*)(slot + 8192 + nrow * 128 + (((2 * kt + (g >> 1)) ^ (nrow & 7)) << 4) + (g & 1) * 8);
            }
#pragma unroll
            for (int kt = 0; kt < 4; ++kt) { uint2 o; o.x = pack2(sacc[kt][0], sacc[kt][1]); o.y = pack2(sacc[kt][2], sacc[kt][3]); *(uint2*)(Sb + (size_t)n * 4096 + 16 * kt) = o; }
            const bf16x8 sb0 = pack8(sacc[0], sacc[1]), sb1 = pack8(sacc[2], sacc[3]);
#pragma unroll
            for (int kt = 0; kt < 4; ++kt) {
                f32x4 a2; a2[0] = bflo(nf[kt].x); a2[1] = bfhi(nf[kt].x); a2[2] = bflo(nf[kt].y); a2[3] = bfhi(nf[kt].y);
                a2 = __builtin_amdgcn_mfma_f32_16x16x32_bf16(mf[2 * kt], sb0, a2, 0, 0, 0);
                a2 = __builtin_amdgcn_mfma_f32_16x16x32_bf16(mf[2 * kt + 1], sb1, a2, 0, 0, 0);
                sacc[kt] = a2;
            }
            asm volatile("s_waitcnt lgkmcnt(0)" ::: "memory");
            __builtin_amdgcn_s_barrier();
        }
    }
}
__device__ __forceinline__ void ph_s2(const Ctx px, const Ctx cx, PRef p, char* ldsv, char* ldsq) {
    if (px.bid < 64) {
        s2_ring(px, p, ldsq);
    } else {
        conv_small(cx, p, ldsv, 960, 1856, cx.bid - 128, cx.nb - 128);
        conv_moe(cx, p, ldsv, cx.bid - 128, cx.nb - 128);
    }
}
__device__ __forceinline__ void ph_s3o(const Ctx cx, PRef p) {
    const int lane = cx.tid & 63, tt = cx.tid >> 6, l15 = lane & 15, g = lane >> 4;
    for (int task = cx.bid; task < 32 * NCHUNK; task += cx.nb) {
        const int bh = task / NCHUNK, cc = task % NCHUNK, h = bh & 15, b = bh >> 4;
        const int t = 16 * tt + l15;
        const size_t tbf = ((size_t)(bh * 2) * NCHUNK + cc) * 4096;
        const size_t tbb = ((size_t)(bh * 2 + 1) * NCHUNK + (cc < 4 ? 3 - cc : 135 - cc)) * 4096;
        const int tb_ = 63 - t;
        const bf16x8 rf0 = *(const bf16x8*)(p.CR + tbf + t * 64 + 8 * g), rf1 = *(const bf16x8*)(p.CR + tbf + t * 64 + 32 + 8 * g);
        const bf16x8 rb0 = *(const bf16x8*)(p.CR + tbb + tb_ * 64 + 8 * g), rb1 = *(const bf16x8*)(p.CR + tbb + tb_ * 64 + 32 + 8 * g);
        const int row = cc < 4 ? ROWS_LAT + b * LCTX + 64 * cc + t : b * TLAT + 64 * (cc - 4) + t;
        const size_t off = (size_t)row * DM + h * 64 + 4 * g;
        float4 rkw4[4], lg4[4], lb4[4];
#pragma unroll
        for (int vt = 0; vt < 4; ++vt) { rkw4[vt] = *(const float4*)(p.rw_rk + h * 64 + 16 * vt + 4 * g); lg4[vt] = *(const float4*)(p.rw_lnx_g + h * 64 + 16 * vt + 4 * g); lb4[vt] = *(const float4*)(p.rw_lnx_b + h * 64 + 16 * vt + 4 * g); }
        uint2 ur4[4], uk4[4], uv4[4], ug4[4];
#pragma unroll
        for (int vt = 0; vt < 4; ++vt) { ur4[vt] = *(const uint2*)(p.R + off + 16 * vt); uk4[vt] = *(const uint2*)(p.K + off + 16 * vt); uv4[vt] = *(const uint2*)(p.V + off + 16 * vt); ug4[vt] = *(const uint2*)(p.G + off + 16 * vt); }
        f32x4 y[4];
#pragma unroll
        for (int vt = 0; vt < 4; ++vt) {
            const bf16x8 sf0 = *(const bf16x8*)(p.CS + tbf + (16 * vt + l15) * 64 + 8 * g), sf1 = *(const bf16x8*)(p.CS + tbf + (16 * vt + l15) * 64 + 32 + 8 * g);
            const bf16x8 sb0 = *(const bf16x8*)(p.CS + tbb + (16 * vt + l15) * 64 + 8 * g), sb1 = *(const bf16x8*)(p.CS + tbb + (16 * vt + l15) * 64 + 32 + 8 * g);
            const uint2 yf = *(const uint2*)(p.CY + tbf + t * 64 + 16 * vt + 4 * g), yb = *(const uint2*)(p.CY + tbb + tb_ * 64 + 16 * vt + 4 * g);
            f32x4 a; a[0] = bflo(yf.x) + bflo(yb.x); a[1] = bfhi(yf.x) + bfhi(yb.x); a[2] = bflo(yf.y) + bflo(yb.y); a[3] = bfhi(yf.y) + bfhi(yb.y);
            a = __builtin_amdgcn_mfma_f32_16x16x32_bf16(sf0, rf0, a, 0, 0, 0);
            a = __builtin_amdgcn_mfma_f32_16x16x32_bf16(sf1, rf1, a, 0, 0, 0);
            a = __builtin_amdgcn_mfma_f32_16x16x32_bf16(sb0, rb0, a, 0, 0, 0);
            a = __builtin_amdgcn_mfma_f32_16x16x32_bf16(sb1, rb1, a, 0, 0, 0);
            y[vt] = a;
        }
        float s = 0.f;
#pragma unroll
        for (int vt = 0; vt < 4; ++vt) s += (y[vt][0] + y[vt][1]) + (y[vt][2] + y[vt][3]);
        s += shx(s, 16, lane); s += shx(s, 32, lane);
        const float mu = s * (1.f / 64.f);
        float q2 = 0.f, rk = 0.f;
        float rr[4][4], vv[4][4], gg[4][4];
#pragma unroll
        for (int vt = 0; vt < 4; ++vt) {
            const uint2 ur = ur4[vt], uk = uk4[vt], uv = uv4[vt], ug = ug4[vt];
            const float4 rkw = rkw4[vt];
            rr[vt][0] = bflo(ur.x); rr[vt][1] = bfhi(ur.x); rr[vt][2] = bflo(ur.y); rr[vt][3] = bfhi(ur.y);
            vv[vt][0] = bflo(uv.x); vv[vt][1] = bfhi(uv.x); vv[vt][2] = bflo(uv.y); vv[vt][3] = bfhi(uv.y);
            gg[vt][0] = bflo(ug.x); gg[vt][1] = bfhi(ug.x); gg[vt][2] = bflo(ug.y); gg[vt][3] = bfhi(ug.y);
            rk += rr[vt][0] * bflo(uk.x) * rkw.x + rr[vt][1] * bfhi(uk.x) * rkw.y + rr[vt][2] * bflo(uk.y) * rkw.z + rr[vt][3] * bfhi(uk.y) * rkw.w;
#pragma unroll
            for (int r = 0; r < 4; ++r) { const float d = y[vt][r] - mu; q2 += d * d; }
        }
        q2 += shx(q2, 16, lane); q2 += shx(q2, 32, lane); rk += shx(rk, 16, lane); rk += shx(rk, 32, lane);
        const float rstd = __builtin_amdgcn_rsqf(q2 * (1.f / 64.f) + 64e-5f);
#pragma unroll
        for (int vt = 0; vt < 4; ++vt) {
            const float4 lg = lg4[vt], lb = lb4[vt];
            const float z0 = ((y[vt][0] - mu) * rstd * lg.x + lb.x + rk * vv[vt][0]) * gg[vt][0];
            const float z1 = ((y[vt][1] - mu) * rstd * lg.y + lb.y + rk * vv[vt][1]) * gg[vt][1];
            const float z2 = ((y[vt][2] - mu) * rstd * lg.z + lb.z + rk * vv[vt][2]) * gg[vt][2];
            const float z3 = ((y[vt][3] - mu) * rstd * lg.w + lb.w + rk * vv[vt][3]) * gg[vt][3];
            uint2 o; o.x = pack2(z0, z1); o.y = pack2(z2, z3);
            *(uint2*)(p.G + off + 16 * vt) = o;
        }
    }
}
__device__ __forceinline__ void ph_oproj(const Ctx cx, PRef p, char* lds, const bf16_t* A_, const bf16_t* Wt, const float* xl, const float* xc, const float* modl, int mt_lo, int mtiles) {
    for (int tile = cx.bid; tile < mtiles * 8; tile += cx.nb) {
        const int mt = mt_lo + (tile >> 3), n0 = (tile & 7) * 128, m0 = mt * 128;
        const bf16_t* A = A_ + (size_t)m0 * DM + G3_CH8;
        const bf16_t* B = Wt + (size_t)n0 * 1024 + G3_CH8;
        EpiResid epi; epi.out = p.PRE; epi.xl = xl; epi.xc = xc; epi.modl = modl; epi.m0 = m0; epi.n0 = n0;
        gemm3_tile(cx, A + (size_t)G3_ROW(0) * DM, A + (size_t)G3_ROW(1) * DM,
                   B + (size_t)G3_ROW(0) * 1024, B + (size_t)G3_ROW(1) * 1024, 1024, epi, lds);
    }
}
__device__ __forceinline__ void ph_ln_router(const Ctx cx, PRef p, int layer, int nrows, char* lds) {
    const int lane_ = cx.tid & 63, gw = (cx.bid * NTHR + cx.tid) >> 6, nw = (cx.nb * NTHR) >> 6;
    const float* lg = p.ln1_g + layer * DM; const float* lb = p.ln1_b + layer * DM;
    {
        const float* rw = p.router_w + (size_t)layer * DM * 16;
        float4* L = (float4*)lds;
#pragma unroll 4
        for (int f = cx.tid; f < 4096; f += NTHR) {
            const float4 w = *(const float4*)(rw + 4 * f);
            const int col = f >> 2, e4 = f & 3, i = col >> 8, ln = (col >> 2) & 63, c = col & 3;
            L[((((i * 4 + c) * 4) + e4) << 6) + ln] = w;
        }
        __syncthreads();
    }
    const bool b5 = lane_ & 32, b4 = lane_ & 16, b3 = lane_ & 8, b2 = lane_ & 4;
    const int myidx = (b5 ? 8 : 0) + (b4 ? 4 : 0) + (b3 ? 2 : 0) + (b2 ? 1 : 0);
    const int nmain = (nrows / (nw * 4)) * (nw * 4);
    const int ntail = nrows - nmain;
    for (int it = gw; it < nmain / 4 + ntail; it += nw) {
        const int rstep = it < nmain / 4 ? 1 : 0;
        const int r0 = rstep ? it * 4 : nmain + (it - nmain / 4);
        int lane = lane_; asm volatile("" : "+v"(lane));
        float mu[4], rstd[4];
        float4 v[4][4];
        {
#pragma unroll
            for (int rr = 0; rr < 4; ++rr) {
                const float* pr = p.PRE + (size_t)(r0 + rr * rstep) * DM;
                float s = 0.f;
#pragma unroll
                for (int i = 0; i < 4; ++i) { v[rr][i] = *(const float4*)(pr + i * 256 + lane * 4); s += (v[rr][i].x + v[rr][i].y) + (v[rr][i].z + v[rr][i].w); }
                mu[rr] = s;
            }
#pragma unroll
            for (int rr = 0; rr < 4; ++rr) mu[rr] = wsum(mu[rr]) * (1.f / 1024.f);
#pragma unroll
            for (int rr = 0; rr < 4; ++rr) {
                float q = 0.f;
#pragma unroll
                for (int i = 0; i < 4; ++i) { const float a = v[rr][i].x - mu[rr], b = v[rr][i].y - mu[rr], c = v[rr][i].z - mu[rr], d = v[rr][i].w - mu[rr]; q += (a * a + b * b) + (c * c + d * d); }
                rstd[rr] = q;
            }
#pragma unroll
            for (int rr = 0; rr < 4; ++rr) rstd[rr] = __builtin_amdgcn_rsqf(wsum(rstd[rr]) * (1.f / 1024.f) + 1e-5f);
        }
        const float* mv = p.modv + (size_t)(layer * 3 + mod_of_row(r0)) * 6144;
        float lgt[4][16];
#pragma unroll
        for (int rr = 0; rr < 4; ++rr)
#pragma unroll
            for (int e = 0; e < 16; ++e) lgt[rr][e] = 0.f;
        float4 wq0, wq1, wq2, wq3;
        const float4* Lw = (const float4*)lds + lane;
        { wq0 = Lw[0]; wq1 = Lw[64]; wq2 = Lw[128]; wq3 = Lw[192]; }
#pragma unroll
        for (int i = 0; i < 4; ++i) {
            const int col = i * 256 + lane * 4;
            const float4 g4 = *(const float4*)(lg + col), b4v = *(const float4*)(lb + col);
            const float4 sh = *(const float4*)(mv + 3 * 1024 + col), sc = *(const float4*)(mv + 4 * 1024 + col);
            float hh[4][4];
#pragma unroll
            for (int rr = 0; rr < 4; ++rr) {
                const float4 vv = v[rr][i];
                float4 x1;
                x1.x = (vv.x - mu[rr]) * rstd[rr] * g4.x + b4v.x; x1.y = (vv.y - mu[rr]) * rstd[rr] * g4.y + b4v.y;
                x1.z = (vv.z - mu[rr]) * rstd[rr] * g4.z + b4v.z; x1.w = (vv.w - mu[rr]) * rstd[rr] * g4.w + b4v.w;
                *(float4*)(p.X1 + (size_t)(r0 + rr * rstep) * DM + col) = x1;
                hh[rr][0] = x1.x * (1.f + sc.x) + sh.x; hh[rr][1] = x1.y * (1.f + sc.y) + sh.y; hh[rr][2] = x1.z * (1.f + sc.z) + sh.z; hh[rr][3] = x1.w * (1.f + sc.w) + sh.w;
                uint2 o; o.x = pack2(hh[rr][0], hh[rr][1]); o.y = pack2(hh[rr][2], hh[rr][3]);
                *(uint2*)(p.H2 + (size_t)(r0 + rr * rstep) * DM + col) = o;
            }
#pragma unroll
            for (int c = 0; c < 4; ++c) {
                float4 n0 = wq0, n1 = wq1, n2 = wq2, n3 = wq3;
                if (i * 4 + c + 1 < 16) {
                    const float4* rp = Lw + (i * 4 + c + 1) * 256;
                    n0 = rp[0]; n1 = rp[64]; n2 = rp[128]; n3 = rp[192];
                }
                const float4 w0 = wq0, w1 = wq1, w2 = wq2, w3 = wq3;
#pragma unroll
                for (int rr = 0; rr < 4; ++rr) {
                    const float hv = hh[rr][c];
                    lgt[rr][0] += hv * w0.x; lgt[rr][1] += hv * w0.y; lgt[rr][2] += hv * w0.z; lgt[rr][3] += hv * w0.w;
                    lgt[rr][4] += hv * w1.x; lgt[rr][5] += hv * w1.y; lgt[rr][6] += hv * w1.z; lgt[rr][7] += hv * w1.w;
                    lgt[rr][8] += hv * w2.x; lgt[rr][9] += hv * w2.y; lgt[rr][10] += hv * w2.z; lgt[rr][11] += hv * w2.w;
                    lgt[rr][12] += hv * w3.x; lgt[rr][13] += hv * w3.y; lgt[rr][14] += hv * w3.z; lgt[rr][15] += hv * w3.w;
                }
                if (c & 1) {
#define LPIN(rr) asm volatile("" : "+v"(lgt[rr][0]), "+v"(lgt[rr][1]), "+v"(lgt[rr][2]), "+v"(lgt[rr][3]), "+v"(lgt[rr][4]), "+v"(lgt[rr][5]), "+v"(lgt[rr][6]), "+v"(lgt[rr][7]), \
                                   "+v"(lgt[rr][8]), "+v"(lgt[rr][9]), "+v"(lgt[rr][10]), "+v"(lgt[rr][11]), "+v"(lgt[rr][12]), "+v"(lgt[rr][13]), "+v"(lgt[rr][14]), "+v"(lgt[rr][15]) :: "memory")
                    LPIN(0); LPIN(1); LPIN(2); LPIN(3);
#undef LPIN
                }
                wq0 = n0; wq1 = n1; wq2 = n2; wq3 = n3;
            }
        }
#pragma unroll
        for (int rr = 0; rr < 4; ++rr) {
            float a8[8], a4[4], a2[2], a1;
#pragma unroll
            for (int i = 0; i < 8; ++i) { const float snd = b5 ? lgt[rr][i] : lgt[rr][i + 8]; const float kp = b5 ? lgt[rr][i + 8] : lgt[rr][i]; a8[i] = kp + shx(snd, 32, lane); }
#pragma unroll
            for (int i = 0; i < 4; ++i) { const float snd = b4 ? a8[i] : a8[i + 4]; const float kp = b4 ? a8[i + 4] : a8[i]; a4[i] = kp + shx(snd, 16, lane); }
#pragma unroll
            for (int i = 0; i < 2; ++i) { const float snd = b3 ? a4[i] : a4[i + 2]; const float kp = b3 ? a4[i + 2] : a4[i]; a2[i] = kp + shx(snd, 8, lane); }
            { const float snd = b2 ? a2[0] : a2[1]; const float kp = b2 ? a2[1] : a2[0]; a1 = kp + shx(snd, 4, lane); }
            a1 += shx(a1, 2, lane); a1 += shx(a1, 1, lane);
            float mx = a1;
            mx = fmaxf(mx, shx(mx, 32, lane)); mx = fmaxf(mx, shx(mx, 16, lane)); mx = fmaxf(mx, shx(mx, 8, lane)); mx = fmaxf(mx, shx(mx, 4, lane));
            const float ex = __expf(a1 - mx);
            float se = ex;
            se += shx(se, 32, lane); se += shx(se, 16, lane); se += shx(se, 8, lane); se += shx(se, 4, lane);
            if ((lane & 3) == 0) { p.afft[(size_t)myidx * ROWS + r0 + rr * rstep] = ex / se; p.inv[(size_t)(r0 + rr * rstep) * 16 + myidx] = -1; }
        }
    }
}
template <int CH>
__device__ __forceinline__ void topk_list(const Ctx cx, PRef p, int e, int rowbase, int cap, int slotbase, unsigned* sh) {
    const int tid = cx.tid, lane = tid & 63, wave = tid >> 6;
    const float* src = p.afft + (size_t)e * ROWS + rowbase + tid * CH;
    unsigned key[CH];
    if (CH >= 4) {
#pragma unroll
        for (int j = 0; j < CH / 4; ++j) { const uint4 u = *(const uint4*)(src + 4 * j); key[4 * j] = u.x; key[4 * j + 1] = u.y; key[4 * j + 2] = u.z; key[4 * j + 3] = u.w; }
    } else {
#pragma unroll
        for (int j = 0; j < CH; ++j) key[j] = __float_as_uint(src[j]);
    }
    unsigned prefix = 0u;
    for (int bit = 30; bit >= 0; --bit) {
        const unsigned cand = prefix | (1u << bit);
        int c = 0;
#pragma unroll
        for (int j = 0; j < CH; ++j) c += (key[j] >= cand) ? 1 : 0;
#pragma unroll
        for (int o = 32; o > 0; o >>= 1) c += shxi(c, o, lane);
        const int slot = (30 - bit) & 1;
        if (lane == 0) sh[slot * 4 + wave] = (unsigned)c;
        __syncthreads();
        const int tot = (int)(sh[slot * 4] + sh[slot * 4 + 1] + sh[slot * 4 + 2] + sh[slot * 4 + 3]);
        if (tot >= cap) prefix = cand;
    }
    __syncthreads();
    const unsigned thr = prefix;
    int cg = 0, ce = 0;
#pragma unroll
    for (int j = 0; j < CH; ++j) { cg += key[j] > thr; ce += key[j] == thr; }
    unsigned pk = (unsigned)cg | ((unsigned)ce << 16);
    unsigned incl = pk;
#pragma unroll
    for (int o = 1; o < 64; o <<= 1) { const unsigned n = (unsigned)shidx((int)incl, (lane - o) & 63); if (lane >= o) incl += n; }
    if (lane == 63) sh[8 + wave] = incl;
    __syncthreads();
    unsigned wbase = 0u, total = 0u;
#pragma unroll
    for (int w = 0; w < 4; ++w) { const unsigned v = sh[8 + w]; if (w < wave) wbase += v; total += v; }
    const unsigned excl = wbase + incl - pk;
    const int tot_gt = (int)(total & 0xffffu);
    const int need_eq = cap - tot_gt;
    int eq_rank = (int)(excl >> 16);
    int gt_before = (int)(excl & 0xffffu);
#pragma unroll
    for (int j = 0; j < CH; ++j) {
        const bool isg = key[j] > thr, ise = key[j] == thr;
        const bool sel = isg || (ise && eq_rank < need_eq);
        if (sel) {
            const int slot = slotbase + gt_before + (eq_rank < need_eq ? eq_rank : need_eq);
            const int row = rowbase + tid * CH + j;
            p.idx[e * MPAD0 + slot] = row;
            p.gate[e * MPAD0 + slot] = __uint_as_float(key[j]);
            p.inv[(size_t)row * 16 + e] = slot;
        }
        gt_before += isg; eq_rank += ise;
    }
    __syncthreads();
}
__device__ __forceinline__ void ph_topk(const Ctx cx, PRef p, int layer, char* lds) {
    unsigned* sh = (unsigned*)lds;
    const int nlists = layer == 0 ? 64 : 32;
    for (int li = cx.bid; li < nlists; li += cx.nb) {
        const int s = li >> 4, e = li & 15;
        if (s < 2) topk_list<32>(cx, p, e, s * TLAT, 1024, s * 1024, sh);
        else {
            topk_list<1>(cx, p, e, ROWS_LAT + (s - 2) * LCTX, 32, 2048 + (s - 2) * 32, sh);
            if (s == 3 && cx.tid < 64) { p.idx[e * MPAD0 + 2112 + cx.tid] = -1; p.gate[e * MPAD0 + 2112 + cx.tid] = 0.f; }
        }
    }
}
__device__ __forceinline__ void ph_moe_up(const Ctx cx, PRef p, int layer, char* lds) {
    if (layer != 0) return;
    for (int tile = cx.bid; tile < 16 * 32; tile += cx.nb) {
        const int e = tile >> 5, nt = tile & 31, m0 = 2048, j0 = nt * 64;
        const bf16_t* ar[2]; const bf16_t* br[2];
        const bf16_t* We = p.CW + (size_t)(layer * 16 + e) * 3 * 2097152;
#pragma unroll
        for (int i = 0; i < 2; ++i) {
            const int r = G3_ROW(i);
            int src = p.idx[e * MPAD0 + m0 + r]; if (src < 0) src = 0;
            ar[i] = p.H2 + (size_t)src * DM + G3_CH8;
            const int j = j0 + (r >> 6) * 32 + ((r >> 4) & 1) * 16 + (r & 15);
            br[i] = We + (size_t)((r >> 5) & 1) * 2097152 + (size_t)j * 1024 + G3_CH8;
        }
        EpiSwiGLU epi; epi.out = p.HMID + (size_t)e * MPAD0 * 2048; epi.m0 = m0; epi.j0 = j0;
        gemm3_tile(cx, ar[0], ar[1], br[0], br[1], 1024, epi, lds);
    }
}
__device__ __forceinline__ void ph_moe_down(const Ctx cx, PRef p, int layer, char* lds) {
    if (layer != 0) return;
    for (int tile = cx.bid; tile < 16 * 8; tile += cx.nb) {
        const int e = tile >> 3, nt = tile & 7, m0 = 2048, n0 = nt * 128;
        const bf16_t* A = p.HMID + ((size_t)e * MPAD0 + m0) * 2048 + G3_CH8;
        const bf16_t* B = p.CW + ((size_t)(layer * 16 + e) * 3 + 2) * 2097152 + (size_t)n0 * 2048 + G3_CH8;
        EpiDown epi; epi.out = p.YE + (size_t)e * MPAD0 * DM; epi.gate = p.gate + e * MPAD0; epi.m0 = m0; epi.n0 = n0;
        gemm3_tile(cx, A + (size_t)G3_ROW(0) * 2048, A + (size_t)G3_ROW(1) * 2048,
                   B + (size_t)G3_ROW(0) * 2048, B + (size_t)G3_ROW(1) * 2048, 2048, epi, lds);
    }
}
__device__ __forceinline__ void ph_combine(const Ctx cx, PRef p, int layer, int nrows) {
    const int lane = cx.tid & 63, gw = (cx.bid * NTHR + cx.tid) >> 6, nw = (cx.nb * NTHR) >> 6;
    const float* lg = p.ln2_g + layer * DM; const float* lb = p.ln2_b + layer * DM;
    int inv_next = (gw < nrows && lane < 16) ? p.inv[(size_t)gw * 16 + lane] : -1;
    for (int row = gw; row < nrows; row += nw) {
        const float* mv = p.modv + (size_t)(layer * 3 + mod_of_row(row)) * 6144;
        float4 m[4];
#pragma unroll
        for (int i = 0; i < 4; ++i) m[i] = make_float4(0.f, 0.f, 0.f, 0.f);
        const int myinv = inv_next;
        float4 x1r[4], g5r[4];
#pragma unroll
        for (int i = 0; i < 4; ++i) { const int col = i * 256 + lane * 4; x1r[i] = *(const float4*)(p.X1 + (size_t)row * DM + col); g5r[i] = *(const float4*)(mv + 5 * 1024 + col); }
        inv_next = (row + nw < nrows && lane < 16) ? p.inv[(size_t)(row + nw) * 16 + lane] : -1;
        unsigned vm = (unsigned)(__builtin_amdgcn_ballot_w64(myinv >= 0) & 0xffffull);
        while (vm) {
            int ek[4]; float wk[4];
#pragma unroll
            for (int k = 0; k < 4; ++k) { if (vm) { ek[k] = __builtin_ctz(vm); vm &= vm - 1u; wk[k] = 1.f; } else { ek[k] = ek[0]; wk[k] = 0.f; } }
            uint2 y[4][4];
#pragma unroll
            for (int k = 0; k < 4; ++k) {
                const int sl = shidx(myinv, ek[k]);
                const bf16_t* yr = p.YE + ((size_t)ek[k] * MPAD0 + sl) * DM;
#pragma unroll
                for (int i = 0; i < 4; ++i) y[k][i] = *(const uint2*)(yr + i * 256 + lane * 4);
            }
#pragma unroll
            for (int k = 0; k < 4; ++k)
#pragma unroll
                for (int i = 0; i < 4; ++i) { m[i].x += wk[k] * bflo(y[k][i].x); m[i].y += wk[k] * bfhi(y[k][i].x); m[i].z += wk[k] * bflo(y[k][i].y); m[i].w += wk[k] * bfhi(y[k][i].y); }
        }
        float4 v[4]; float s = 0.f;
#pragma unroll
        for (int i = 0; i < 4; ++i) {
            const int col = i * 256 + lane * 4;
            const float4 x1 = x1r[i], g5 = g5r[i];
            v[i].x = ALPHA_F * x1.x + g5.x * m[i].x; v[i].y = ALPHA_F * x1.y + g5.y * m[i].y; v[i].z = ALPHA_F * x1.z + g5.z * m[i].z; v[i].w = ALPHA_F * x1.w + g5.w * m[i].w;
            s += (v[i].x + v[i].y) + (v[i].z + v[i].w);
        }
        const float mu = wsum(s) * (1.f / 1024.f);
        float q = 0.f;
#pragma unroll
        for (int i = 0; i < 4; ++i) { const float a = v[i].x - mu, b = v[i].y - mu, c = v[i].z - mu, d = v[i].w - mu; q += (a * a + b * b) + (c * c + d * d); }
        const float rstd = __builtin_amdgcn_rsqf(wsum(q) * (1.f / 1024.f) + 1e-5f);
        const float* mv1 = p.modv + (size_t)(3 + mod_of_row(row)) * 6144;
#pragma unroll
        for (int i = 0; i < 4; ++i) {
            const int col = i * 256 + lane * 4;
            const float4 g4 = *(const float4*)(lg + col), b4 = *(const float4*)(lb + col);
            float4 x2;
            x2.x = (v[i].x - mu) * rstd * g4.x + b4.x; x2.y = (v[i].y - mu) * rstd * g4.y + b4.y;
            x2.z = (v[i].z - mu) * rstd * g4.z + b4.z; x2.w = (v[i].w - mu) * rstd * g4.w + b4.w;
            if (layer == 0) {
                *(float4*)(p.X1 + (size_t)row * DM + col) = x2;
                const float4 sh = *(const float4*)(mv1 + col), sc = *(const float4*)(mv1 + 1024 + col);
                uint2 o; o.x = pack2(x2.x * (1.f + sc.x) + sh.x, x2.y * (1.f + sc.y) + sh.y); o.y = pack2(x2.z * (1.f + sc.z) + sh.z, x2.w * (1.f + sc.w) + sh.w);
                *(uint2*)(p.HB + (size_t)row * DM + col) = o;
            } else {
                *(float4*)(p.out + (size_t)row * DM + col) = x2;
            }
        }
    }
}
__device__ __forceinline__ void ph_qkv(const Ctx cx, PRef p, char* lds) {
    for (int tile = cx.bid; tile < 16; tile += cx.nb) {
        const int mt = 128 + (tile >> 2), n0 = (8 + (tile & 3)) * 128, m0 = mt * 128;
        const bf16_t* A = p.HB + (size_t)m0 * DM + G3_CH8;
        const bf16_t* B = p.wqkvT + (size_t)n0 * 1024 + G3_CH8;
        EpiQKV epi; epi.p = &p; epi.m0 = m0; epi.n0 = n0;
        gemm3_tile(cx, A + (size_t)G3_ROW(0) * DM, A + (size_t)G3_ROW(1) * DM,
                   B + (size_t)G3_ROW(0) * 1024, B + (size_t)G3_ROW(1) * 1024, 1024, epi, lds);
    }
}
#define AT_ROW 72
__device__ __forceinline__ void ph_attn(const Ctx cx, PRef p, char* lds) {
    const int tid = cx.tid, lane = tid & 63, wave = tid >> 6, qi = lane & 15, g = lane >> 4;
    bf16_t* Ks = (bf16_t*)lds;
    bf16_t* Vs = Ks + 64 * AT_ROW;
    const float LOG2E = 1.4426950408889634f;
    for (int item = cx.bid; item < 2 * 128 * 4; item += cx.nb) {
        const int hk = item & 3, qb = (item >> 2) & 127, b = item >> 9;
        const int hq = hk * 4 + wave, q0 = qb * 64;
        bf16x8 qf[4][2];
#pragma unroll
        for (int qs = 0; qs < 4; ++qs)
#pragma unroll
            for (int ks = 0; ks < 2; ++ks)
                qf[qs][ks] = *(const bf16x8*)(p.Q + (size_t)(b * TLAT + q0 + qs * 16 + qi) * DM + hq * 64 + ks * 32 + 8 * g);
        f32x4 o[4][4];
#pragma unroll
        for (int i = 0; i < 4; ++i)
#pragma unroll
            for (int j = 0; j < 4; ++j) o[i][j] = (f32x4){0.f, 0.f, 0.f, 0.f};
        const float sink = p.at_sink[hq] * LOG2E;
        float mrow[4], lrow[4];
#pragma unroll
        for (int qs = 0; qs < 4; ++qs) { mrow[qs] = sink; lrow[qs] = (g == 0) ? 1.f : 0.f; }
        uint4 kr0, kr1, vr0, vr1;
        kr0 = kr1 = vr0 = vr1 = make_uint4(0u, 0u, 0u, 0u);
#define AT_GEOM(tile_, isctx_, ts_, skip_) const bool isctx_ = (tile_) < 4; const int ts_ = isctx_ ? (tile_) * 64 : q0 - 128 + ((tile_) - 4) * 64; const bool skip_ = !isctx_ && (ts_ < 0 || ts_ >= TLAT)
#define AT_LOAD(tile_) do { AT_GEOM(tile_, ic_, tl_, sk_); if (!sk_) { \
            const bf16_t* kbase = ic_ ? p.KA + (size_t)(ROWS_LAT + b * LCTX + tl_) * 256 + hk * 64 : p.KA + (size_t)(b * TLAT + tl_) * 256 + hk * 64; \
            const bf16_t* vbase = ic_ ? p.VTC + (size_t)(b * 4 + hk) * 64 * LCTX + tl_ : p.VTL + (size_t)(b * 4 + hk) * 64 * TLAT + tl_; \
            const int ldv = ic_ ? LCTX : TLAT; \
            const int r0_ = tid >> 3, r1_ = (tid + 256) >> 3, c8_ = (tid & 7) * 8; \
            kr0 = *(const uint4*)(kbase + (size_t)r0_ * 256 + c8_); vr0 = *(const uint4*)(vbase + (size_t)r0_ * ldv + c8_); \
            kr1 = *(const uint4*)(kbase + (size_t)r1_ * 256 + c8_); vr1 = *(const uint4*)(vbase + (size_t)r1_ * ldv + c8_); } } while (0)
        AT_LOAD(0);
        for (int tile = 0; tile < 9; ++tile) {
            AT_GEOM(tile, isctx, ts, skip);
            __syncthreads();
            if (!skip) {
                const int r0_ = tid >> 3, r1_ = (tid + 256) >> 3, c8_ = (tid & 7) * 8;
                *(uint4*)(Ks + r0_ * AT_ROW + c8_) = kr0; *(uint4*)(Vs + r0_ * AT_ROW + c8_) = vr0;
                *(uint4*)(Ks + r1_ * AT_ROW + c8_) = kr1; *(uint4*)(Vs + r1_ * AT_ROW + c8_) = vr1;
            }
            if (tile + 1 < 9) AT_LOAD(tile + 1);
            __syncthreads();
            if (!skip)
#pragma unroll
            for (int qh = 0; qh < 2; ++qh) {
                f32x4 s[4][2];
#pragma unroll
                for (int kt = 0; kt < 4; ++kt) {
                    const bf16x8 k0 = *(const bf16x8*)(Ks + (kt * 16 + qi) * AT_ROW + 8 * g);
                    const bf16x8 k1 = *(const bf16x8*)(Ks + (kt * 16 + qi) * AT_ROW + 32 + 8 * g);
#pragma unroll
                    for (int q2 = 0; q2 < 2; ++q2) {
                        f32x4 a = (f32x4){0.f, 0.f, 0.f, 0.f};
                        a = __builtin_amdgcn_mfma_f32_16x16x32_bf16(k0, qf[2 * qh + q2][0], a, 0, 0, 0);
                        a = __builtin_amdgcn_mfma_f32_16x16x32_bf16(k1, qf[2 * qh + q2][1], a, 0, 0, 0);
                        s[kt][q2] = a;
                    }
                }
                __builtin_amdgcn_sched_barrier(0);
#pragma unroll
                for (int q2 = 0; q2 < 2; ++q2) {
                    const int qs = 2 * qh + q2;
                    const int qp = q0 + qs * 16 + qi;
                    float tmax = -1e30f;
#pragma unroll
                    for (int kt = 0; kt < 4; ++kt)
#pragma unroll
                        for (int r = 0; r < 4; ++r) {
                            float v = s[kt][q2][r] * LOG2E;
                            if (!isctx) { const int kp = ts + kt * 16 + 4 * g + r; const int dd = qp - kp; if (dd > 128 || dd < -128) v = -1e30f; }
                            s[kt][q2][r] = v; tmax = fmaxf(tmax, v);
                        }
                    tmax = fmaxf(tmax, shx(tmax, 16, lane)); tmax = fmaxf(tmax, shx(tmax, 32, lane));
                    const float mn = fmaxf(mrow[qs], tmax);
                    const float alpha = __builtin_amdgcn_exp2f(mrow[qs] - mn);
                    mrow[qs] = mn;
                    float ls = 0.f;
#pragma unroll
                    for (int kt = 0; kt < 4; ++kt)
#pragma unroll
                        for (int r = 0; r < 4; ++r) { const float pv = __builtin_amdgcn_exp2f(s[kt][q2][r] - mn); s[kt][q2][r] = pv; ls += pv; }
                    lrow[qs] = lrow[qs] * alpha + ls;
#pragma unroll
                    for (int dt = 0; dt < 4; ++dt) o[dt][qs] = o[dt][qs] * alpha;
                }
                __builtin_amdgcn_sched_barrier(0);
#pragma unroll
                for (int kk = 0; kk < 2; ++kk) {
                    bf16x8 pf[2];
#pragma unroll
                    for (int q2 = 0; q2 < 2; ++q2) {
                        uint4 u;
                        u.x = pack2(s[2 * kk][q2][0], s[2 * kk][q2][1]); u.y = pack2(s[2 * kk][q2][2], s[2 * kk][q2][3]);
                        u.z = pack2(s[2 * kk + 1][q2][0], s[2 * kk + 1][q2][1]); u.w = pack2(s[2 * kk + 1][q2][2], s[2 * kk + 1][q2][3]);
                        pf[q2] = *(bf16x8*)&u;
                    }
#pragma unroll
                    for (int dt = 0; dt < 4; ++dt) {
                        const bf16_t* vr = Vs + (dt * 16 + qi) * AT_ROW + 32 * kk + 4 * g;
                        uint4 u; const uint2 lo = *(const uint2*)(vr), hi = *(const uint2*)(vr + 16);
                        u.x = lo.x; u.y = lo.y; u.z = hi.x; u.w = hi.y;
                        const bf16x8 vf = *(bf16x8*)&u;
#pragma unroll
                        for (int q2 = 0; q2 < 2; ++q2) o[dt][2 * qh + q2] = __builtin_amdgcn_mfma_f32_16x16x32_bf16(vf, pf[q2], o[dt][2 * qh + q2], 0, 0, 0);
                    }
                }
            }
        }
#pragma unroll
        for (int qs = 0; qs < 4; ++qs) {
            float l = lrow[qs]; l += shx(l, 16, lane); l += shx(l, 32, lane);
            const float il = __builtin_amdgcn_rcpf(l);
            bf16_t* op = p.O + (size_t)(b * TLAT + q0 + qs * 16 + qi) * DM + hq * 64 + 4 * g;
#pragma unroll
            for (int dt = 0; dt < 4; ++dt) {
                uint2 u; u.x = pack2(o[dt][qs][0] * il, o[dt][qs][1] * il); u.y = pack2(o[dt][qs][2] * il, o[dt][qs][3] * il);
                *(uint2*)(op + dt * 16) = u;
            }
        }
    }
}

#define N_PHASES 23
#define VLDS (S1_LDS_BYTES)
__global__ void __launch_bounds__(2 * NTHR, 2) mk_forward(Params p_by_value) {
    __shared__ __attribute__((aligned(16))) char lds[2 * VLDS + 64];
    volatile unsigned* bst = (volatile unsigned*)(lds + 2 * VLDS);
    PPtr pp = (PPtr)__builtin_amdgcn_kernarg_segment_ptr();
    const int ph_lo = pp->ph_lo, ph_hi = pp->ph_hi;
    const int wave_s = __builtin_amdgcn_readfirstlane((int)threadIdx.x >> 6);
    const bool multi = ph_hi > ph_lo;
    if (multi) {
        if (threadIdx.x == 0) { bst[0] = 0u; bst[1] = 0u; }
        __syncthreads();
        (void)xcd_barrier_post(pp->bar, bst);
    }
    bool dup_done = false; (void)dup_done;
    for (int ph = ph_lo; ph <= ph_hi; ++ph) {
#ifdef ONLY_PH
        if (ph != ONLY_PH) continue;
#endif
        if (ph == 4 || ph == 8) continue;
        PPtr q = pp; asm volatile("" : "+s"(q));
        PRef p = *q;
#define LDSP (lds + (wave_s >> 2) * VLDS + fresh_zero())
#define MKPX(name) Ctx name; name.tid = wave_s * 64 + fresh_lane(); name.bid = blockIdx.x; name.nb = gridDim.x; asm volatile("" : "+v"(name.tid), "+s"(name.bid), "+s"(name.nb))
#define MKCX(name) Ctx name; name.tid = (wave_s & 3) * 64 + fresh_lane(); name.bid = blockIdx.x * 2 + (wave_s >> 2); name.nb = gridDim.x * 2; asm volatile("" : "+v"(name.tid), "+s"(name.bid), "+s"(name.nb)); int lz2_ = 0; asm volatile("" : "+v"(lz2_)); char* ldsy = lds + (wave_s >> 2) * VLDS + lz2_
        switch (ph) {
            case 0: { MKCX(cx);  ph_ada(cx, p, LDSP); } break;
            case 1: { MKCX(cx);  ph_pre0(cx, p); } break;
            case 2: { MKPX(px);  { ProbRKV pr; pr.p = q; pr.K = 1024; pr.c = px.bid; pr.G = px.nb; { int z8 = 0; asm volatile("" : "+v"(z8)); gemm8(px, lds + z8, pr); } MKCX(cy); ph_g1(cy, p, ldsy); } } break;
            case 3: { MKCX(cx);  ph_g2(cx, p, LDSP); } break;
            case 4: { MKCX(cx);  ph_prep(cx, p); } break;
            case 5: { MKCX(cx);  ph_s1(cx, p, LDSP); } break;
            case 6: { MKPX(px); MKCX(cx);  ph_s2(px, cx, p, LDSP, lds + fresh_zero()); } break;
            case 7: { MKCX(cx);  ph_s3o(cx, p); } break;
            case 9: case 17: {
                const bool l1 = ph == 17; MKPX(px);
                {
                    ProbOproj pr; pr.A = l1 ? p.O : p.G; pr.Wt = l1 ? p.atwoT : p.woT; pr.out = p.PRE; pr.xl = l1 ? p.X1 : p.x; pr.modl = l1 ? p.modv + 3 * 6144 : p.modv; pr.K = 1024; pr.c = px.bid; pr.G = px.nb;
                    { int z8 = 0; asm volatile("" : "+v"(z8)); gemm8(px, lds + z8, pr); }
                }
                if (!l1) { MKCX(cy); ph_oproj(cy, p, ldsy, p.G, p.woT, p.x, p.ctx, p.modv, 128, 4); }
            } break;
            case 10: case 18: { MKCX(cx); ph_ln_router(cx, p, ph == 18 ? 1 : 0, ph == 18 ? ROWS_LAT : ROWS, LDSP); } break;
            case 11: case 19: { MKCX(cx); ph_topk(cx, p, ph == 19 ? 1 : 0, LDSP); } break;
            case 12: case 20: { MKPX(px); { ProbUp pr; pr.p = q; pr.K = 1024; pr.c = px.bid; pr.G = px.nb; pr.layer = ph == 20 ? 1 : 0; { int z8 = 0; asm volatile("" : "+v"(z8)); gemm8(px, lds + z8, pr); } MKCX(cy); ph_moe_up(cy, p, ph == 20 ? 1 : 0, ldsy); } } break;
            case 13: case 21: { MKPX(px); { ProbDown pr; pr.p = q; pr.K = 2048; pr.c = px.bid; pr.G = px.nb; pr.layer = ph == 21 ? 1 : 0; { int z8 = 0; asm volatile("" : "+v"(z8)); gemm8(px, lds + z8, pr); } MKCX(cy); ph_moe_down(cy, p, ph == 21 ? 1 : 0, ldsy); } } break;
            case 14: case 22: { MKCX(cx); ph_combine(cx, p, ph == 22 ? 1 : 0, ph == 22 ? ROWS_LAT : ROWS); } break;
            case 15: { MKPX(px);  { ProbQKV pr; pr.p = q; pr.K = 1024; pr.c = px.bid; pr.G = px.nb; { int z8 = 0; asm volatile("" : "+v"(z8)); gemm8(px, lds + z8, pr); } MKCX(cy); ph_qkv(cy, p, ldsy); } } break;
            case 16: { MKCX(cx);  ph_attn(cx, p, LDSP); } break;
        }
#ifdef DUP_MASK
        if (((DUP_MASK >> ph) & 1u) && !dup_done) { dup_done = true; --ph; } else dup_done = false;
        if (ph + 1 <= ph_hi && (ph < ph_hi)) {
#else
        if (ph < ph_hi) {
#endif
            if (ph == ph_lo && q->bar == nullptr) cg::this_grid().sync();
            { XcdBarrier xb2; xb2.bar = q->bar; xb2.x = xb_xcc_id(); int lz3 = 0; asm volatile("" : "+v"(lz3)); xb2.st = (volatile unsigned*)(lds + 2 * VLDS + lz3); asm volatile("" : "+s"(xb2.x)); xcd_barrier(xb2); }
        }
    }
}

extern "C" void kernel_launch(void* const* d_in, const int* in_sizes, int n_in, void* d_out, int out_size, void* d_ws, size_t ws_size, hipStream_t stream) {
    Params p{};
    const float** f = (const float**)d_in;
    p.x = f[0]; p.c = f[1]; p.ctx = f[2]; p.c_ctx = f[3]; p.ada_w = f[4]; p.ada_b = f[5]; p.ln1_g = f[6]; p.ln1_b = f[7]; p.ln2_g = f[8]; p.ln2_b = f[9];
    p.rw_mu = f[10]; p.rw_wr = f[11]; p.rw_wk = f[12]; p.rw_wv = f[13]; p.rw_w0 = f[14]; p.rw_w1 = f[15]; p.rw_w2 = f[16]; p.rw_a0 = f[17]; p.rw_a1 = f[18]; p.rw_a2 = f[19];
    p.rw_g1 = f[20]; p.rw_g2 = f[21]; p.rw_kk = f[22]; p.rw_ka = f[23]; p.rw_rk = f[24]; p.rw_lnx_g = f[25]; p.rw_lnx_b = f[26]; p.rw_wo = f[27];
    p.at_wqkv = f[28]; p.at_wo = f[29]; p.at_sink = f[30]; p.router_w = f[31]; p.moe_w_gate = f[32]; p.moe_w_up = f[33]; p.moe_w_down = f[34];
    p.out = (float*)d_out;
    char* ws = (char*)d_ws; size_t off = 0;
    auto take = [&](size_t bytes) { char* r = ws + off; off += (bytes + 255) & ~(size_t)255; return r; };
    const size_t U = (size_t)ROWS * DM * 2;
    p.bar = (unsigned*)take(16384);
    p.modv = (float*)take(2 * 3 * 6144 * 4);
    p.modp = (float*)take((size_t)16 * 2 * 3 * 6144 * 4);
    p.rope = (float*)take(128 * 16 * 2 * 4);
    p.afft = (float*)take((size_t)16 * ROWS * 4);
    p.inv = (int*)take((size_t)ROWS * 16 * 4);
    p.idx = (int*)take(16 * MPAD0 * 4);
    p.gate = (float*)take(16 * MPAD0 * 4);
    p.wrT = (bf16_t*)take(2097152); p.wkT = (bf16_t*)take(2097152); p.wvT = (bf16_t*)take(2097152); p.woT = (bf16_t*)take(2097152);
    p.l1T = (bf16_t*)take(384 * 1024 * 2); p.g2T = (bf16_t*)take(1024 * 128 * 2); p.w2T = (bf16_t*)take(2 * 65536 * 2); p.a2T = (bf16_t*)take(2 * 65536 * 2);
    p.wqkvT = (bf16_t*)take(1536 * 1024 * 2); p.atwoT = (bf16_t*)take(2097152);
    char* base = take(30 * U);
    char* RA = base, *RB = base + 12 * U, *RC = base + 20 * U, *RD = base + 23 * U, *RE = base + 25 * U, *RF = base + 26 * U;
    p.XM = (bf16_t*)RA;
    p.W0 = (float*)RA; p.W1 = (float*)(RA + 2 * U); p.AD0 = (bf16_t*)(RA + 4 * U); p.AD1 = (bf16_t*)(RA + 5 * U); p.KK = (float*)(RA + 6 * U);
    p.CW = (bf16_t*)RA;
    p.CM = (bf16_t*)RB; p.CN = (bf16_t*)(RB + 2 * U); p.CR = (bf16_t*)(RB + 4 * U); p.CY = (bf16_t*)(RB + 6 * U);
    p.HMID = (bf16_t*)RB; p.YE = (bf16_t*)(RB + (size_t)16 * MPAD0 * 2048 * 2);
    p.R = (bf16_t*)RC; p.K = (bf16_t*)(RC + U); p.V = (bf16_t*)(RC + 2 * U);
    p.Q = (bf16_t*)RC; p.O = (bf16_t*)(RC + (size_t)ROWS_LAT * DM * 2); p.KA = (bf16_t*)(RC + (size_t)2 * ROWS_LAT * DM * 2);
    p.VTL = p.KA + (size_t)ROWS * 256; p.VTC = p.VTL + (size_t)2 * 4 * 64 * TLAT;
    p.LH = (bf16_t*)RD; p.CS = (bf16_t*)RD; p.H2 = (bf16_t*)RD; p.HB = (bf16_t*)(RD + U);
    p.G = (bf16_t*)RE;
    p.Y0 = (float*)RF; p.Y1 = (float*)(RF + 2 * U); p.PRE = (float*)RF; p.X1 = (float*)(RF + 2 * U);
    p.XXB = nullptr;
    if (off > ws_size) fprintf(stderr, "workspace too small: need %zu have %zu\n", off, ws_size);

    static int grid_blocks = 0;
    if (!grid_blocks) {
        int dev = 0, cus = 0, per_cu = 0;
        hipGetDevice(&dev);
        hipDeviceGetAttribute(&cus, hipDeviceAttributeMultiprocessorCount, dev);
        hipOccupancyMaxActiveBlocksPerMultiprocessor(&per_cu, mk_forward, 2 * NTHR, 0);
        if (per_cu > 1) per_cu = 1;
        if (per_cu < 1) per_cu = 1;
        grid_blocks = cus * per_cu;
    }
#if MK_SINGLE
    hipMemsetAsync(p.bar, 0, 16384, stream);
    p.ph_lo = 0; p.ph_hi = N_PHASES - 1;
    void* args[] = {&p};
    hipError_t e = hipLaunchCooperativeKernel((void*)mk_forward, dim3(grid_blocks), dim3(2 * NTHR), args, 0, stream);
    if (e != hipSuccess) fprintf(stderr, "cooperative launch failed: %s (grid %d)\n", hipGetErrorString(e), grid_blocks);
#else
    for (int ph = 0; ph < N_PHASES; ++ph) {
        p.ph_lo = ph; p.ph_hi = ph;
        hipLaunchKernelGGL(mk_forward, dim3(grid_blocks), dim3(2 * NTHR), 0, stream, p);
    }
#endif
}
```

```cpp
#include <hip/hip_runtime.h>
#include <hip/hip_cooperative_groups.h>
#include <cstdio>
#include <cstdint>
namespace cg = cooperative_groups;

#ifndef MK_SINGLE
#define MK_SINGLE 1
#endif

typedef short bf16x8 __attribute__((ext_vector_type(8)));
typedef float f32x4 __attribute__((ext_vector_type(4)));
typedef unsigned short bf16_t;

#define DM 1024
#define TLAT 8192
#define LCTX 256
#define ROWS_LAT 16384
#define ROWS_CTX 512
#define ROWS 16896
#define NTHR 256
#define ALPHA_F 1.41421356237f
#define MPAD0 2176
#define MPAD1 2048

struct Params {
    const float *x, *c, *ctx, *c_ctx, *ada_w, *ada_b, *ln1_g, *ln1_b, *ln2_g, *ln2_b;
    const float *rw_mu, *rw_wr, *rw_wk, *rw_wv, *rw_w0, *rw_w1, *rw_w2, *rw_a0, *rw_a1, *rw_a2, *rw_g1, *rw_g2;
    const float *rw_kk, *rw_ka, *rw_rk, *rw_lnx_g, *rw_lnx_b, *rw_wo;
    const float *at_wqkv, *at_wo, *at_sink, *router_w, *moe_w_gate, *moe_w_up, *moe_w_down;
    float* out;
    unsigned* bar;
    float* modv;
    float* modp;
    float* rope;
    float* afft;
    int* inv;
    int* idx;
    float* gate;
    float* X1;
    float* PRE;
    bf16_t* HB;
    bf16_t* XXB;
    bf16_t* H2;
    bf16_t *R, *K, *V;
    float *KK, *W0, *W1;
    bf16_t *AD0, *AD1;
    bf16_t *CM, *CN, *CR, *CY, *CS;
    bf16_t* G;
    bf16_t* LH;
    float *Y0, *Y1;
    bf16_t* HMID;
    bf16_t* YE;
    bf16_t *Q, *KA, *VTL, *VTC, *O;
    bf16_t* XM;
    bf16_t *wrT, *wkT, *wvT, *woT, *l1T, *g2T, *w2T, *a2T, *wqkvT, *atwoT;
    bf16_t* CW;
    int ph_lo, ph_hi;
};

struct Ctx { int tid, bid, nb; };
typedef const __attribute__((address_space(4))) Params& PRef;
typedef const __attribute__((address_space(4))) Params* PPtr;
__device__ __forceinline__ unsigned short f2bf(float f) { return __builtin_bit_cast(unsigned short, (__bf16)f); }
__device__ __forceinline__ unsigned pack2(float lo, float hi) { typedef __bf16 bf2_t __attribute__((ext_vector_type(2))); bf2_t v; v[0] = (__bf16)lo; v[1] = (__bf16)hi; return __builtin_bit_cast(unsigned, v); }
__device__ __forceinline__ float bflo(unsigned u) { return __uint_as_float(u << 16); }
__device__ __forceinline__ float bfhi(unsigned u) { return __uint_as_float(u & 0xffff0000u); }
__device__ __forceinline__ float sigmoidf_(float v) { return __builtin_amdgcn_rcpf(1.f + __expf(-v)); }
__device__ __forceinline__ float shx(float v, int o, int lane) { return __int_as_float(__builtin_amdgcn_ds_bpermute((lane ^ o) << 2, __float_as_int(v))); }
__device__ __forceinline__ int shxi(int v, int o, int lane) { return __builtin_amdgcn_ds_bpermute((lane ^ o) << 2, v); }
__device__ __forceinline__ int shidx(int v, int src) { return __builtin_amdgcn_ds_bpermute(src << 2, v); }
template <int CTRL> __device__ __forceinline__ float dppf(float v) { return __int_as_float(__builtin_amdgcn_update_dpp(0, __float_as_int(v), CTRL, 0xF, 0xF, true)); }
__device__ __forceinline__ float dx1(float v) { return dppf<0xB1>(v); }
__device__ __forceinline__ float dx2(float v) { return dppf<0x4E>(v); }
__device__ __forceinline__ float dx4(float v) { return dppf<0x1B>(dppf<0x141>(v)); }
__device__ __forceinline__ float dx8(float v) { return dppf<0x128>(v); }
__device__ __forceinline__ float wsum_l(float v, int lane) {
    v += shx(v, 32, lane); v += shx(v, 16, lane);
    v += dx8(v); v += dx4(v); v += dx2(v); v += dx1(v);
    return v;
}
#define wsum(v) wsum_l((v), lane)
__device__ __forceinline__ int mod_of_row(int row) { return row < ROWS_LAT ? (row >> 13) : 2; }
__device__ __forceinline__ const float* xin_row(PRef p, int row) {
    return row < ROWS_LAT ? p.x + (size_t)row * DM : p.ctx + (size_t)(row - ROWS_LAT) * DM;
}

#define XB_TMO      128
#define XB_XCNT(j)  (256  + 64 * (j))
#define XB_XSUB(j)  (1280 + 64 * (j))
#define XB_XGEN(j)  (2304 + 64 * (j))
#define XB_TOP      3328
#define XB_TOPGEN   3392
#define XCD_BAR_WORDS 3456
#define XB_SPIN_CAP (1u << 22)
#define LAS __attribute__((address_space(3)))
__device__ __forceinline__ unsigned xb_ld(unsigned* p)              { return __hip_atomic_load(p, __ATOMIC_RELAXED, __HIP_MEMORY_SCOPE_AGENT); }
__device__ __forceinline__ unsigned xb_add(unsigned* p, unsigned v) { return __hip_atomic_fetch_add(p, v, __ATOMIC_RELAXED, __HIP_MEMORY_SCOPE_AGENT); }
__device__ __forceinline__ unsigned xb_xcc_id() { return (unsigned)__builtin_amdgcn_s_getreg((3 << 11) | 20) & 0xFu; }
#define XB_SPIN(cond, bar) do { unsigned _sp = 0; while (cond) { __builtin_amdgcn_s_sleep(1); \
    if ((++_sp & 255u) == 0u) { if (xb_ld(&(bar)[XB_TMO])) break; if (_sp > XB_SPIN_CAP) { atomicAdd(&(bar)[XB_TMO], 1u); break; } } } } while (0)
struct XcdBarrier { unsigned* bar; unsigned x; volatile unsigned* st; };
__device__ __forceinline__ XcdBarrier xcd_barrier_post(unsigned* bar, volatile unsigned* st) {
    XcdBarrier b; b.bar = bar; b.x = xb_xcc_id(); b.st = st;
    if (threadIdx.x == 0) (void)xb_add(&bar[XB_XCNT(b.x)], 1u);
    return b;
}
__device__ __forceinline__ void xcd_barrier_complete(unsigned* bar, unsigned x, unsigned& nloc, unsigned& nx) {
    const unsigned G = gridDim.x * gridDim.y * gridDim.z;
    unsigned sum, cnt, mine, sp = 0u;
    for (;;) {
        sum = 0u; cnt = 0u; mine = 0u;
#pragma unroll
        for (unsigned j = 0; j < 16; ++j) { const unsigned c = xb_ld(&bar[XB_XCNT(j)]); sum += c; cnt += (c > 0u) ? 1u : 0u; }
        mine = xb_ld(&bar[XB_XCNT(x)]);
        if (sum == G) break;
        __builtin_amdgcn_s_sleep(1);
        if ((++sp & 255u) == 0u) { if (xb_ld(&bar[XB_TMO])) break; if (sp > XB_SPIN_CAP) { atomicAdd(&bar[XB_TMO], 1u); break; } }
    }
    nloc = mine > 0u ? mine : 1u; nx = cnt > 0u ? cnt : 1u;
}
__device__ __forceinline__ void xcd_barrier(const XcdBarrier& b) {
    asm volatile("s_waitcnt vmcnt(0)" ::: "memory");
    __syncthreads();
    if (threadIdx.x == 0) {
        unsigned* bar = b.bar;
        __builtin_amdgcn_s_waitcnt(0);
        unsigned nloc = b.st[0], nx = b.st[1];
        if (nloc == 0u) { xcd_barrier_complete(bar, b.x, nloc, nx); b.st[0] = nloc; b.st[1] = nx; }
        const unsigned old = xb_add(&bar[XB_XSUB(b.x)], 1u);
        const unsigned gen = old / nloc;
        if (old + 1u == (gen + 1u) * nloc) {
            __builtin_amdgcn_fence(__ATOMIC_RELEASE, "agent");
            asm volatile("s_waitcnt vmcnt(0)" ::: "memory");
            const unsigned og = xb_add(&bar[XB_TOP], 1u);
            const unsigned tg = og / nx;
            if (og + 1u == (tg + 1u) * nx) xb_add(&bar[XB_TOPGEN], 1u);
            else XB_SPIN(xb_ld(&bar[XB_TOPGEN]) == tg, bar);
            __builtin_amdgcn_fence(__ATOMIC_ACQUIRE, "agent");
            xb_add(&bar[XB_XGEN(b.x)], 1u);
            asm volatile("s_waitcnt vmcnt(0)" ::: "memory");
        } else {
            XB_SPIN(xb_ld(&bar[XB_XGEN(b.x)]) == gen, bar);
            __builtin_amdgcn_fence(__ATOMIC_ACQUIRE, "agent");
            asm volatile("s_waitcnt vmcnt(0)" ::: "memory");
        }
    }
    __syncthreads();
}

#define G_BK 32
#define G_LDSROW 40
#define G_BUFB (128 * G_LDSROW * 2)
#define G_LDS_BYTES (4 * G_BUFB)

struct ALBf16 {
    struct Raw { uint4 a, b; };
    const bf16_t* rowp;
    __device__ __forceinline__ Raw ld(int k) const { Raw r; r.a = *(const uint4*)(rowp + k); r.b = *(const uint4*)(rowp + k + 8); return r; }
    __device__ __forceinline__ void cvt(const Raw& r, int k, uint4& lo, uint4& hi) const { lo = r.a; hi = r.b; }
};
struct ALMix {
    struct Raw { uint4 h0, h1, x0, x1; };
    const bf16_t *hp, *xp; const float* mu;
    __device__ __forceinline__ Raw ld(int k) const { Raw r; r.h0 = *(const uint4*)(hp + k); r.h1 = *(const uint4*)(hp + k + 8); r.x0 = *(const uint4*)(xp + k); r.x1 = *(const uint4*)(xp + k + 8); return r; }
    __device__ __forceinline__ unsigned mix2(unsigned h, unsigned x, float m0, float m1) const { return pack2(bflo(h) + bflo(x) * m0, bfhi(h) + bfhi(x) * m1); }
    __device__ __forceinline__ void cvt(const Raw& r, int k, uint4& lo, uint4& hi) const {
        const float4 m0 = *(const float4*)(mu + k), m1 = *(const float4*)(mu + k + 4), m2 = *(const float4*)(mu + k + 8), m3 = *(const float4*)(mu + k + 12);
        lo.x = mix2(r.h0.x, r.x0.x, m0.x, m0.y); lo.y = mix2(r.h0.y, r.x0.y, m0.z, m0.w); lo.z = mix2(r.h0.z, r.x0.z, m1.x, m1.y); lo.w = mix2(r.h0.w, r.x0.w, m1.z, m1.w);
        hi.x = mix2(r.h1.x, r.x1.x, m2.x, m2.y); hi.y = mix2(r.h1.y, r.x1.y, m2.z, m2.w); hi.z = mix2(r.h1.z, r.x1.z, m3.x, m3.y); hi.w = mix2(r.h1.w, r.x1.w, m3.z, m3.w);
    }
};

template <class AL, class EPI>
__device__ __forceinline__ void gemm_tile(const Ctx cx, const AL& al, const float* bp  , int ldb, int K, const EPI& epi, char* lds) {
    const int tid = cx.tid, lane = tid & 63, wid = tid >> 6, wr = wid >> 1, wc = wid & 1, fr = lane & 15, fq = lane >> 4;
    const int arow = tid >> 1, akq = (tid & 1) * 16;
    const int bn4 = (tid & 31) * 4, bk4 = (tid >> 5) * 4;
    f32x4 acc[4][4];
#pragma unroll
    for (int i = 0; i < 4; ++i)
#pragma unroll
        for (int j = 0; j < 4; ++j) acc[i][j] = (f32x4){0.f, 0.f, 0.f, 0.f};
    const int nk = K / G_BK;
    typename AL::Raw ra; float4 rb0, rb1, rb2, rb3;
    auto ldB = [&](int k0) {
        const float* q = bp + (size_t)(k0 + bk4) * ldb;
        rb0 = *(const float4*)(q); rb1 = *(const float4*)(q + ldb); rb2 = *(const float4*)(q + 2 * (size_t)ldb); rb3 = *(const float4*)(q + 3 * (size_t)ldb);
    };
    auto stage = [&](int buf, int k0) {
        char* As = lds + buf * 2 * G_BUFB; char* Bs = As + G_BUFB;
        uint4 lo, hi; al.cvt(ra, k0 + akq, lo, hi);
        *(uint4*)(As + arow * (G_LDSROW * 2) + akq * 2) = lo;
        *(uint4*)(As + arow * (G_LDSROW * 2) + akq * 2 + 16) = hi;
        uint2 w;
        w.x = pack2(rb0.x, rb1.x); w.y = pack2(rb2.x, rb3.x); *(uint2*)(Bs + (bn4 + 0) * (G_LDSROW * 2) + bk4 * 2) = w;
        w.x = pack2(rb0.y, rb1.y); w.y = pack2(rb2.y, rb3.y); *(uint2*)(Bs + (bn4 + 1) * (G_LDSROW * 2) + bk4 * 2) = w;
        w.x = pack2(rb0.z, rb1.z); w.y = pack2(rb2.z, rb3.z); *(uint2*)(Bs + (bn4 + 2) * (G_LDSROW * 2) + bk4 * 2) = w;
        w.x = pack2(rb0.w, rb1.w); w.y = pack2(rb2.w, rb3.w); *(uint2*)(Bs + (bn4 + 3) * (G_LDSROW * 2) + bk4 * 2) = w;
    };
    ra = al.ld(akq); ldB(0);
    stage(0, 0);
    __syncthreads();
    for (int kt = 0; kt < nk; ++kt) {
        const bool more = (kt + 1 < nk);
        if (more) { ra = al.ld((kt + 1) * G_BK + akq); ldB((kt + 1) * G_BK); }
        const char* As = lds + (kt & 1) * 2 * G_BUFB; const char* Bs = As + G_BUFB;
        bf16x8 af[4], bfr[4];
#pragma unroll
        for (int i = 0; i < 4; ++i) {
            af[i] = *(const bf16x8*)(As + (wr * 64 + i * 16 + fr) * (G_LDSROW * 2) + fq * 16);
            bfr[i] = *(const bf16x8*)(Bs + (wc * 64 + i * 16 + fr) * (G_LDSROW * 2) + fq * 16);
        }
#pragma unroll
        for (int i = 0; i < 4; ++i)
#pragma unroll
            for (int j = 0; j < 4; ++j) acc[i][j] = __builtin_amdgcn_mfma_f32_16x16x32_bf16(bfr[j], af[i], acc[i][j], 0, 0, 0);
        if (more) stage((kt + 1) & 1, (kt + 1) * G_BK);
        __syncthreads();
    }
    epi(acc, wr, wc, fr, fq);
}

#define G2_STAGE 32768
__device__ __forceinline__ void glds16(const bf16_t* g, char* l) {
    __builtin_amdgcn_global_load_lds((const unsigned*)g, (__attribute__((address_space(3))) unsigned*)l, 16, 0, 0);
}
template <class EPI>
__device__ __forceinline__ void gemm2_tile(const Ctx cx, const bf16_t* a0, const bf16_t* a1, const bf16_t* a2, const bf16_t* a3,
                                           const bf16_t* b0, const bf16_t* b1, const bf16_t* b2, const bf16_t* b3, int K, const EPI& epi, char* lds) {
    const int tid = cx.tid, lane = tid & 63, wid = __builtin_amdgcn_readfirstlane(tid >> 6), wr = wid >> 1, wc = wid & 1, fr = lane & 15, fq = lane >> 4;
    f32x4 acc[4][4];
#pragma unroll
    for (int i = 0; i < 4; ++i)
#pragma unroll
        for (int j = 0; j < 4; ++j) acc[i][j] = (f32x4){0.f, 0.f, 0.f, 0.f};
    const int nk = K >> 6;
    auto issue = [&](int kt, int st) {
        char* sa = lds + st * G2_STAGE + wid * 1024;
        const int ko = kt * 64;
        glds16(a0 + ko, sa); glds16(a1 + ko, sa + 4096); glds16(a2 + ko, sa + 8192); glds16(a3 + ko, sa + 12288);
        glds16(b0 + ko, sa + 16384); glds16(b1 + ko, sa + 20480); glds16(b2 + ko, sa + 24576); glds16(b3 + ko, sa + 28672);
    };
    issue(0, 0);
    asm volatile("s_waitcnt vmcnt(0)" ::: "memory");
    __builtin_amdgcn_s_barrier();
    for (int kt = 0; kt < nk; ++kt) {
        if (kt + 1 < nk) issue(kt + 1, (kt + 1) & 1);
        const char* As = lds + (kt & 1) * G2_STAGE; const char* Bs = As + 16384;
#pragma unroll
        for (int ks = 0; ks < 2; ++ks) {
            const int co = ((ks * 4 + fq) ^ (fr & 7)) << 4;
            bf16x8 af[4], bfr[4];
#pragma unroll
            for (int i = 0; i < 4; ++i) {
                af[i] = *(const bf16x8*)(As + (wr * 64 + i * 16 + fr) * 128 + co);
                bfr[i] = *(const bf16x8*)(Bs + (wc * 64 + i * 16 + fr) * 128 + co);
            }
#pragma unroll
            for (int i = 0; i < 4; ++i)
#pragma unroll
                for (int j = 0; j < 4; ++j) acc[i][j] = __builtin_amdgcn_mfma_f32_16x16x32_bf16(bfr[j], af[i], acc[i][j], 0, 0, 0);
        }
        asm volatile("s_waitcnt vmcnt(0) lgkmcnt(0)" ::: "memory");
        __builtin_amdgcn_s_barrier();
    }
    epi(acc, wr, wc, fr, fq);
}
#define G3_STAGE 16384
#define G3_H(q) ((0x1320 >> (4 * (q))) & 3)
#define G3_ROW(i) ((i) * 64 + (cx.tid >> 2))
#define G3_CH8 ((((cx.tid) & 3) ^ G3_H(((cx.tid) >> 4) & 3)) * 8)
struct G3Next { bool has; const bf16_t *a0, *a1, *b0, *b1; int K; };
template <class EPI>
__device__ __forceinline__ void gemm3_tile(const Ctx cx, const bf16_t* a0, const bf16_t* a1, const bf16_t* b0, const bf16_t* b1, int K, const EPI& epi, char* lds, bool pre = false, G3Next nx = G3Next{false, nullptr, nullptr, nullptr, nullptr, 0}) {
    const int tid = cx.tid, lane = tid & 63, wid = __builtin_amdgcn_readfirstlane(tid >> 6), wr = wid >> 1, wc = wid & 1, fr = lane & 15, fq = lane >> 4;
    f32x4 acc[4][4];
#pragma unroll
    for (int i = 0; i < 4; ++i)
#pragma unroll
        for (int j = 0; j < 4; ++j) acc[i][j] = (f32x4){0.f, 0.f, 0.f, 0.f};
    const int nk = K >> 5;
    auto issue = [&](int kt) {
        char* sa = lds + (kt & 3) * G3_STAGE + wid * 1024;
        const int ko = kt * 32;
        glds16(a0 + ko, sa); glds16(a1 + ko, sa + 4096); glds16(b0 + ko, sa + 8192); glds16(b1 + ko, sa + 12288);
    };
    if (!pre) { issue(0); if (nk > 1) issue(1); if (nk > 2) issue(2); }
    else asm volatile("s_waitcnt vmcnt(0)" ::: "memory");
    const int co = (fq ^ G3_H((fr >> 2) & 3)) << 4;
    for (int kt = 0; kt < nk; ++kt) {
        if (kt + 2 < nk) asm volatile("s_waitcnt vmcnt(8)" ::: "memory");
        else if (kt + 1 < nk) asm volatile("s_waitcnt vmcnt(4)" ::: "memory");
        else asm volatile("s_waitcnt vmcnt(0)" ::: "memory");
        asm volatile("s_waitcnt lgkmcnt(0)" ::: "memory");
        __builtin_amdgcn_s_barrier();
        if (kt + 3 < nk) issue(kt + 3);
        const char* As = lds + (kt & 3) * G3_STAGE; const char* Bs = As + 8192;
        bf16x8 af[4], bfr[4];
#pragma unroll
        for (int i = 0; i < 4; ++i) {
            af[i] = *(const bf16x8*)(As + (wr * 64 + i * 16 + fr) * 64 + co);
            bfr[i] = *(const bf16x8*)(Bs + (wc * 64 + i * 16 + fr) * 64 + co);
        }
#pragma unroll
        for (int i = 0; i < 4; ++i)
#pragma unroll
            for (int j = 0; j < 4; ++j) acc[i][j] = __builtin_amdgcn_mfma_f32_16x16x32_bf16(bfr[j], af[i], acc[i][j], 0, 0, 0);
    }
    asm volatile("s_waitcnt lgkmcnt(0)" ::: "memory");
    __builtin_amdgcn_s_barrier();
    if (nx.has) {
        const int nkn = nx.K >> 5;
#pragma unroll
        for (int st = 0; st < 3; ++st) if (st < nkn) {
            char* sa = lds + st * G3_STAGE + wid * 1024; const int ko = st * 32;
            glds16(nx.a0 + ko, sa); glds16(nx.a1 + ko, sa + 4096); glds16(nx.b0 + ko, sa + 8192); glds16(nx.b1 + ko, sa + 12288);
        }
    }
    epi(acc, wr, wc, fr, fq);
}
#define G8_HTB 16384
typedef __attribute__((address_space(3))) unsigned char* G8LP;
__device__ __forceinline__ int g8_lds_byte(int r, int c) { const int st = (r >> 4) * 2 + (c >> 5), rr = r & 15, cc = c & 31, ob = rr * 64 + cc * 2; return st * 1024 + (ob ^ (((ob >> 9) & 1) << 5)); }
__device__ __forceinline__ void g8_stage_rc(int b, int& R, int& C) { const int st = b / 1024, sb = b % 1024, swz = sb ^ (((sb >> 9) & 1) << 5); R = (st >> 1) * 16 + swz / 64; C = (st & 1) * 32 + (swz % 64) / 2; }
struct Unit8 { int pm, pn, e; };
__device__ __forceinline__ int fresh_zero() { int z = 0; asm volatile("" : "+v"(z)); return z; }
__device__ __forceinline__ int fresh_lane() { int l; asm volatile("v_mbcnt_lo_u32_b32 %0, -1, 0\n\tv_mbcnt_hi_u32_b32 %0, -1, %0" : "=v"(l)); return l; }
template <class P>
__device__ __forceinline__ void gemm8(const Ctx px, char* ldsg, const P& prob) {
    G8LP lds = (G8LP)ldsg;
    const int tid = px.tid, wid = __builtin_amdgcn_readfirstlane(tid >> 6), lane = tid & 63, wr = wid >> 2, wc = wid & 3, fr = lane & 15, fq = lane >> 4;
    const int nt = prob.K / 64;
    int R0, C0, R1, C1; g8_stage_rc(tid * 16, R0, C0); g8_stage_rc(tid * 16 + 8192, R1, C1);
    Unit8 cur, nxt; int ui = 0;
    if (!prob.next(0, cur)) return;
    unsigned cA[2][2], cB[2][2], nA[2][2], nB[2][2];
#define G8_OFFS(u, oa, ob) do { _Pragma("unroll") for (int h_ = 0; h_ < 2; ++h_) { \
        oa[h_][0] = prob.offA(u, h_ * 128 + R0) + (unsigned)C0 * 2u; oa[h_][1] = prob.offA(u, h_ * 128 + R1) + (unsigned)C1 * 2u; \
        ob[h_][0] = prob.offB(u, h_ * 128 + R0) + (unsigned)C0 * 2u; ob[h_][1] = prob.offB(u, h_ * 128 + R1) + (unsigned)C1 * 2u; } } while (0)
    G8_OFFS(cur, cA, cB);
    const char* bAc = prob.baseA(cur); const char* bBc = prob.baseB(cur);
    const unsigned ldsw = (unsigned)wid * 1024u;
    const int aoff = g8_lds_byte(wr * 64 + fr, fq * 8), boff = g8_lds_byte(wc * 32 + fr, fq * 8);
#define G8_SA(b, h) (((b) * 2 + (h)) * G8_HTB)
#define G8_SB(b, h) ((4 + (b) * 2 + (h)) * G8_HTB)
#define G8_STAGE(bufoff, gbase, voff, kb) do { _Pragma("unroll") for (int _i = 0; _i < 2; ++_i) \
        __builtin_amdgcn_global_load_lds((const unsigned*)((gbase) + (size_t)((voff)[_i] + (unsigned)(kb))), (__attribute__((address_space(3))) unsigned*)(lds + (bufoff) + ldsw + _i * 8192), 16, 0, 0); } while (0)
#define G8_LDA(dst, b, h) do { _Pragma("unroll") for (int m = 0; m < 4; ++m) _Pragma("unroll") for (int k = 0; k < 2; ++k) dst[m][k] = *(const __attribute__((address_space(3))) bf16x8*)(lds + G8_SA(b, h) + aoff + m * 2048 + k * 1024); } while (0)
#define G8_LDB(dst, b, h) do { _Pragma("unroll") for (int n = 0; n < 2; ++n) _Pragma("unroll") for (int k = 0; k < 2; ++k) dst[n][k] = *(const __attribute__((address_space(3))) bf16x8*)(lds + G8_SB(b, h) + boff + n * 2048 + k * 1024); } while (0)
#define G8_MMA(ai, bj, At, Bt) do { __builtin_amdgcn_s_setprio(1); _Pragma("unroll") for (int m = 0; m < 4; ++m) _Pragma("unroll") for (int n = 0; n < 2; ++n) _Pragma("unroll") for (int k = 0; k < 2; ++k) \
        acc[ai][bj][m][n] = __builtin_amdgcn_mfma_f32_16x16x32_bf16(Bt[n][k], At[m][k], acc[ai][bj][m][n], 0, 0, 0); __builtin_amdgcn_s_setprio(0); } while (0)
#define G8_WAIT_V(n) asm volatile("s_waitcnt vmcnt(" #n ")" ::: "memory")
#define G8_WAIT_L(n) asm volatile("s_waitcnt lgkmcnt(" #n ")" ::: "memory")
#define G8_BAR __builtin_amdgcn_s_barrier()
#define G8_SCHED __builtin_amdgcn_sched_barrier(0)
    f32x4 acc[2][2][4][2];
#pragma unroll
    for (int a = 0; a < 2; ++a)
#pragma unroll
        for (int b = 0; b < 2; ++b)
#pragma unroll
            for (int m = 0; m < 4; ++m)
#pragma unroll
                for (int n = 0; n < 2; ++n) acc[a][b][m][n] = (f32x4){0.f, 0.f, 0.f, 0.f};
    bf16x8 At[4][2], B0[2][2], B1[2][2];
    G8_STAGE(G8_SB(0, 0), bBc, cB[0], 0); G8_STAGE(G8_SA(0, 0), bAc, cA[0], 0); G8_STAGE(G8_SB(0, 1), bBc, cB[1], 0); G8_STAGE(G8_SA(0, 1), bAc, cA[1], 0);
    if (wr == 1) G8_BAR;
    G8_WAIT_V(4); G8_BAR;
    G8_STAGE(G8_SB(1, 0), bBc, cB[0], 128); G8_STAGE(G8_SA(1, 0), bAc, cA[0], 128); G8_STAGE(G8_SB(1, 1), bBc, cB[1], 128);
    G8_WAIT_V(6); G8_BAR;
    for (;;) {
        const bool has_next = prob.next(ui + 1, nxt);
        const char* bAn = bAc; const char* bBn = bBc;
        if (has_next) { G8_OFFS(nxt, nA, nB); bAn = prob.baseA(nxt); bBn = prob.baseB(nxt); }
        else {
#pragma unroll
            for (int h_ = 0; h_ < 2; ++h_) { nA[h_][0] = cA[h_][0]; nA[h_][1] = cA[h_][1]; nB[h_][0] = cB[h_][0]; nB[h_][1] = cB[h_][1]; }
        }
        for (int t = 0; t < nt; t += 2) {
            const bool last = (t == nt - 2);
            const unsigned k1 = (unsigned)(t + 1) * 128u;
            const char* a2b = last ? bAn : bAc; const char* b2b = last ? bBn : bBc;
            const unsigned k2 = last ? 0u : (unsigned)(t + 2) * 128u, k3 = k2 + 128u;
            unsigned a2o0[2], a2o1[2], b2o0[2], b2o1[2];
            a2o0[0] = last ? nA[0][0] : cA[0][0]; a2o0[1] = last ? nA[0][1] : cA[0][1]; a2o1[0] = last ? nA[1][0] : cA[1][0]; a2o1[1] = last ? nA[1][1] : cA[1][1];
            b2o0[0] = last ? nB[0][0] : cB[0][0]; b2o0[1] = last ? nB[0][1] : cB[0][1]; b2o1[0] = last ? nB[1][0] : cB[1][0]; b2o1[1] = last ? nB[1][1] : cB[1][1];
            G8_LDB(B0, 0, 0); G8_SCHED; G8_LDA(At, 0, 0); G8_STAGE(G8_SA(1, 1), bAc, cA[1], k1);
            G8_WAIT_L(8); G8_BAR; G8_WAIT_L(0); G8_MMA(0, 0, At, B0); G8_BAR; G8_SCHED;
            G8_LDB(B1, 0, 1); G8_STAGE(G8_SB(0, 0), b2b, b2o0, k2);
            G8_BAR; G8_WAIT_L(0); G8_MMA(0, 1, At, B1); G8_BAR;
            G8_LDA(At, 0, 1); G8_STAGE(G8_SA(0, 0), a2b, a2o0, k2);
            G8_BAR; G8_WAIT_L(0); G8_MMA(1, 0, At, B0); G8_BAR; G8_SCHED;
            G8_STAGE(G8_SB(0, 1), b2b, b2o1, k2);
            G8_WAIT_V(6); G8_BAR; G8_MMA(1, 1, At, B1); G8_BAR;
            G8_LDB(B0, 1, 0); G8_SCHED; G8_LDA(At, 1, 0); G8_STAGE(G8_SA(0, 1), a2b, a2o1, k2);
            G8_WAIT_L(8); G8_BAR; G8_WAIT_L(0); G8_MMA(0, 0, At, B0); G8_BAR; G8_SCHED;
            G8_LDB(B1, 1, 1); G8_STAGE(G8_SB(1, 0), b2b, b2o0, k3);
            G8_BAR; G8_WAIT_L(0); G8_MMA(0, 1, At, B1); G8_BAR;
            G8_LDA(At, 1, 1); G8_STAGE(G8_SA(1, 0), a2b, a2o0, k3);
            G8_BAR; G8_WAIT_L(0); G8_MMA(1, 0, At, B0); G8_BAR; G8_SCHED;
            G8_STAGE(G8_SB(1, 1), b2b, b2o1, k3);
            G8_WAIT_V(6); G8_BAR; G8_MMA(1, 1, At, B1); G8_BAR;
        }
        { const int le = fresh_lane(); prob.epi(acc, cur, wr, wc, le & 15, le >> 4); }
        if (!has_next) break;
#pragma unroll
        for (int a = 0; a < 2; ++a)
#pragma unroll
            for (int b = 0; b < 2; ++b)
#pragma unroll
                for (int m = 0; m < 4; ++m)
#pragma unroll
                    for (int n = 0; n < 2; ++n) acc[a][b][m][n] = (f32x4){0.f, 0.f, 0.f, 0.f};
        cur = nxt; bAc = bAn; bBc = bBn; ++ui;
#pragma unroll
        for (int h_ = 0; h_ < 2; ++h_) { cA[h_][0] = nA[h_][0]; cA[h_][1] = nA[h_][1]; cB[h_][0] = nB[h_][0]; cB[h_][1] = nB[h_][1]; }
    }
    G8_WAIT_V(0);
    if (wr == 0) G8_BAR;
    G8_BAR;
#undef G8_OFFS
#undef G8_SA
#undef G8_SB
#undef G8_STAGE
#undef G8_LDA
#undef G8_LDB
#undef G8_MMA
#undef G8_WAIT_V
#undef G8_WAIT_L
#undef G8_BAR
#undef G8_SCHED
}
struct ProbOproj {
    const bf16_t* A; const bf16_t* Wt; float* out; const float* xl; const float* modl; int K; int c, G;
    __device__ __forceinline__ bool next(int i, Unit8& u) const { const int L = i * G + c; if (L >= 256) return false; const int x = L & 7, j = L >> 3; u.pn = j >> 3; u.pm = 8 * x + (j & 7); u.e = 0; return true; }
    __device__ __forceinline__ const char* baseA(const Unit8& u) const { return (const char*)(A + (size_t)u.pm * 256 * DM); }
    __device__ __forceinline__ const char* baseB(const Unit8& u) const { return (const char*)(Wt + (size_t)u.pn * 256 * 1024); }
    __device__ __forceinline__ unsigned offA(const Unit8&, int row) const { return (unsigned)row * (DM * 2); }
    __device__ __forceinline__ unsigned offB(const Unit8&, int rho) const { return (unsigned)rho * 2048u; }
    __device__ __forceinline__ void epi(const f32x4 (&acc)[2][2][4][2], const Unit8& u, int wr, int wc, int fr, int fq) const {
#pragma unroll
        for (int ai = 0; ai < 2; ++ai)
#pragma unroll
            for (int m = 0; m < 4; ++m) {
                const int row = u.pm * 256 + ai * 128 + wr * 64 + m * 16 + fr;
                const float* xr = xl + (size_t)row * DM;
                const float* gt = modl + (size_t)(row >> 13) * 6144 + 2 * 1024;
#pragma unroll
                for (int bj = 0; bj < 2; ++bj)
#pragma unroll
                    for (int n = 0; n < 2; ++n) {
                        const int col = u.pn * 256 + bj * 128 + wc * 32 + n * 16 + 4 * fq;
                        const f32x4 xv = *(const f32x4*)(xr + col), gv = *(const f32x4*)(gt + col);
                        f32x4 o;
#pragma unroll
                        for (int r = 0; r < 4; ++r) o[r] = ALPHA_F * xv[r] + gv[r] * acc[ai][bj][m][n][r];
                        *(f32x4*)(out + (size_t)row * DM + col) = o;
                    }
            }
    }
};
struct ProbRKV {
    PPtr p; int K; int c, G;
    __device__ __forceinline__ bool next(int i, Unit8& u) const { const int L = i * G + c; if (L >= 768) return false; const int cc = L & 255, x = cc & 7, j = cc >> 3; u.pn = (L >> 8) * 4 + (j >> 3); u.pm = 8 * x + (j & 7); u.e = 0; return true; }
    __device__ __forceinline__ const char* baseA(const Unit8& u) const { const int g = u.pn >> 2; const int msel = g == 0 ? 0 : (g == 1 ? 2 : 3); return (const char*)(p->XM + ((size_t)msel * ROWS + (size_t)u.pm * 256) * DM); }
    __device__ __forceinline__ const char* baseB(const Unit8& u) const { const int g = u.pn >> 2; const bf16_t* w = g == 0 ? p->wrT : (g == 1 ? p->wkT : p->wvT); return (const char*)(w + (size_t)(u.pn & 3) * 256 * 1024); }
    __device__ __forceinline__ unsigned offA(const Unit8&, int row) const { return (unsigned)row * 2048u; }
    __device__ __forceinline__ unsigned offB(const Unit8&, int rho) const { const int bj = rho >> 7, wc = (rho >> 5) & 3, w = rho & 31; return (unsigned)(64 * wc + 32 * bj + w) * 2048u; }
    __device__ __forceinline__ void epi(const f32x4 (&acc)[2][2][4][2], const Unit8& u, int wr, int wc, int fr, int fq) const {
        const int g = u.pn >> 2, lane = fr + 16 * fq;
        const int cb = (u.pn & 3) * 256 + 64 * wc + 4 * fq;
        bf16_t* out = g == 0 ? p->R : (g == 1 ? p->K : p->V);
#pragma unroll
        for (int ai = 0; ai < 2; ++ai)
#pragma unroll
            for (int m = 0; m < 4; ++m) {
                const int row = u.pm * 256 + ai * 128 + wr * 64 + m * 16 + fr;
                if (g != 1) {
#pragma unroll
                    for (int bj = 0; bj < 2; ++bj)
#pragma unroll
                        for (int n = 0; n < 2; ++n) {
                            uint2 o; o.x = pack2(acc[ai][bj][m][n][0], acc[ai][bj][m][n][1]); o.y = pack2(acc[ai][bj][m][n][2], acc[ai][bj][m][n][3]);
                            *(uint2*)(out + (size_t)row * DM + cb + 32 * bj + 16 * n) = o;
                        }
                } else {
                    f32x4 kv[2][2]; float ss = 0.f;
#pragma unroll
                    for (int bj = 0; bj < 2; ++bj)
#pragma unroll
                        for (int n = 0; n < 2; ++n) {
                            const int col = cb + 32 * bj + 16 * n;
                            const f32x4 kw = *(const f32x4*)(p->rw_kk + col);
                            uint2 o; o.x = pack2(acc[ai][bj][m][n][0], acc[ai][bj][m][n][1]); o.y = pack2(acc[ai][bj][m][n][2], acc[ai][bj][m][n][3]);
                            *(uint2*)(out + (size_t)row * DM + col) = o;
                            f32x4 t; t[0] = bflo(o.x) * kw[0]; t[1] = bfhi(o.x) * kw[1]; t[2] = bflo(o.y) * kw[2]; t[3] = bfhi(o.y) * kw[3];
                            kv[bj][n] = t; ss += (t[0] * t[0] + t[1] * t[1]) + (t[2] * t[2] + t[3] * t[3]);
                        }
                    ss += shx(ss, 16, lane); ss += shx(ss, 32, lane);
                    const float inv = fminf(__builtin_amdgcn_rsqf(ss), 1e12f);
#pragma unroll
                    for (int bj = 0; bj < 2; ++bj)
#pragma unroll
                        for (int n = 0; n < 2; ++n) *(f32x4*)(p->KK + (size_t)row * DM + cb + 32 * bj + 16 * n) = kv[bj][n] * inv;
                }
            }
    }
};
struct ProbQKV {
    PPtr p; int K; int c, G;
    __device__ __forceinline__ bool next(int i, Unit8& u) const { const int L = i * G + c; if (L >= 384) return false; const int cc = L & 255, x = cc & 7, j = cc >> 3; u.pn = (L >> 8) * 4 + (j >> 3); u.pm = 8 * x + (j & 7); u.e = 0; return true; }
    __device__ __forceinline__ const char* baseA(const Unit8& u) const { return (const char*)(p->HB + (size_t)u.pm * 256 * DM); }
    __device__ __forceinline__ const char* baseB(const Unit8& u) const { return (const char*)(p->wqkvT + (size_t)u.pn * 256 * 1024); }
    __device__ __forceinline__ unsigned offA(const Unit8&, int row) const { return (unsigned)row * 2048u; }
    __device__ __forceinline__ unsigned offB(const Unit8&, int rho) const { const int bj = rho >> 7, wc = (rho >> 5) & 3, w = rho & 31; return (unsigned)(64 * wc + 32 * bj + w) * 2048u; }
    __device__ __forceinline__ void epi(const f32x4 (&acc)[2][2][4][2], const Unit8& u, int wr, int wc, int fr, int fq) const {
        const int hs = u.pn * 4 + wc;
#pragma unroll
        for (int ai = 0; ai < 2; ++ai)
#pragma unroll
            for (int m = 0; m < 4; ++m) {
                const int row = u.pm * 256 + ai * 128 + wr * 64 + m * 16 + fr;
                const int t = row & (TLAT - 1), b = row >> 13;
                if (hs < 20) {
                    f32x4 v0 = acc[ai][0][m][0], v1 = acc[ai][0][m][1], v2 = acc[ai][1][m][0], v3 = acc[ai][1][m][1];
                    const int rp = t >> 6, cp = t & 63;
#pragma unroll
                    for (int r = 0; r < 4; ++r) {
                        const int fi = 4 * fq + r;
                        const float2 cr = *(const float2*)(p->rope + 2 * (rp * 16 + fi)), cc = *(const float2*)(p->rope + 2 * (cp * 16 + fi));
                        const float a = v0[r], bb = v1[r]; v0[r] = a * cr.x - bb * cr.y; v1[r] = bb * cr.x + a * cr.y;
                        const float c2 = v2[r], d2 = v3[r]; v2[r] = c2 * cc.x - d2 * cc.y; v3[r] = d2 * cc.x + c2 * cc.y;
                    }
                    const float sc = hs < 16 ? 0.125f : 1.f;
                    bf16_t* dst = hs < 16 ? p->Q + (size_t)row * DM + hs * 64 + 4 * fq : p->KA + (size_t)row * 256 + (hs - 16) * 64 + 4 * fq;
                    uint2 o;
                    o.x = pack2(v0[0] * sc, v0[1] * sc); o.y = pack2(v0[2] * sc, v0[3] * sc); *(uint2*)(dst) = o;
                    o.x = pack2(v1[0] * sc, v1[1] * sc); o.y = pack2(v1[2] * sc, v1[3] * sc); *(uint2*)(dst + 16) = o;
                    o.x = pack2(v2[0] * sc, v2[1] * sc); o.y = pack2(v2[2] * sc, v2[3] * sc); *(uint2*)(dst + 32) = o;
                    o.x = pack2(v3[0] * sc, v3[1] * sc); o.y = pack2(v3[2] * sc, v3[3] * sc); *(uint2*)(dst + 48) = o;
                } else {
                    bf16_t* vt = p->VTL + (size_t)(b * 4 + (hs - 20)) * 64 * TLAT + t;
#pragma unroll
                    for (int bj = 0; bj < 2; ++bj)
#pragma unroll
                        for (int n = 0; n < 2; ++n)
#pragma unroll
                            for (int r = 0; r < 4; ++r) vt[(size_t)(32 * bj + 16 * n + 4 * fq + r) * TLAT] = f2bf(acc[ai][bj][m][n][r]);
                }
            }
    }
};
struct ProbUp {
    PPtr p; int K; int c, G; int layer;
    __device__ __forceinline__ bool next(int i, Unit8& u) const { const int L = i * G + c; if (L >= 2048) return false; const int cc = L & 255, x = cc & 7, j = cc >> 3; u.e = (L >> 8) * 2 + (x >> 2); u.pn = 4 * (x & 3) + (j & 3); u.pm = j >> 2; return true; }
    __device__ __forceinline__ const char* baseA(const Unit8&) const { return (const char*)p->H2; }
    __device__ __forceinline__ const char* baseB(const Unit8& u) const { return (const char*)(p->CW + (size_t)(layer * 16 + u.e) * 3 * 2097152); }
    __device__ __forceinline__ unsigned offA(const Unit8& u, int row) const { const int src = p->idx[u.e * MPAD0 + u.pm * 256 + row]; return (unsigned)src * 2048u; }
    __device__ __forceinline__ unsigned offB(const Unit8& u, int rho) const { const int bj = rho >> 7, wc = (rho >> 5) & 3, n = (rho >> 4) & 1, cc = rho & 15; return (unsigned)n * 4194304u + (unsigned)(128 * u.pn + 64 * bj + 16 * wc + cc) * 2048u; }
    __device__ __forceinline__ void epi(const f32x4 (&acc)[2][2][4][2], const Unit8& u, int wr, int wc, int fr, int fq) const {
        bf16_t* out = p->HMID + (size_t)u.e * MPAD0 * 2048;
#pragma unroll
        for (int ai = 0; ai < 2; ++ai)
#pragma unroll
            for (int m = 0; m < 4; ++m) {
                const int slot = u.pm * 256 + ai * 128 + wr * 64 + m * 16 + fr;
#pragma unroll
                for (int bj = 0; bj < 2; ++bj) {
                    float v[4];
#pragma unroll
                    for (int r = 0; r < 4; ++r) { const float a = acc[ai][bj][m][0][r], uu = acc[ai][bj][m][1][r]; v[r] = a * sigmoidf_(a) * uu; }
                    uint2 o; o.x = pack2(v[0], v[1]); o.y = pack2(v[2], v[3]);
                    *(uint2*)(out + (size_t)slot * 2048 + 128 * u.pn + 64 * bj + 16 * wc + 4 * fq) = o;
                }
            }
    }
};
struct ProbDown {
    PPtr p; int K; int c, G; int layer;
    __device__ __forceinline__ bool next(int i, Unit8& u) const { const int L = i * G + c; if (L >= 512) return false; const int cc = L & 255, x = cc & 7, j = cc >> 3; u.e = (L >> 8) * 8 + x; u.pn = j & 3; u.pm = j >> 2; return true; }
    __device__ __forceinline__ const char* baseA(const Unit8& u) const { return (const char*)(p->HMID + ((size_t)u.e * MPAD0 + (size_t)u.pm * 256) * 2048); }
    __device__ __forceinline__ const char* baseB(const Unit8& u) const { return (const char*)(p->CW + ((size_t)(layer * 16 + u.e) * 3 + 2) * 2097152 + (size_t)u.pn * 256 * 2048); }
    __device__ __forceinline__ unsigned offA(const Unit8&, int row) const { return (unsigned)row * 4096u; }
    __device__ __forceinline__ unsigned offB(const Unit8&, int rho) const { return (unsigned)rho * 4096u; }
    __device__ __forceinline__ void epi(const f32x4 (&acc)[2][2][4][2], const Unit8& u, int wr, int wc, int fr, int fq) const {
        bf16_t* out = p->YE + (size_t)u.e * MPAD0 * DM;
#pragma unroll
        for (int ai = 0; ai < 2; ++ai)
#pragma unroll
            for (int m = 0; m < 4; ++m) {
                const int slot = u.pm * 256 + ai * 128 + wr * 64 + m * 16 + fr;
                const float g = p->gate[u.e * MPAD0 + slot];
#pragma unroll
                for (int bj = 0; bj < 2; ++bj)
#pragma unroll
                    for (int n = 0; n < 2; ++n) {
                        uint2 o; o.x = pack2(acc[ai][bj][m][n][0] * g, acc[ai][bj][m][n][1] * g); o.y = pack2(acc[ai][bj][m][n][2] * g, acc[ai][bj][m][n][3] * g);
                        *(uint2*)(out + (size_t)slot * DM + u.pn * 256 + bj * 128 + wc * 32 + n * 16 + 4 * fq) = o;
                    }
            }
    }
};
__device__ __forceinline__ void conv_tile(const Ctx cx, const float* src, int ldn, bf16_t* dst, int ldk, int k0, int n0, char* lds, bool valid) {
    bf16_t* T = (bf16_t*)lds;
    const int tid = cx.tid;
    {
        const int k4 = (tid >> 4) * 4, n4 = (tid & 15) * 4;
        const float* q = src + (size_t)(k0 + k4) * ldn + n0 + n4;
        float4 r0 = make_float4(0.f, 0.f, 0.f, 0.f), r1 = r0, r2 = r0, r3 = r0;
        if (valid) { r0 = *(const float4*)q; r1 = *(const float4*)(q + ldn); r2 = *(const float4*)(q + 2 * (size_t)ldn); r3 = *(const float4*)(q + 3 * (size_t)ldn); }
        uint2 w;
        w.x = pack2(r0.x, r1.x); w.y = pack2(r2.x, r3.x); *(uint2*)(T + (n4 + 0) * 72 + k4) = w;
        w.x = pack2(r0.y, r1.y); w.y = pack2(r2.y, r3.y); *(uint2*)(T + (n4 + 1) * 72 + k4) = w;
        w.x = pack2(r0.z, r1.z); w.y = pack2(r2.z, r3.z); *(uint2*)(T + (n4 + 2) * 72 + k4) = w;
        w.x = pack2(r0.w, r1.w); w.y = pack2(r2.w, r3.w); *(uint2*)(T + (n4 + 3) * 72 + k4) = w;
    }
    __syncthreads();
    {
        const int n = tid >> 2, kc = (tid & 3) * 16;
        const uint4 u0 = *(const uint4*)(T + n * 72 + kc), u1 = *(const uint4*)(T + n * 72 + kc + 8);
        bf16_t* d = dst + (size_t)(n0 + n) * ldk + k0 + kc;
        if (valid) { *(uint4*)d = u0; *(uint4*)(d + 8) = u1; }
    }
    __syncthreads();
}
struct Conv4Regs { float4 r[4][4]; };
__device__ __forceinline__ void conv4_load(const Ctx cx, Conv4Regs& R, const float* src, int ldn, int k0, int n0, bool valid) {
    const int tid = cx.tid, k4 = (tid >> 4) * 4, n4 = (tid & 15) * 4;
#pragma unroll
    for (int s4 = 0; s4 < 4; ++s4) {
        const float* q = src + (size_t)(k0 + k4) * ldn + n0 + 64 * s4 + n4;
        if (valid) { R.r[s4][0] = *(const float4*)q; R.r[s4][1] = *(const float4*)(q + ldn); R.r[s4][2] = *(const float4*)(q + 2 * (size_t)ldn); R.r[s4][3] = *(const float4*)(q + 3 * (size_t)ldn); }
        else { R.r[s4][0] = R.r[s4][1] = R.r[s4][2] = R.r[s4][3] = make_float4(0.f, 0.f, 0.f, 0.f); }
    }
}
__device__ __forceinline__ void conv4_finish(const Ctx cx, const Conv4Regs& R, bf16_t* dst, int ldk, int k0, int n0, char* lds, bool valid) {
    const int tid = cx.tid, k4 = (tid >> 4) * 4, n4 = (tid & 15) * 4;
#pragma unroll
    for (int s4 = 0; s4 < 4; ++s4) {
        bf16_t* T = (bf16_t*)lds + s4 * (64 * 72);
        uint2 w;
        w.x = pack2(R.r[s4][0].x, R.r[s4][1].x); w.y = pack2(R.r[s4][2].x, R.r[s4][3].x); *(uint2*)(T + (n4 + 0) * 72 + k4) = w;
        w.x = pack2(R.r[s4][0].y, R.r[s4][1].y); w.y = pack2(R.r[s4][2].y, R.r[s4][3].y); *(uint2*)(T + (n4 + 1) * 72 + k4) = w;
        w.x = pack2(R.r[s4][0].z, R.r[s4][1].z); w.y = pack2(R.r[s4][2].z, R.r[s4][3].z); *(uint2*)(T + (n4 + 2) * 72 + k4) = w;
        w.x = pack2(R.r[s4][0].w, R.r[s4][1].w); w.y = pack2(R.r[s4][2].w, R.r[s4][3].w); *(uint2*)(T + (n4 + 3) * 72 + k4) = w;
    }
    __syncthreads();
    {
        const int n = tid >> 2, kc = (tid & 3) * 16;
#pragma unroll
        for (int s4 = 0; s4 < 4; ++s4) {
            const bf16_t* T = (const bf16_t*)lds + s4 * (64 * 72);
            const uint4 u0 = *(const uint4*)(T + n * 72 + kc), u1 = *(const uint4*)(T + n * 72 + kc + 8);
            bf16_t* d = dst + (size_t)(n0 + 64 * s4 + n) * ldk + k0 + kc;
            if (valid) { *(uint4*)d = u0; *(uint4*)(d + 8) = u1; }
        }
    }
    __syncthreads();
}
__device__ __forceinline__ void conv_tile_w(int lane, const float* src, int ldn, bf16_t* dst, int ldk, int k0, int n0, bf16_t* T) {
    const int n4 = (lane & 15) * 4, kq = lane >> 4;
    float4 r[4][4];
#pragma unroll
    for (int i = 0; i < 4; ++i) {
        const float* q = src + (size_t)(k0 + (kq + 4 * i) * 4) * ldn + n0 + n4;
        r[i][0] = *(const float4*)q; r[i][1] = *(const float4*)(q + ldn); r[i][2] = *(const float4*)(q + 2 * (size_t)ldn); r[i][3] = *(const float4*)(q + 3 * (size_t)ldn);
    }
#pragma unroll
    for (int i = 0; i < 4; ++i) {
        const int k4 = (kq + 4 * i) * 4;
        uint2 w;
        w.x = pack2(r[i][0].x, r[i][1].x); w.y = pack2(r[i][2].x, r[i][3].x); *(uint2*)(T + (n4 + 0) * 72 + k4) = w;
        w.x = pack2(r[i][0].y, r[i][1].y); w.y = pack2(r[i][2].y, r[i][3].y); *(uint2*)(T + (n4 + 1) * 72 + k4) = w;
        w.x = pack2(r[i][0].z, r[i][1].z); w.y = pack2(r[i][2].z, r[i][3].z); *(uint2*)(T + (n4 + 2) * 72 + k4) = w;
        w.x = pack2(r[i][0].w, r[i][1].w); w.y = pack2(r[i][2].w, r[i][3].w); *(uint2*)(T + (n4 + 3) * 72 + k4) = w;
    }
    asm volatile("s_waitcnt lgkmcnt(0)" ::: "memory");
    bf16_t* d = dst + (size_t)(n0 + lane) * ldk + k0;
#pragma unroll
    for (int j = 0; j < 8; ++j) { const uint4 u = *(const uint4*)(T + lane * 72 + 8 * j); *(uint4*)(d + 8 * j) = u; }
    asm volatile("s_waitcnt lgkmcnt(0)" ::: "memory");
}
__device__ __forceinline__ void conv_moe_w(PRef p, int lane, int cw, int ncw, bf16_t* T) {
    for (int t = cw; t < 2 * 16 * 3 * 512; t += ncw) {
        const int le = t / 1536, rem = t % 1536, mat = rem >> 9, tl = rem & 511;
        const float* src = (mat == 0 ? p.moe_w_gate : (mat == 1 ? p.moe_w_up : p.moe_w_down)) + (size_t)le * 2097152;
        bf16_t* dst = p.CW + ((size_t)le * 3 + mat) * 2097152;
        const int K = mat == 2 ? 2048 : 1024, N = mat == 2 ? 1024 : 2048;
        const int nn = N >> 6, nt = tl % nn, kt = tl / nn;
        conv_tile_w(lane, src, N, dst, K, kt * 64, nt * 64, T);
    }
}
__device__ __forceinline__ void conv_small(const Ctx cx, PRef p, char* lds, int t_lo, int t_hi, int cid, int cnb) {
    const int ntl = t_hi - t_lo;
    const int trips = (ntl - (cid & ~1) + cnb - 1) / cnb;
    for (int it = 0; it < trips; ++it) {
        const int t0 = cid + it * cnb; const bool valid = t0 < ntl; const int t = t_lo + (valid ? t0 : 0);
        const float* src; bf16_t* dst; int K, N, tl;
        if (t < 768) { const int w = t >> 8; tl = t & 255; src = w == 0 ? p.rw_wr : (w == 1 ? p.rw_wk : p.rw_wv); dst = w == 0 ? p.wrT : (w == 1 ? p.wkT : p.wvT); K = 1024; N = 1024; }
        else if (t < 800) { tl = t - 768; src = p.rw_g1; dst = p.l1T; K = 1024; N = 128; }
        else if (t < 832) { const int d = (t - 800) >> 4; tl = (t - 800) & 15; src = p.rw_w1 + (size_t)d * 65536; dst = p.l1T + (size_t)(128 + 64 * d) * 1024; K = 1024; N = 64; }
        else if (t < 864) { const int d = (t - 832) >> 4; tl = (t - 832) & 15; src = p.rw_a1 + (size_t)d * 65536; dst = p.l1T + (size_t)(256 + 64 * d) * 1024; K = 1024; N = 64; }
        else if (t < 896) { tl = t - 864; src = p.rw_g2; dst = p.g2T; K = 128; N = 1024; }
        else if (t < 928) { const int d = (t - 896) >> 4; tl = (t - 896) & 15; src = p.rw_w2 + (size_t)d * 65536; dst = p.w2T + (size_t)d * 65536; K = 64; N = 1024; }
        else if (t < 960) { const int d = (t - 928) >> 4; tl = (t - 928) & 15; src = p.rw_a2 + (size_t)d * 65536; dst = p.a2T + (size_t)d * 65536; K = 64; N = 1024; }
        else if (t < 1216) { tl = t - 960; src = p.rw_wo; dst = p.woT; K = 1024; N = 1024; }
        else if (t < 1600) { tl = t - 1216; src = p.at_wqkv; dst = p.wqkvT; K = 1024; N = 1536; }
        else { tl = t - 1600; src = p.at_wo; dst = p.atwoT; K = 1024; N = 1024; }
        const int nn = N >> 6, nt = tl % nn, kt = tl / nn;
        conv_tile(cx, src, N, dst, K, kt * 64, nt * 64, lds, valid);
    }
}
__device__ __forceinline__ void conv_moe(const Ctx cx, PRef p, char* lds, int cid, int cnb) {
    const int NTL = 2 * 16 * 3 * 128;
    const int trips = (NTL - (cid & ~1) + cnb - 1) / cnb;
#define CONV_DESC(t0_, valid_, src_, dst_, K_, N_, k0_, n0_) \
        const bool valid_ = (t0_) < NTL; const int tq_##valid_ = valid_ ? (t0_) : 0; \
        const int le_##valid_ = tq_##valid_ / 384, rem_##valid_ = tq_##valid_ % 384, mat_##valid_ = rem_##valid_ >> 7, tl_##valid_ = rem_##valid_ & 127; \
        const float* src_ = (mat_##valid_ == 0 ? p.moe_w_gate : (mat_##valid_ == 1 ? p.moe_w_up : p.moe_w_down)) + (size_t)le_##valid_ * 2097152; \
        bf16_t* dst_ = p.CW + ((size_t)le_##valid_ * 3 + mat_##valid_) * 2097152; \
        const int K_ = mat_##valid_ == 2 ? 2048 : 1024, N_ = mat_##valid_ == 2 ? 1024 : 2048; \
        const int k0_ = (tl_##valid_ / (N_ >> 8)) * 64, n0_ = (tl_##valid_ % (N_ >> 8)) * 256
    Conv4Regs Ra, Rb;
    { CONV_DESC(cid, v0, s0, d0, K0, N0, k00, n00); (void)d0; (void)K0; conv4_load(cx, Ra, s0, N0, k00, n00, v0); }
    for (int it = 0; it < trips; it += 2) {
        { CONV_DESC(cid + (it + 1) * cnb, v1, s1, d1, K1, N1, k01, n01); (void)d1; (void)K1; conv4_load(cx, Rb, s1, N1, k01, n01, v1 && (it + 1 < trips)); }
        { CONV_DESC(cid + it * cnb, v2, s2, d2, K2, N2, k02, n02); (void)s2; (void)N2; conv4_finish(cx, Ra, d2, K2, k02, n02, lds, v2); }
        if (it + 1 < trips) {
            { CONV_DESC(cid + (it + 2) * cnb, v3, s3, d3, K3, N3, k03, n03); (void)d3; (void)K3; conv4_load(cx, Ra, s3, N3, k03, n03, v3 && (it + 2 < trips)); }
            { CONV_DESC(cid + (it + 1) * cnb, v4, s4, d4, K4, N4, k04, n04); (void)s4; (void)N4; conv4_finish(cx, Rb, d4, K4, k04, n04, lds, v4); }
        }
    }
#undef CONV_DESC
}
__device__ __forceinline__ void ph_ada(const Ctx cx, PRef p, char* ldsc) {
    float* sv = (float*)ldsc;
    for (int i = cx.tid; i < 3072; i += NTHR) {
        const int s = i >> 10, k = i & 1023;
        const float v = (s < 2) ? p.c[s * 1024 + k] : p.c_ctx[k];
        sv[i] = v / (1.f + __expf(-v));
    }
    __syncthreads();
    const int lane = cx.tid & 63, gw = (cx.bid * NTHR + cx.tid) >> 6, nw = (cx.nb * NTHR) >> 6;
    for (int item = gw; item < 3072; item += nw) {
        const int ks = item & 15, ch = (item >> 4) % 96, l = item / (16 * 96), n0 = ch * 64, kb = ks * 64;
        const float* w = p.ada_w + (size_t)l * 1024 * 6144 + n0 + lane;
        float a0 = 0.f, a1 = 0.f, a2 = 0.f;
#pragma unroll 32
        for (int k = 0; k < 64; ++k) {
            const float wv = w[(size_t)(kb + k) * 6144];
            a0 += wv * sv[kb + k]; a1 += wv * sv[1024 + kb + k]; a2 += wv * sv[2048 + kb + k];
        }
        float* mo = p.modp + ((size_t)ks * 6 + l * 3) * 6144 + n0 + lane;
        mo[0] = a0; mo[6144] = a1; mo[2 * 6144] = a2;
    }
    for (int i = cx.bid * NTHR + cx.tid; i < 128 * 16; i += cx.nb * NTHR) {
        const int pos = i >> 4, fi = i & 15;
        const float th = __builtin_amdgcn_exp2f(-(float)fi * (13.287712379549449f / 16.0f));
        const float t2 = th * th;
        float cs = 1.f - t2 * (0.5f - t2 * (1.f / 24.f - t2 * (1.f / 720.f - t2 * (1.f / 40320.f - t2 * (1.f / 3628800.f)))));
        float sn = th * (1.f - t2 * (1.f / 6.f - t2 * (1.f / 120.f - t2 * (1.f / 5040.f - t2 * (1.f / 362880.f - t2 * (1.f / 39916800.f))))));
        float rc = 1.f, rs = 0.f;
#pragma unroll
        for (int bb = 0; bb < 7; ++bb) {
            if ((pos >> bb) & 1) { const float nc = rc * cs - rs * sn, ns = rc * sn + rs * cs; rc = nc; rs = ns; }
            const float c2 = cs * cs - sn * sn, s2 = 2.f * cs * sn; cs = c2; sn = s2;
        }
        p.rope[2 * i] = rc; p.rope[2 * i + 1] = rs;
    }
    __syncthreads();
    conv_small(cx, p, ldsc, 0, 960, cx.bid, cx.nb);
}
__device__ __forceinline__ void ph_pre0(const Ctx cx, PRef p) {
    const int col = cx.tid * 4;
    for (int i = cx.bid * NTHR + cx.tid; i < 2 * 3 * 6144; i += cx.nb * NTHR) {
        float v = p.ada_b[(i / (3 * 6144)) * 6144 + i % 6144];
#pragma unroll
        for (int ks = 0; ks < 16; ++ks) v += p.modp[(size_t)ks * 36864 + i];
        p.modv[i] = v;
    }
    float4 sh0, sh1, sh2, sc0, sc1, sc2;
#define PRE0_RED(S3, SH, SC) do { float4 a = *(const float4*)(p.ada_b + col), b = *(const float4*)(p.ada_b + 1024 + col); \
        _Pragma("unroll") for (int ks = 0; ks < 16; ++ks) { \
            const float4 pa = *(const float4*)(p.modp + (size_t)ks * 36864 + (S3) * 6144 + col), pb = *(const float4*)(p.modp + (size_t)ks * 36864 + (S3) * 6144 + 1024 + col); \
            a.x += pa.x; a.y += pa.y; a.z += pa.z; a.w += pa.w; b.x += pb.x; b.y += pb.y; b.z += pb.z; b.w += pb.w; } \
        SH = a; SC = b; } while (0)
    PRE0_RED(0, sh0, sc0); PRE0_RED(1, sh1, sc1); PRE0_RED(2, sh2, sc2);
#undef PRE0_RED
    for (int r0 = cx.bid * 4; r0 < ROWS; r0 += cx.nb * 4) {
        const int s = mod_of_row(r0);
        const int t0 = r0 < ROWS_LAT ? (r0 & (TLAT - 1)) : ((r0 - ROWS_LAT) & (LCTX - 1));
        const int len = r0 < ROWS_LAT ? TLAT : LCTX;
        const float4 sh = s == 0 ? sh0 : (s == 1 ? sh1 : sh2), sc = s == 0 ? sc0 : (s == 1 ? sc1 : sc2);
        const float* xr = xin_row(p, r0);
        float4 xv[6];
#pragma unroll
        for (int j = 0; j < 6; ++j) {
            const int t = t0 - 1 + j;
            xv[j] = make_float4(0.f, 0.f, 0.f, 0.f);
            if (t >= 0 && t < len) xv[j] = *(const float4*)(xr + (ptrdiff_t)(j - 1) * DM + col);
        }
        float4 mu[6];
#pragma unroll
        for (int m = 0; m < 6; ++m) mu[m] = *(const float4*)(p.rw_mu + m * 1024 + col);
        float hv[6][4];
#pragma unroll
        for (int j = 0; j < 6; ++j) {
            const int t = t0 - 1 + j; const bool in = (t >= 0 && t < len);
            hv[j][0] = in ? xv[j].x * (1.f + sc.x) + sh.x : 0.f; hv[j][1] = in ? xv[j].y * (1.f + sc.y) + sh.y : 0.f;
            hv[j][2] = in ? xv[j].z * (1.f + sc.z) + sh.z : 0.f; hv[j][3] = in ? xv[j].w * (1.f + sc.w) + sh.w : 0.f;
        }
#pragma unroll
        for (int rr = 0; rr < 4; ++rr) {
            float h[4], xx[4];
#pragma unroll
            for (int i = 0; i < 4; ++i) { h[i] = hv[rr + 1][i]; xx[i] = 0.5f * (hv[rr][i] + hv[rr + 2][i]) - h[i]; }
#pragma unroll
            for (int m = 0; m < 6; ++m) {
                uint2 o; o.x = pack2(h[0] + xx[0] * mu[m].x, h[1] + xx[1] * mu[m].y); o.y = pack2(h[2] + xx[2] * mu[m].z, h[3] + xx[3] * mu[m].w);
                *(uint2*)(p.XM + ((size_t)m * ROWS + r0 + rr) * DM + col) = o;
            }
        }
    }
}

struct EpiF32 {
    float* out; int ld, m0, n0;
    __device__ __forceinline__ void operator()(const f32x4 (&acc)[4][4], int wr, int wc, int fr, int fq) const {
#pragma unroll
        for (int i = 0; i < 4; ++i)
#pragma unroll
            for (int j = 0; j < 4; ++j) {
                const int row = m0 + wr * 64 + i * 16 + fr, col = n0 + wc * 64 + j * 16 + 4 * fq;
                *(f32x4*)(out + (size_t)row * ld + col) = acc[i][j];
            }
    }
};
struct EpiBf {
    bf16_t* out; int ld, m0, n0;
    __device__ __forceinline__ void operator()(const f32x4 (&acc)[4][4], int wr, int wc, int fr, int fq) const {
#pragma unroll
        for (int i = 0; i < 4; ++i)
#pragma unroll
            for (int j = 0; j < 4; ++j) {
                const int row = m0 + wr * 64 + i * 16 + fr, col = n0 + wc * 64 + j * 16 + 4 * fq;
                uint2 o; o.x = pack2(acc[i][j][0], acc[i][j][1]); o.y = pack2(acc[i][j][2], acc[i][j][3]);
                *(uint2*)(out + (size_t)row * ld + col) = o;
            }
    }
};
struct EpiK {
    bf16_t* out; float* kk; const float* k_k; int m0, n0;
    __device__ __forceinline__ void operator()(const f32x4 (&acc)[4][4], int wr, int wc, int fr, int fq) const {
        const int lane = fr + 16 * fq;
#pragma unroll
        for (int i = 0; i < 4; ++i) {
            const int row = m0 + wr * 64 + i * 16 + fr;
            f32x4 kv[4]; float ss = 0.f;
#pragma unroll
            for (int j = 0; j < 4; ++j) {
                const int col = n0 + wc * 64 + j * 16 + 4 * fq;
                const f32x4 kw = *(const f32x4*)(k_k + col);
                uint2 o; o.x = pack2(acc[i][j][0], acc[i][j][1]); o.y = pack2(acc[i][j][2], acc[i][j][3]);
                *(uint2*)(out + (size_t)row * DM + col) = o;
                kv[j][0] = bflo(o.x) * kw[0]; kv[j][1] = bfhi(o.x) * kw[1]; kv[j][2] = bflo(o.y) * kw[2]; kv[j][3] = bfhi(o.y) * kw[3];
                ss += (kv[j][0] * kv[j][0] + kv[j][1] * kv[j][1]) + (kv[j][2] * kv[j][2] + kv[j][3] * kv[j][3]);
            }
            ss += shx(ss, 16, lane); ss += shx(ss, 32, lane);
            const float inv = fminf(__builtin_amdgcn_rsqf(ss), 1e12f);
#pragma unroll
            for (int j = 0; j < 4; ++j) {
                const int col = n0 + wc * 64 + j * 16 + 4 * fq;
                *(f32x4*)(kk + (size_t)row * DM + col) = kv[j] * inv;
            }
        }
    }
};
struct EpiLH {
    bf16_t* out; int m0, coff, act;
    __device__ __forceinline__ void operator()(const f32x4 (&acc)[4][4], int wr, int wc, int fr, int fq) const {
#pragma unroll
        for (int i = 0; i < 4; ++i)
#pragma unroll
            for (int j = 0; j < 4; ++j) {
                const int row = m0 + wr * 64 + i * 16 + fr, col = wc * 64 + j * 16 + 4 * fq;
                float v[4];
#pragma unroll
                for (int r = 0; r < 4; ++r) { const float a = acc[i][j][r]; v[r] = act == 0 ? sigmoidf_(a) : (act == 1 ? (1.f - 2.f * __builtin_amdgcn_rcpf(1.f + __expf(2.f * a))) : a); }
                uint2 o; o.x = pack2(v[0], v[1]); o.y = pack2(v[2], v[3]);
                *(uint2*)(out + (size_t)row * 384 + coff + col) = o;
            }
    }
};
struct EpiG2 {
    bf16_t* outb; float* outf; const float* bias; int m0, n0, kind;
    __device__ __forceinline__ void operator()(const f32x4 (&acc)[4][4], int wr, int wc, int fr, int fq) const {
#pragma unroll
        for (int i = 0; i < 4; ++i)
#pragma unroll
            for (int j = 0; j < 4; ++j) {
                const int row = m0 + wr * 64 + i * 16 + fr, col = n0 + wc * 64 + j * 16 + 4 * fq;
                if (kind == 0) {
                    uint2 o; o.x = pack2(acc[i][j][0], acc[i][j][1]); o.y = pack2(acc[i][j][2], acc[i][j][3]);
                    *(uint2*)(outb + (size_t)row * DM + col) = o;
                } else if (kind == 2) {
                    const float4 b = *(const float4*)(bias + col);
                    uint2 o; o.x = pack2(sigmoidf_(b.x + acc[i][j][0]), sigmoidf_(b.y + acc[i][j][1])); o.y = pack2(sigmoidf_(b.z + acc[i][j][2]), sigmoidf_(b.w + acc[i][j][3]));
                    *(uint2*)(outb + (size_t)row * DM + col) = o;
                } else {
                    const float4 b = *(const float4*)(bias + col);
                    const float bv[4] = {b.x, b.y, b.z, b.w};
                    f32x4 o;
#pragma unroll
                    for (int r = 0; r < 4; ++r) {
                        const float s = sigmoidf_(bv[r] + acc[i][j][r]);
                        o[r] = kind == 1 ? __expf(-0.606531f * s) : s;
                    }
                    *(f32x4*)(outf + (size_t)row * DM + col) = o;
                }
            }
    }
};
struct EpiResid {
    float* out; const float* xl; const float* xc; const float* modl; int m0, n0;
    __device__ __forceinline__ void operator()(const f32x4 (&acc)[4][4], int wr, int wc, int fr, int fq) const {
#pragma unroll
        for (int i = 0; i < 4; ++i) {
            const int row = m0 + wr * 64 + i * 16 + fr;
            const float* xr = row < ROWS_LAT ? xl + (size_t)row * DM : xc + (size_t)(row - ROWS_LAT) * DM;
            const float* gt = modl + (size_t)mod_of_row(row) * 6144 + 2 * 1024;
#pragma unroll
            for (int j = 0; j < 4; ++j) {
                const int col = n0 + wc * 64 + j * 16 + 4 * fq;
                const f32x4 xv = *(const f32x4*)(xr + col), gv = *(const f32x4*)(gt + col);
                f32x4 o;
#pragma unroll
                for (int r = 0; r < 4; ++r) o[r] = ALPHA_F * xv[r] + gv[r] * acc[i][j][r];
                *(f32x4*)(out + (size_t)row * DM + col) = o;
            }
        }
    }
};
struct EpiSwiGLU {
    bf16_t* out; int m0, j0;
    __device__ __forceinline__ void operator()(const f32x4 (&acc)[4][4], int wr, int wc, int fr, int fq) const {
#pragma unroll
        for (int i = 0; i < 4; ++i) {
            const int row = m0 + wr * 64 + i * 16 + fr;
#pragma unroll
            for (int j = 0; j < 2; ++j) {
                const int col = j0 + wc * 32 + j * 16 + 4 * fq;
                float v[4];
#pragma unroll
                for (int r = 0; r < 4; ++r) { const float a = acc[i][j][r], u = acc[i][j + 2][r]; v[r] = a * sigmoidf_(a) * u; }
                uint2 o; o.x = pack2(v[0], v[1]); o.y = pack2(v[2], v[3]);
                *(uint2*)(out + (size_t)row * 2048 + col) = o;
            }
        }
    }
};
struct EpiDown {
    bf16_t* out; const float* gate; int m0, n0;
    __device__ __forceinline__ void operator()(const f32x4 (&acc)[4][4], int wr, int wc, int fr, int fq) const {
#pragma unroll
        for (int i = 0; i < 4; ++i) {
            const int row = m0 + wr * 64 + i * 16 + fr;
            const float g = gate[row];
#pragma unroll
            for (int j = 0; j < 4; ++j) {
                const int col = n0 + wc * 64 + j * 16 + 4 * fq;
                uint2 o; o.x = pack2(acc[i][j][0] * g, acc[i][j][1] * g); o.y = pack2(acc[i][j][2] * g, acc[i][j][3] * g);
                *(uint2*)(out + (size_t)row * DM + col) = o;
            }
        }
    }
};
struct EpiQKV {
    PPtr p; int m0, n0;
    __device__ __forceinline__ void operator()(const f32x4 (&acc)[4][4], int wr, int wc, int fr, int fq) const {
        const int hs = (n0 + wc * 64) >> 6;
#pragma unroll
        for (int i = 0; i < 4; ++i) {
            const int row = m0 + wr * 64 + i * 16 + fr;
            const bool lat = row < ROWS_LAT;
            if (hs < 20) {
                f32x4 v0 = acc[i][0], v1 = acc[i][1], v2 = acc[i][2], v3 = acc[i][3];
                if (lat) {
                    const int t = row & (TLAT - 1), rp = t >> 6, cp = t & 63;
#pragma unroll
                    for (int r = 0; r < 4; ++r) {
                        const int fi = 4 * fq + r;
                        const float2 cr = *(const float2*)(p->rope + 2 * (rp * 16 + fi)), cc = *(const float2*)(p->rope + 2 * (cp * 16 + fi));
                        const float a = v0[r], b = v1[r]; v0[r] = a * cr.x - b * cr.y; v1[r] = b * cr.x + a * cr.y;
                        const float c2 = v2[r], d2 = v3[r]; v2[r] = c2 * cc.x - d2 * cc.y; v3[r] = d2 * cc.x + c2 * cc.y;
                    }
                }
                if (hs < 16) {
                    if (lat) {
                        bf16_t* q = p->Q + (size_t)row * DM + hs * 64 + 4 * fq;
                        uint2 o;
                        o.x = pack2(v0[0] * 0.125f, v0[1] * 0.125f); o.y = pack2(v0[2] * 0.125f, v0[3] * 0.125f); *(uint2*)(q) = o;
                        o.x = pack2(v1[0] * 0.125f, v1[1] * 0.125f); o.y = pack2(v1[2] * 0.125f, v1[3] * 0.125f); *(uint2*)(q + 16) = o;
                        o.x = pack2(v2[0] * 0.125f, v2[1] * 0.125f); o.y = pack2(v2[2] * 0.125f, v2[3] * 0.125f); *(uint2*)(q + 32) = o;
                        o.x = pack2(v3[0] * 0.125f, v3[1] * 0.125f); o.y = pack2(v3[2] * 0.125f, v3[3] * 0.125f); *(uint2*)(q + 48) = o;
                    }
                } else {
                    bf16_t* k = p->KA + (size_t)row * 256 + (hs - 16) * 64 + 4 * fq;
                    uint2 o;
                    o.x = pack2(v0[0], v0[1]); o.y = pack2(v0[2], v0[3]); *(uint2*)(k) = o;
                    o.x = pack2(v1[0], v1[1]); o.y = pack2(v1[2], v1[3]); *(uint2*)(k + 16) = o;
                    o.x = pack2(v2[0], v2[1]); o.y = pack2(v2[2], v2[3]); *(uint2*)(k + 32) = o;
                    o.x = pack2(v3[0], v3[1]); o.y = pack2(v3[2], v3[3]); *(uint2*)(k + 48) = o;
                }
            } else {
                const int hk = hs - 20;
                bf16_t* vt; int ldt, t;
                if (lat) { const int b = row >> 13; t = row & (TLAT - 1); vt = p->VTL + (size_t)(b * 4 + hk) * 64 * TLAT; ldt = TLAT; }
                else { const int rr = row - ROWS_LAT, b = rr >> 8; t = rr & (LCTX - 1); vt = p->VTC + (size_t)(b * 4 + hk) * 64 * LCTX; ldt = LCTX; }
#pragma unroll
                for (int j = 0; j < 4; ++j)
#pragma unroll
                    for (int r = 0; r < 4; ++r) vt[(size_t)(j * 16 + 4 * fq + r) * ldt + t] = f2bf(acc[i][j][r]);
            }
        }
    }
};

__device__ __forceinline__ void ph_g1(const Ctx cx, PRef p, char* lds) {
    for (int tile = cx.bid; tile < 96 + 396; tile += cx.nb) {
        int mt, nt;
        if (tile < 96) { mt = 128 + tile / 24; nt = tile % 24; } else { const int t2 = tile - 96; mt = t2 / 3; nt = 24 + t2 % 3; }
        const int m0 = mt * 128;
        int msel, n0; const bf16_t* Bt;
        if (nt < 24) { const int gsel = nt >> 3; n0 = (nt & 7) * 128; msel = gsel == 0 ? 0 : (gsel == 1 ? 2 : 3); Bt = (gsel == 0 ? p.wrT : (gsel == 1 ? p.wkT : p.wvT)) + (size_t)n0 * 1024; }
        else { const int q = nt - 24; n0 = 0; msel = q == 0 ? 5 : (q == 1 ? 1 : 4); Bt = p.l1T + (size_t)q * 128 * 1024; }
        const bf16_t* A = p.XM + ((size_t)msel * ROWS + m0) * DM + G3_CH8;
        const bf16_t* B = Bt + G3_CH8;
        if (nt < 24) {
            const int gsel = nt >> 3;
            if (gsel == 1) {
                EpiK epi; epi.out = p.K; epi.kk = p.KK; epi.k_k = p.rw_kk; epi.m0 = m0; epi.n0 = n0;
                gemm3_tile(cx, A + (size_t)G3_ROW(0) * DM, A + (size_t)G3_ROW(1) * DM,
                           B + (size_t)G3_ROW(0) * 1024, B + (size_t)G3_ROW(1) * 1024, 1024, epi, lds);
            } else {
                EpiBf epi; epi.out = gsel == 0 ? p.R : p.V; epi.ld = DM; epi.m0 = m0; epi.n0 = n0;
                gemm3_tile(cx, A + (size_t)G3_ROW(0) * DM, A + (size_t)G3_ROW(1) * DM,
                           B + (size_t)G3_ROW(0) * 1024, B + (size_t)G3_ROW(1) * 1024, 1024, epi, lds);
            }
        } else {
            const int q = nt - 24;
            EpiLH epi; epi.out = p.LH; epi.m0 = m0; epi.coff = q * 128; epi.act = q;
            gemm3_tile(cx, A + (size_t)G3_ROW(0) * DM, A + (size_t)G3_ROW(1) * DM,
                       B + (size_t)G3_ROW(0) * 1024, B + (size_t)G3_ROW(1) * 1024, 1024, epi, lds);
        }
    }
}
__device__ __forceinline__ void ph_g2(const Ctx cx, PRef p, char* lds) {
#define G2_DESC(tile_, A_, B_, K_, epi_) \
        const int mt_##A_ = (tile_) / 40, rem_##A_ = (tile_) % 40, gsel_##A_ = rem_##A_ >> 3, n0_##A_ = (rem_##A_ & 7) * 128, m0_##A_ = mt_##A_ * 128; \
        const bf16_t* A_; const bf16_t* B_; int K_; EpiG2 epi_; epi_.m0 = m0_##A_; epi_.n0 = n0_##A_; epi_.outb = nullptr; epi_.outf = nullptr; epi_.bias = nullptr; \
        if (gsel_##A_ == 0) { A_ = p.LH; B_ = p.g2T + (size_t)n0_##A_ * 128; K_ = 128; epi_.kind = 0; epi_.outb = p.G; } \
        else if (gsel_##A_ <= 2) { const int d = gsel_##A_ - 1; A_ = p.LH + 128 + 64 * d; B_ = p.w2T + (size_t)d * 65536 + (size_t)n0_##A_ * 64; K_ = 64; epi_.kind = 1; epi_.outf = d ? p.W1 : p.W0; epi_.bias = p.rw_w0 + d * 1024; } \
        else { const int d = gsel_##A_ - 3; A_ = p.LH + 256 + 64 * d; B_ = p.a2T + (size_t)d * 65536 + (size_t)n0_##A_ * 64; K_ = 64; epi_.kind = 2; epi_.outb = d ? p.AD1 : p.AD0; epi_.bias = p.rw_a0 + d * 1024; } \
        A_ += (size_t)m0_##A_ * 384 + G3_CH8; B_ += G3_CH8
    bool pre = false;
    for (int tile = cx.bid; tile < 132 * 40; tile += cx.nb) {
        G2_DESC(tile, A, B, K, epi);
        const int tn = tile + cx.nb; const bool hn = tn < 132 * 40;
        G2_DESC(hn ? tn : tile, An, Bn, Kn, epin); (void)epin;
        G3Next nx; nx.has = hn; nx.a0 = An + (size_t)G3_ROW(0) * 384; nx.a1 = An + (size_t)G3_ROW(1) * 384; nx.b0 = Bn + (size_t)G3_ROW(0) * Kn; nx.b1 = Bn + (size_t)G3_ROW(1) * Kn; nx.K = Kn;
        gemm3_tile(cx, A + (size_t)G3_ROW(0) * 384, A + (size_t)G3_ROW(1) * 384,
                   B + (size_t)G3_ROW(0) * K, B + (size_t)G3_ROW(1) * K, K, epi, lds, pre, nx);
        pre = hn;
    }
#undef G2_DESC
}
__device__ __forceinline__ void ph_prep(const Ctx cx, PRef p) { (void)cx; (void)p; }
#define NCHUNK 132
#define CH_ROW 72
#define L_AT 0
#define L_BT 9216
#define L_KT 18432
#define L_RT 27648
#define L_BH 36864
#define L_KH 46080
#define L_VT 55296
#define L_AAB 64512
#define L_PC 80896
#define L_X2 L_AT
#define L_UT L_KT
#define L_WT L_KH
#define S1_LDS_BYTES (80896 + 256)
__device__ __forceinline__ void chunk_rows(int b, int dir, int n, int& rbase, int& sgn) {
    sgn = dir ? -1 : 1;
    if (n < 4) { const int t0 = 64 * n; rbase = ROWS_LAT + b * LCTX + (dir ? (LCTX - 1 - t0) : t0); }
    else { const int t0 = 64 * (n - 4); rbase = b * TLAT + (dir ? (TLAT - 1 - t0) : t0); }
}
__device__ __forceinline__ bf16x8 pack8(const f32x4& a, const f32x4& b) {
    uint4 u; u.x = pack2(a[0], a[1]); u.y = pack2(a[2], a[3]); u.z = pack2(b[0], b[1]); u.w = pack2(b[2], b[3]);
    return *(bf16x8*)&u;
}
__device__ __forceinline__ void mm64(f32x4 (&acc)[4][4], const bf16_t* X, const bf16_t* Y, int l15, int g) {
    bf16x8 yf[4][2];
#pragma unroll
    for (int yt = 0; yt < 4; ++yt) { yf[yt][0] = *(const bf16x8*)(Y + (16 * yt + l15) * CH_ROW + 8 * g); yf[yt][1] = *(const bf16x8*)(Y + (16 * yt + l15) * CH_ROW + 32 + 8 * g); }
#pragma unroll
    for (int xt = 0; xt < 4; ++xt) {
        const bf16x8 x0 = *(const bf16x8*)(X + (16 * xt + l15) * CH_ROW + 8 * g), x1 = *(const bf16x8*)(X + (16 * xt + l15) * CH_ROW + 32 + 8 * g);
#pragma unroll
        for (int yt = 0; yt < 4; ++yt) {
            acc[xt][yt] = __builtin_amdgcn_mfma_f32_16x16x32_bf16(x0, yf[yt][0], acc[xt][yt], 0, 0, 0);
            acc[xt][yt] = __builtin_amdgcn_mfma_f32_16x16x32_bf16(x1, yf[yt][1], acc[xt][yt], 0, 0, 0);
        }
    }
}
__device__ __forceinline__ void mm64_accB(f32x4 (&out)[4][4], const bf16_t* X, const f32x4 (&acc)[4][4], int l15, int g) {
#pragma unroll
    for (int js = 0; js < 2; ++js) {
        bf16x8 bfr[4];
#pragma unroll
        for (int tt = 0; tt < 4; ++tt) bfr[tt] = pack8(acc[2 * js][tt], acc[2 * js + 1][tt]);
#pragma unroll
        for (int xt = 0; xt < 4; ++xt) {
            const bf16_t* xp = X + (16 * xt + l15) * CH_ROW + 32 * js + 4 * g;
            const uint2 lo = *(const uint2*)xp, hi = *(const uint2*)(xp + 16);
            uint4 u; u.x = lo.x; u.y = lo.y; u.z = hi.x; u.w = hi.y;
            const bf16x8 af = *(bf16x8*)&u;
#pragma unroll
            for (int tt = 0; tt < 4; ++tt) out[xt][tt] = __builtin_amdgcn_mfma_f32_16x16x32_bf16(af, bfr[tt], out[xt][tt], 0, 0, 0);
        }
    }
}
__device__ __forceinline__ void zero44(f32x4 (&a)[4][4]) {
#pragma unroll
    for (int i = 0; i < 4; ++i)
#pragma unroll
        for (int j = 0; j < 4; ++j) a[i][j] = (f32x4){0.f, 0.f, 0.f, 0.f};
}
__device__ __forceinline__ void mask44(f32x4 (&a)[4][4], int l15, int g, bool strict) {
#pragma unroll
    for (int jt = 0; jt < 4; ++jt)
#pragma unroll
        for (int tt = 0; tt < 4; ++tt)
#pragma unroll
            for (int r = 0; r < 4; ++r) {
                const int j = 16 * jt + 4 * g + r, t = 16 * tt + l15;
                const bool keep = strict ? (j < t) : (j <= t);
                a[jt][tt][r] = keep ? a[jt][tt][r] : 0.f;
            }
}
__host__ __device__ constexpr int fsub_qp(int J) { return J < 24 ? 10 : 16; }
template <int J> __device__ __forceinline__ void fsub_col(float (&z)[64], const float* AabT, const float4 (&cur)[16]) {
    float4 nxt[16];
    if constexpr (J < 62) {
#pragma unroll
        for (int q = (J + 2) / 4; q < fsub_qp(J); ++q) nxt[q] = *(const float4*)(AabT + (J + 1) * 64 + 4 * q);
    }
    const float zj = z[J];
    constexpr int QV = J == 0 ? 16 : fsub_qp(J - 1);
#pragma unroll
    for (int q = (J + 1) / 4; q < 16; ++q) {
        const float4 c4 = q < QV ? cur[q] : *(const float4*)(AabT + J * 64 + 4 * q);
        if (4 * q + 0 > J) z[4 * q + 0] += c4.x * zj;
        if (4 * q + 1 > J) z[4 * q + 1] += c4.y * zj;
        if (4 * q + 2 > J) z[4 * q + 2] += c4.z * zj;
        if (4 * q + 3 > J) z[4 * q + 3] += c4.w * zj;
    }
#define ZPIN16(a) asm volatile("" : "+v"(z[a]), "+v"(z[a+1]), "+v"(z[a+2]), "+v"(z[a+3]), "+v"(z[a+4]), "+v"(z[a+5]), "+v"(z[a+6]), "+v"(z[a+7]), \
                                    "+v"(z[a+8]), "+v"(z[a+9]), "+v"(z[a+10]), "+v"(z[a+11]), "+v"(z[a+12]), "+v"(z[a+13]), "+v"(z[a+14]), "+v"(z[a+15]) :: "memory")
    if constexpr (J < 15) ZPIN16(0);
    if constexpr (J < 31) ZPIN16(16);
    if constexpr (J < 47) ZPIN16(32);
    ZPIN16(48);
#undef ZPIN16
    if constexpr (J < 62) fsub_col<J + 1>(z, AabT, nxt);
}
__device__ __forceinline__ void s1_diag_inverse(const bf16_t* Abf, bf16_t* TD, int lane) {
    const int bi = lane >> 4, c = lane & 15;
    float z[16];
#pragma unroll
    for (int t = 0; t < 16; ++t) {
        const uint4 u0 = *(const uint4*)(Abf + (16 * bi + t) * CH_ROW + 16 * bi), u1 = *(const uint4*)(Abf + (16 * bi + t) * CH_ROW + 16 * bi + 8);
        const unsigned uw[8] = {u0.x, u0.y, u0.z, u0.w, u1.x, u1.y, u1.z, u1.w};
        float acc_ = (t == c) ? 1.f : 0.f;
#pragma unroll
        for (int j = 0; j < t; ++j) acc_ += ((j & 1) ? bfhi(uw[j >> 1]) : bflo(uw[j >> 1])) * z[j];
        z[t] = acc_;
        TD[(16 * bi + t) * 24 + c] = f2bf(acc_);
    }
}
__device__ __forceinline__ void s1_load_slab(f32x4 (&Rs)[4][2], const bf16_t* X, int cb, int l15, int g) {
#pragma unroll
    for (int i = 0; i < 4; ++i)
#pragma unroll
        for (int ct = 0; ct < 2; ++ct)
#pragma unroll
            for (int r = 0; r < 4; ++r) Rs[i][ct][r] = bflo((unsigned)X[(16 * i + 4 * g + r) * CH_ROW + cb + 16 * ct + l15]);
}
__device__ __forceinline__ void s1_x2_slab(f32x4 (&Rs)[4][2], const bf16_t* Kbf, const bf16_t* VT, int vb, int l15, int g) {
#pragma unroll
    for (int i = 0; i < 4; ++i) { Rs[i][0] = (f32x4){0.f, 0.f, 0.f, 0.f}; Rs[i][1] = (f32x4){0.f, 0.f, 0.f, 0.f}; }
#pragma unroll
    for (int ks = 0; ks < 2; ++ks) {
        const bf16x8 v0 = *(const bf16x8*)(VT + (vb + l15) * CH_ROW + 32 * ks + 8 * g), v1 = *(const bf16x8*)(VT + (vb + 16 + l15) * CH_ROW + 32 * ks + 8 * g);
#pragma unroll
        for (int i = 0; i < 4; ++i) {
            const bf16x8 kf = *(const bf16x8*)(Kbf + (16 * i + l15) * CH_ROW + 32 * ks + 8 * g);
            Rs[i][0] = __builtin_amdgcn_mfma_f32_16x16x32_bf16(kf, v0, Rs[i][0], 0, 0, 0);
            Rs[i][1] = __builtin_amdgcn_mfma_f32_16x16x32_bf16(kf, v1, Rs[i][1], 0, 0, 0);
        }
    }
}
__device__ __forceinline__ void s1_slab_solve(f32x4 (&Rs)[4][2], const bf16_t* Abf, const bf16_t* TD, bf16_t* XT, int l15, int g) {
#pragma unroll
    for (int i = 0; i < 4; ++i) {
        f32x4 X0 = Rs[i][0], X1 = Rs[i][1];
#pragma unroll
        for (int j = 0; j < i; ++j) {
            const uint2 av = *(const uint2*)(Abf + (16 * i + l15) * CH_ROW + 16 * j + 4 * g);
            uint4 ua; ua.x = av.x; ua.y = av.y; ua.z = 0u; ua.w = 0u;
            uint4 ub0, ub1; ub0.x = pack2(Rs[j][0][0], Rs[j][0][1]); ub0.y = pack2(Rs[j][0][2], Rs[j][0][3]); ub0.z = 0u; ub0.w = 0u;
            ub1.x = pack2(Rs[j][1][0], Rs[j][1][1]); ub1.y = pack2(Rs[j][1][2], Rs[j][1][3]); ub1.z = 0u; ub1.w = 0u;
            X0 = __builtin_amdgcn_mfma_f32_16x16x32_bf16(*(bf16x8*)&ua, *(bf16x8*)&ub0, X0, 0, 0, 0);
            X1 = __builtin_amdgcn_mfma_f32_16x16x32_bf16(*(bf16x8*)&ua, *(bf16x8*)&ub1, X1, 0, 0, 0);
        }
        const uint2 tv = *(const uint2*)(TD + (16 * i + l15) * 24 + 4 * g);
        uint4 ut; ut.x = tv.x; ut.y = tv.y; ut.z = 0u; ut.w = 0u;
        uint4 ux0, ux1; ux0.x = pack2(X0[0], X0[1]); ux0.y = pack2(X0[2], X0[3]); ux0.z = 0u; ux0.w = 0u;
        ux1.x = pack2(X1[0], X1[1]); ux1.y = pack2(X1[2], X1[3]); ux1.z = 0u; ux1.w = 0u;
        const f32x4 zz = (f32x4){0.f, 0.f, 0.f, 0.f};
        Rs[i][0] = __builtin_amdgcn_mfma_f32_16x16x32_bf16(*(bf16x8*)&ut, *(bf16x8*)&ux0, zz, 0, 0, 0);
        Rs[i][1] = __builtin_amdgcn_mfma_f32_16x16x32_bf16(*(bf16x8*)&ut, *(bf16x8*)&ux1, zz, 0, 0, 0);
    }
#pragma unroll
    for (int i = 0; i < 4; ++i)
#pragma unroll
        for (int ct = 0; ct < 2; ++ct) { uint2 o; o.x = pack2(Rs[i][ct][0], Rs[i][ct][1]); o.y = pack2(Rs[i][ct][2], Rs[i][ct][3]); *(uint2*)(XT + (16 * ct + l15) * CH_ROW + 16 * i + 4 * g) = o; }
}
__device__ __forceinline__ void ph_s1(const Ctx cx, PRef p, char* lds) {
    const int wave = (__builtin_amdgcn_readfirstlane(cx.tid >> 6) + 2 * (cx.bid & 1)) & 3;
    for (int pairi = cx.bid >> 1; pairi < 32 * NCHUNK; pairi += cx.nb >> 1) {
        int lz = 0; asm volatile("" : "+v"(lz));
        char* ldsb = lds + lz;
        bf16_t* At = (bf16_t*)(ldsb + L_AT); bf16_t* Bt = (bf16_t*)(ldsb + L_BT); bf16_t* Kt = (bf16_t*)(ldsb + L_KT); bf16_t* Rt = (bf16_t*)(ldsb + L_RT);
        bf16_t* BhT = (bf16_t*)(ldsb + L_BH); bf16_t* KhT = (bf16_t*)(ldsb + L_KH); bf16_t* VT = (bf16_t*)(ldsb + L_VT);
        float* Aab = (float*)(ldsb + L_AAB); float* pcl = (float*)(ldsb + L_PC); float* X2 = (float*)(ldsb + L_X2);
        bf16_t* UT = (bf16_t*)(ldsb + L_UT); bf16_t* WT = (bf16_t*)(ldsb + L_WT);
        int tid = cx.tid; asm volatile("" : "+v"(tid));
        const int lane = tid & 63, l15 = lane & 15, g = lane >> 4;
        const int bh_ = pairi / NCHUNK, cc_ = pairi % NCHUNK, dir = cx.bid & 1;
        const int chain = bh_ * 2 + dir, n = dir ? (cc_ < 4 ? 3 - cc_ : 135 - cc_) : cc_, task = chain * NCHUNK + n;
        const int h = (chain >> 1) & 15, b = chain >> 5;
        int rbase, sgn; chunk_rows(b, dir, n, rbase, sgn);
        const float* Wd = dir ? p.W1 : p.W0; const bf16_t* ADd = dir ? p.AD1 : p.AD0;
        {
            const int kq = lane & 15, gq = lane >> 4;
            f32x4 wv[4], kkv[4]; uint2 adv[4], kvv[4], rvv[4], vvv[4];
#pragma unroll
            for (int i = 0; i < 4; ++i) {
                const size_t off = (size_t)(rbase + sgn * (16 * wave + 4 * gq + i)) * DM + h * 64 + 4 * kq;
                wv[i] = *(const f32x4*)(Wd + off); kkv[i] = *(const f32x4*)(p.KK + off);
                adv[i] = *(const uint2*)(ADd + off); kvv[i] = *(const uint2*)(p.K + off); rvv[i] = *(const uint2*)(p.R + off); vvv[i] = *(const uint2*)(p.V + off);
            }
            f32x4 lp[4];
            lp[0] = wv[0]; lp[1] = lp[0] * wv[1]; lp[2] = lp[1] * wv[2]; lp[3] = lp[2] * wv[3];
            f32x4 eg = (f32x4){1.f, 1.f, 1.f, 1.f}, wt = (f32x4){1.f, 1.f, 1.f, 1.f};
#pragma unroll
            for (int g2 = 0; g2 < 4; ++g2)
#pragma unroll
                for (int c = 0; c < 4; ++c) {
                    const float tv = __int_as_float(shidx(__float_as_int(lp[3][c]), kq + 16 * g2));
                    eg[c] = (g2 < gq) ? eg[c] * tv : eg[c]; wt[c] *= tv;
                }
            if (gq == 0) *(f32x4*)(Aab + wave * 64 + 4 * kq) = wt;
            __syncthreads();
            f32x4 prefix = eg, pC = (f32x4){1.f, 1.f, 1.f, 1.f};
#pragma unroll
            for (int w2 = 0; w2 < 4; ++w2) { const f32x4 tv = *(const f32x4*)(Aab + w2 * 64 + 4 * kq); if (w2 < wave) prefix = prefix * tv; pC = pC * tv; }
            if (wave == 0 && gq == 0) *(f32x4*)(pcl + 4 * kq) = pC;
            const f32x4 ka = *(const f32x4*)(p.rw_ka + h * 64 + 4 * kq);
            float bh[4][4], kh[4][4];
#pragma unroll
            for (int i = 0; i < 4; ++i) {
                const int t = 16 * wave + 4 * gq + i;
                const float adf[4] = {bflo(adv[i].x), bfhi(adv[i].x), bflo(adv[i].y), bfhi(adv[i].y)};
                const float kvf[4] = {bflo(kvv[i].x), bfhi(kvv[i].x), bflo(kvv[i].y), bfhi(kvv[i].y)};
                const float rvf[4] = {bflo(rvv[i].x), bfhi(rvv[i].x), bflo(rvv[i].y), bfhi(rvv[i].y)};
                float at[4], bt[4], kt[4], rt[4];
#pragma unroll
                for (int c = 0; c < 4; ++c) {
                    const float pt = prefix[c] * lp[i][c], pprev = i ? prefix[c] * lp[i ? i - 1 : 0][c] : prefix[c];
                    const float ip = __builtin_amdgcn_rcpf(pt);
                    at[c] = -kkv[i][c] * pprev; bt[c] = kkv[i][c] * adf[c] * ip; kt[c] = kvf[c] * (1.f + (adf[c] - 1.f) * ka[c]) * ip; rt[c] = rvf[c] * pt;
                    bh[i][c] = bt[c] * pC[c]; kh[i][c] = kt[c] * pC[c];
                }
                uint2 o;
                o.x = pack2(at[0], at[1]); o.y = pack2(at[2], at[3]); *(uint2*)(At + t * CH_ROW + 4 * kq) = o;
                o.x = pack2(bt[0], bt[1]); o.y = pack2(bt[2], bt[3]); *(uint2*)(Bt + t * CH_ROW + 4 * kq) = o;
                o.x = pack2(kt[0], kt[1]); o.y = pack2(kt[2], kt[3]); *(uint2*)(Kt + t * CH_ROW + 4 * kq) = o;
                o.x = pack2(rt[0], rt[1]); o.y = pack2(rt[2], rt[3]); *(uint2*)(Rt + t * CH_ROW + 4 * kq) = o;
            }
#pragma unroll
            for (int c = 0; c < 4; ++c) {
                const int col = 16 * wave + 4 * gq;
                uint2 o;
                o.x = pack2(bh[0][c], bh[1][c]); o.y = pack2(bh[2][c], bh[3][c]); *(uint2*)(BhT + (4 * kq + c) * CH_ROW + col) = o;
                o.x = pack2(kh[0][c], kh[1][c]); o.y = pack2(kh[2][c], kh[3][c]); *(uint2*)(KhT + (4 * kq + c) * CH_ROW + col) = o;
                const unsigned v0 = (c & 1) ? (((c >> 1) ? vvv[0].y : vvv[0].x) >> 16) : (((c >> 1) ? vvv[0].y : vvv[0].x) & 0xffffu);
                const unsigned v1 = (c & 1) ? (((c >> 1) ? vvv[1].y : vvv[1].x) >> 16) : (((c >> 1) ? vvv[1].y : vvv[1].x) & 0xffffu);
                const unsigned v2 = (c & 1) ? (((c >> 1) ? vvv[2].y : vvv[2].x) >> 16) : (((c >> 1) ? vvv[2].y : vvv[2].x) & 0xffffu);
                const unsigned v3 = (c & 1) ? (((c >> 1) ? vvv[3].y : vvv[3].x) >> 16) : (((c >> 1) ? vvv[3].y : vvv[3].x) & 0xffffu);
                o.x = v0 | (v1 << 16); o.y = v2 | (v3 << 16); *(uint2*)(VT + (4 * kq + c) * CH_ROW + col) = o;
            }
        }
        __syncthreads();
        const size_t tb = (size_t)task * 4096;
        bf16_t* Abf = (bf16_t*)(ldsb + L_AAB);
        bf16_t* TD = (bf16_t*)(ldsb + L_AAB + 9216);
        bf16_t* Kbf = Bt;
        if (wave == 0) {
            f32x4 Rs[4][2];
            {
                f32x4 accP[4][4]; zero44(accP);
                mm64(accP, Bt, At, l15, g); mask44(accP, l15, g, true);
#pragma unroll
                for (int xt = 0; xt < 4; ++xt)
#pragma unroll
                    for (int yt = 0; yt < 4; ++yt) { uint2 o; o.x = pack2(accP[xt][yt][0], accP[xt][yt][1]); o.y = pack2(accP[xt][yt][2], accP[xt][yt][3]); *(uint2*)(Abf + (16 * yt + l15) * CH_ROW + 16 * xt + 4 * g) = o; }
            }
            s1_diag_inverse(Abf, TD, lane);
            __syncthreads();
            s1_load_slab(Rs, At, 0, l15, g);
            __syncthreads();
            s1_slab_solve(Rs, Abf, TD, WT, l15, g);
            __syncthreads();
            {
                f32x4 accM[4][4]; zero44(accM);
                mm64(accM, WT, BhT, l15, g);
#pragma unroll
                for (int kpt = 0; kpt < 4; ++kpt)
#pragma unroll
                    for (int kt = 0; kt < 4; ++kt) {
                        const int k = 16 * kt + l15;
                        const float pc = pcl[k];
                        float v[4];
#pragma unroll
                        for (int r = 0; r < 4; ++r) v[r] = accM[kpt][kt][r] + ((16 * kpt + 4 * g + r) == k ? pc : 0.f);
                        uint2 o; o.x = pack2(v[0], v[1]); o.y = pack2(v[2], v[3]);
                        *(uint2*)(p.CM + tb + k * 64 + 32 * (kpt >> 1) + 8 * g + 4 * (kpt & 1)) = o;
                    }
            }
            __syncthreads();
        } else if (wave == 1) {
            f32x4 Rs[4][2];
            {
                f32x4 accA[4][4]; zero44(accA);
                mm64(accA, Kt, At, l15, g); mask44(accA, l15, g, true);
                __syncthreads();
#pragma unroll
                for (int xt = 0; xt < 4; ++xt)
#pragma unroll
                    for (int yt = 0; yt < 4; ++yt) { uint2 o; o.x = pack2(accA[xt][yt][0], accA[xt][yt][1]); o.y = pack2(accA[xt][yt][2], accA[xt][yt][3]); *(uint2*)(Kbf + (16 * yt + l15) * CH_ROW + 16 * xt + 4 * g) = o; }
            }
            s1_load_slab(Rs, At, 32, l15, g);
            __syncthreads();
            s1_slab_solve(Rs, Abf, TD, WT + 32 * CH_ROW, l15, g);
            __syncthreads();
            __syncthreads();
        } else if (wave == 2) {
            f32x4 accP[4][4], accQ[4][4];
            zero44(accP); zero44(accQ);
            mm64(accP, Kt, Rt, l15, g); mask44(accP, l15, g, false);
            mm64_accB(accQ, VT, accP, l15, g);
            zero44(accP);
            mm64(accP, Bt, Rt, l15, g); mask44(accP, l15, g, false);
            __syncthreads();
            __syncthreads();
            {
                f32x4 Rs[4][2];
                s1_x2_slab(Rs, Kbf, VT, 0, l15, g);
                s1_slab_solve(Rs, Abf, TD, UT, l15, g);
            }
            __syncthreads();
            mm64_accB(accQ, UT, accP, l15, g);
#pragma unroll
            for (int vt = 0; vt < 4; ++vt)
#pragma unroll
                for (int tt = 0; tt < 4; ++tt) {
                    uint2 o; o.x = pack2(accQ[vt][tt][0], accQ[vt][tt][1]); o.y = pack2(accQ[vt][tt][2], accQ[vt][tt][3]);
                    *(uint2*)(p.CY + tb + (16 * tt + l15) * 64 + 16 * vt + 4 * g) = o;
                }
            zero44(accQ);
            mm64_accB(accQ, WT, accP, l15, g);
#pragma unroll
            for (int kt = 0; kt < 4; ++kt)
#pragma unroll
                for (int tt = 0; tt < 4; ++tt) {
                    const uint2 rr = *(const uint2*)(Rt + (16 * tt + l15) * CH_ROW + 16 * kt + 4 * g);
                    uint2 o; o.x = pack2(accQ[kt][tt][0] + bflo(rr.x), accQ[kt][tt][1] + bfhi(rr.x)); o.y = pack2(accQ[kt][tt][2] + bflo(rr.y), accQ[kt][tt][3] + bfhi(rr.y));
                    *(uint2*)(p.CR + tb + (16 * tt + l15) * 64 + 16 * kt + 4 * g) = o;
                }
            __syncthreads();
        } else {
            f32x4 accP[4][4];
            zero44(accP);
            mm64(accP, KhT, VT, l15, g);
            __syncthreads();
            __syncthreads();
            {
                f32x4 Rs[4][2];
                s1_x2_slab(Rs, Kbf, VT, 32, l15, g);
                s1_slab_solve(Rs, Abf, TD, UT + 32 * CH_ROW, l15, g);
            }
            __syncthreads();
            mm64(accP, BhT, UT, l15, g);
#pragma unroll
            for (int kt = 0; kt < 4; ++kt)
#pragma unroll
                for (int vt = 0; vt < 4; ++vt) {
                    uint2 o; o.x = pack2(accP[kt][vt][0], accP[kt][vt][1]); o.y = pack2(accP[kt][vt][2], accP[kt][vt][3]);
                    *(uint2*)(p.CN + tb + (16 * vt + l15) * 64 + 16 * kt + 4 * g) = o;
                }
            __syncthreads();
        }
    }
}
#define S2_PF 4
__device__ __forceinline__ void s2_body(const Ctx cx, PRef p) {
    const int lane = cx.tid & 63, l15 = lane & 15, g = lane >> 4;
    const int item = cx.bid, chain = item >> 2, vs = (item & 3) * 16;
    const bf16_t* Mb = p.CM + (size_t)chain * NCHUNK * 4096;
    const bf16_t* Nb = p.CN + (size_t)chain * NCHUNK * 4096 + (vs + l15) * 64 + 4 * g;
    bf16_t* Sb = p.CS + (size_t)chain * NCHUNK * 4096 + (vs + l15) * 64 + 4 * g;
    f32x4 sacc[4];
#pragma unroll
    for (int kt = 0; kt < 4; ++kt) sacc[kt] = (f32x4){0.f, 0.f, 0.f, 0.f};
    uint4 mreg[S2_PF][8]; uint2 nreg[S2_PF][4];
    auto ldstep = [&](int slot, int n) {
#pragma unroll
        for (int kt = 0; kt < 4; ++kt) {
            mreg[slot][2 * kt] = *(const uint4*)(Mb + (size_t)n * 4096 + (16 * kt + l15) * 64 + 8 * g);
            mreg[slot][2 * kt + 1] = *(const uint4*)(Mb + (size_t)n * 4096 + (16 * kt + l15) * 64 + 32 + 8 * g);
            nreg[slot][kt] = *(const uint2*)(Nb + (size_t)n * 4096 + 16 * kt);
        }
    };
#pragma unroll
    for (int s2 = 0; s2 < S2_PF; ++s2) ldstep(s2, s2);
    for (int n0 = 0; n0 < NCHUNK; n0 += S2_PF) {
#pragma unroll
        for (int s2 = 0; s2 < S2_PF; ++s2) {
            const int n = n0 + s2;
#pragma unroll
            for (int kt = 0; kt < 4; ++kt) { uint2 o; o.x = pack2(sacc[kt][0], sacc[kt][1]); o.y = pack2(sacc[kt][2], sacc[kt][3]); *(uint2*)(Sb + (size_t)n * 4096 + 16 * kt) = o; }
            const bf16x8 sb0 = pack8(sacc[0], sacc[1]), sb1 = pack8(sacc[2], sacc[3]);
#pragma unroll
            for (int kt = 0; kt < 4; ++kt) {
                f32x4 a; a[0] = bflo(nreg[s2][kt].x); a[1] = bfhi(nreg[s2][kt].x); a[2] = bflo(nreg[s2][kt].y); a[3] = bfhi(nreg[s2][kt].y);
                a = __builtin_amdgcn_mfma_f32_16x16x32_bf16(*(bf16x8*)&mreg[s2][2 * kt], sb0, a, 0, 0, 0);
                a = __builtin_amdgcn_mfma_f32_16x16x32_bf16(*(bf16x8*)&mreg[s2][2 * kt + 1], sb1, a, 0, 0, 0);
                sacc[kt] = a;
            }
            if (n + S2_PF < NCHUNK) ldstep(s2, n + S2_PF);
        }
    }
}
#define S2R_SLOTS 8
#define S2R_AHEAD 7
__device__ __forceinline__ void s2_ring(const Ctx px, PRef p, char* lds) {
    const int wv = __builtin_amdgcn_readfirstlane(px.tid >> 6), lane = px.tid & 63, l15 = lane & 15, g = lane >> 4;
    const int chain = px.bid;
    const bf16_t* Mb = p.CM + (size_t)chain * NCHUNK * 4096;
    const bf16_t* Nb = p.CN + (size_t)chain * NCHUNK * 4096;
    if (wv >= 4) {
        const int lw = wv - 4;
        unsigned so[2];
#pragma unroll
        for (int i = 0; i < 2; ++i) { const int sl = lw * 128 + i * 64 + lane, row = sl >> 3, cp = sl & 7; so[i] = (unsigned)(row * 64 + ((cp ^ (row & 7)) * 8)); }
        auto issue = [&](int n) {
            char* slot = lds + (n & (S2R_SLOTS - 1)) * 16384 + lw * 2048;
            glds16(Mb + (size_t)n * 4096 + so[0], slot); glds16(Mb + (size_t)n * 4096 + so[1], slot + 1024);
            glds16(Nb + (size_t)n * 4096 + so[0], slot + 8192); glds16(Nb + (size_t)n * 4096 + so[1], slot + 8192 + 1024);
        };
        for (int n = 0; n < S2R_AHEAD; ++n) issue(n);
        asm volatile("s_waitcnt vmcnt(24)" ::: "memory");
        __builtin_amdgcn_s_barrier();
        for (int n = 0; n < NCHUNK; ++n) {
            if (n + S2R_AHEAD < NCHUNK) { issue(n + S2R_AHEAD); asm volatile("s_waitcnt vmcnt(24)" ::: "memory"); }
            else asm volatile("s_waitcnt vmcnt(0)" ::: "memory");
            __builtin_amdgcn_s_barrier();
        }
    } else {
        const int vs = wv * 16;
        bf16_t* Sb = p.CS + (size_t)chain * NCHUNK * 4096 + (vs + l15) * 64 + 4 * g;
        f32x4 sacc[4];
#pragma unroll
        for (int kt = 0; kt < 4; ++kt) sacc[kt] = (f32x4){0.f, 0.f, 0.f, 0.f};
        __builtin_amdgcn_s_barrier();
        for (int n = 0; n < NCHUNK; ++n) {
            const char* slot = lds + (n & (S2R_SLOTS - 1)) * 16384;
            bf16x8 mf[8]; uint2 nf[4];
#pragma unroll
            for (int kt = 0; kt < 4; ++kt) {
                const int row = 16 * kt + l15;
                mf[2 * kt] = *(const bf16x8*)(slot + row * 128 + ((g ^ (row & 7)) << 4));
                mf[2 * kt + 1] = *(const bf16x8*)(slot + row * 128 + (((4 + g) ^ (row & 7)) << 4));
                const int nrow = vs + l15;
                nf[kt] = *(const uint2*)(slot + 8192 + nrow * 128 + (((2 * kt + (g >> 1)) ^ (nrow & 7)) << 4) + (g & 1) * 8);
            }
#pragma unroll
            for (int kt = 0; kt < 4; ++kt) { uint2 o; o.x = pack2(sacc[kt][0], sacc[kt][1]); o.y = pack2(sacc[kt][2], sacc[kt][3]); *(uint2*)(Sb + (size_t)n * 4096 + 16 * kt) = o; }
            const bf16x8 sb0 = pack8(sacc[0], sacc[1]), sb1 = pack8(sacc[2], sacc[3]);
#pragma unroll
            for (int kt = 0; kt < 4; ++kt) {
                f32x4 a2; a2[0] = bflo(nf[kt].x); a2[1] = bfhi(nf[kt].x); a2[2] = bflo(nf[kt].y); a2[3] = bfhi(nf[kt].y);
                a2 = __builtin_amdgcn_mfma_f32_16x16x32_bf16(mf[2 * kt], sb0, a2, 0, 0, 0);
                a2 = __builtin_amdgcn_mfma_f32_16x16x32_bf16(mf[2 * kt + 1], sb1, a2, 0, 0, 0);
                sacc[kt] = a2;
            }
            asm volatile("s_waitcnt lgkmcnt(0)" ::: "memory");
            __builtin_amdgcn_s_barrier();
        }
    }
}
__device__ __forceinline__ void ph_s2(const Ctx px, const Ctx cx, PRef p, char* ldsv, char* ldsq) {
    if (px.bid < 64) {
        s2_ring(px, p, ldsq);
    } else {
        conv_small(cx, p, ldsv, 960, 1856, cx.bid - 128, cx.nb - 128);
        conv_moe(cx, p, ldsv, cx.bid - 128, cx.nb - 128);
    }
}
__device__ __forceinline__ void ph_s3o(const Ctx cx, PRef p) {
    const int lane = cx.tid & 63, tt = cx.tid >> 6, l15 = lane & 15, g = lane >> 4;
    for (int task = cx.bid; task < 32 * NCHUNK; task += cx.nb) {
        const int bh = task / NCHUNK, cc = task % NCHUNK, h = bh & 15, b = bh >> 4;
        const int t = 16 * tt + l15;
        const size_t tbf = ((size_t)(bh * 2) * NCHUNK + cc) * 4096;
        const size_t tbb = ((size_t)(bh * 2 + 1) * NCHUNK + (cc < 4 ? 3 - cc : 135 - cc)) * 4096;
        const int tb_ = 63 - t;
        const bf16x8 rf0 = *(const bf16x8*)(p.CR + tbf + t * 64 + 8 * g), rf1 = *(const bf16x8*)(p.CR + tbf + t * 64 + 32 + 8 * g);
        const bf16x8 rb0 = *(const bf16x8*)(p.CR + tbb + tb_ * 64 + 8 * g), rb1 = *(const bf16x8*)(p.CR + tbb + tb_ * 64 + 32 + 8 * g);
        const int row = cc < 4 ? ROWS_LAT + b * LCTX + 64 * cc + t : b * TLAT + 64 * (cc - 4) + t;
        const size_t off = (size_t)row * DM + h * 64 + 4 * g;
        float4 rkw4[4], lg4[4], lb4[4];
#pragma unroll
        for (int vt = 0; vt < 4; ++vt) { rkw4[vt] = *(const float4*)(p.rw_rk + h * 64 + 16 * vt + 4 * g); lg4[vt] = *(const float4*)(p.rw_lnx_g + h * 64 + 16 * vt + 4 * g); lb4[vt] = *(const float4*)(p.rw_lnx_b + h * 64 + 16 * vt + 4 * g); }
        uint2 ur4[4], uk4[4], uv4[4], ug4[4];
#pragma unroll
        for (int vt = 0; vt < 4; ++vt) { ur4[vt] = *(const uint2*)(p.R + off + 16 * vt); uk4[vt] = *(const uint2*)(p.K + off + 16 * vt); uv4[vt] = *(const uint2*)(p.V + off + 16 * vt); ug4[vt] = *(const uint2*)(p.G + off + 16 * vt); }
        f32x4 y[4];
#pragma unroll
        for (int vt = 0; vt < 4; ++vt) {
            const bf16x8 sf0 = *(const bf16x8*)(p.CS + tbf + (16 * vt + l15) * 64 + 8 * g), sf1 = *(const bf16x8*)(p.CS + tbf + (16 * vt + l15) * 64 + 32 + 8 * g);
            const bf16x8 sb0 = *(const bf16x8*)(p.CS + tbb + (16 * vt + l15) * 64 + 8 * g), sb1 = *(const bf16x8*)(p.CS + tbb + (16 * vt + l15) * 64 + 32 + 8 * g);
            const uint2 yf = *(const uint2*)(p.CY + tbf + t * 64 + 16 * vt + 4 * g), yb = *(const uint2*)(p.CY + tbb + tb_ * 64 + 16 * vt + 4 * g);
            f32x4 a; a[0] = bflo(yf.x) + bflo(yb.x); a[1] = bfhi(yf.x) + bfhi(yb.x); a[2] = bflo(yf.y) + bflo(yb.y); a[3] = bfhi(yf.y) + bfhi(yb.y);
            a = __builtin_amdgcn_mfma_f32_16x16x32_bf16(sf0, rf0, a, 0, 0, 0);
            a = __builtin_amdgcn_mfma_f32_16x16x32_bf16(sf1, rf1, a, 0, 0, 0);
            a = __builtin_amdgcn_mfma_f32_16x16x32_bf16(sb0, rb0, a, 0, 0, 0);
            a = __builtin_amdgcn_mfma_f32_16x16x32_bf16(sb1, rb1, a, 0, 0, 0);
            y[vt] = a;
        }
        float s = 0.f;
#pragma unroll
        for (int vt = 0; vt < 4; ++vt) s += (y[vt][0] + y[vt][1]) + (y[vt][2] + y[vt][3]);
        s += shx(s, 16, lane); s += shx(s, 32, lane);
        const float mu = s * (1.f / 64.f);
        float q2 = 0.f, rk = 0.f;
        float rr[4][4], vv[4][4], gg[4][4];
#pragma unroll
        for (int vt = 0; vt < 4; ++vt) {
            const uint2 ur = ur4[vt], uk = uk4[vt], uv = uv4[vt], ug = ug4[vt];
            const float4 rkw = rkw4[vt];
            rr[vt][0] = bflo(ur.x); rr[vt][1] = bfhi(ur.x); rr[vt][2] = bflo(ur.y); rr[vt][3] = bfhi(ur.y);
            vv[vt][0] = bflo(uv.x); vv[vt][1] = bfhi(uv.x); vv[vt][2] = bflo(uv.y); vv[vt][3] = bfhi(uv.y);
            gg[vt][0] = bflo(ug.x); gg[vt][1] = bfhi(ug.x); gg[vt][2] = bflo(ug.y); gg[vt][3] = bfhi(ug.y);
            rk += rr[vt][0] * bflo(uk.x) * rkw.x + rr[vt][1] * bfhi(uk.x) * rkw.y + rr[vt][2] * bflo(uk.y) * rkw.z + rr[vt][3] * bfhi(uk.y) * rkw.w;
#pragma unroll
            for (int r = 0; r < 4; ++r) { const float d = y[vt][r] - mu; q2 += d * d; }
        }
        q2 += shx(q2, 16, lane); q2 += shx(q2, 32, lane); rk += shx(rk, 16, lane); rk += shx(rk, 32, lane);
        const float rstd = __builtin_amdgcn_rsqf(q2 * (1.f / 64.f) + 64e-5f);
#pragma unroll
        for (int vt = 0; vt < 4; ++vt) {
            const float4 lg = lg4[vt], lb = lb4[vt];
            const float z0 = ((y[vt][0] - mu) * rstd * lg.x + lb.x + rk * vv[vt][0]) * gg[vt][0];
            const float z1 = ((y[vt][1] - mu) * rstd * lg.y + lb.y + rk * vv[vt][1]) * gg[vt][1];
            const float z2 = ((y[vt][2] - mu) * rstd * lg.z + lb.z + rk * vv[vt][2]) * gg[vt][2];
            const float z3 = ((y[vt][3] - mu) * rstd * lg.w + lb.w + rk * vv[vt][3]) * gg[vt][3];
            uint2 o; o.x = pack2(z0, z1); o.y = pack2(z2, z3);
            *(uint2*)(p.G + off + 16 * vt) = o;
        }
    }
}
__device__ __forceinline__ void ph_oproj(const Ctx cx, PRef p, char* lds, const bf16_t* A_, const bf16_t* Wt, const float* xl, const float* xc, const float* modl, int mt_lo, int mtiles) {
    for (int tile = cx.bid; tile < mtiles * 8; tile += cx.nb) {
        const int mt = mt_lo + (tile >> 3), n0 = (tile & 7) * 128, m0 = mt * 128;
        const bf16_t* A = A_ + (size_t)m0 * DM + G3_CH8;
        const bf16_t* B = Wt + (size_t)n0 * 1024 + G3_CH8;
        EpiResid epi; epi.out = p.PRE; epi.xl = xl; epi.xc = xc; epi.modl = modl; epi.m0 = m0; epi.n0 = n0;
        gemm3_tile(cx, A + (size_t)G3_ROW(0) * DM, A + (size_t)G3_ROW(1) * DM,
                   B + (size_t)G3_ROW(0) * 1024, B + (size_t)G3_ROW(1) * 1024, 1024, epi, lds);
    }
}
__device__ __forceinline__ void ph_ln_router(const Ctx cx, PRef p, int layer, int nrows, char* lds) {
    const int lane_ = cx.tid & 63, gw = (cx.bid * NTHR + cx.tid) >> 6, nw = (cx.nb * NTHR) >> 6;
    {
        const int ptid = (cx.bid & 1) * NTHR + cx.tid;
        const float* rw = p.router_w + (size_t)layer * DM * 16;
        float4* L = (float4*)lds;
#pragma unroll 4
        for (int f = ptid; f < 4096; f += 2 * NTHR) {
            const float4 w = *(const float4*)(rw + 4 * f);
            const int col = f >> 2, e4 = f & 3, i = col >> 8, ln = (col >> 2) & 63, c = col & 3;
            L[((((i * 4 + c) * 4) + e4) << 6) + ln] = w;
        }
#pragma unroll
        for (int f = ptid; f < 2048; f += 2 * NTHR) {
            const int vec = f >> 8, idx = f & 255;
            const float* src = vec == 0 ? p.ln1_g + layer * DM : (vec == 1 ? p.ln1_b + layer * DM : p.modv + (size_t)(layer * 3 + ((vec - 2) >> 1)) * 6144 + (3 + (vec & 1)) * 1024);
            float4 w = *(const float4*)(src + 4 * idx);
            if (vec >= 2 && (vec & 1)) { w.x += 1.f; w.y += 1.f; w.z += 1.f; w.w += 1.f; }
            L[4096 + f] = w;
        }
        __syncthreads();
    }
    const bool b5 = lane_ & 32, b4 = lane_ & 16, b3 = lane_ & 8, b2 = lane_ & 4;
    const int myidx = (b3 ? 8 : 0) + (b2 ? 4 : 0) + (b5 ? 2 : 0) + (b4 ? 1 : 0);
    const int nmain = (nrows / (nw * 4)) * (nw * 4);
    const int ntail = nrows - nmain;
    for (int it = gw; it < nmain / 4 + ntail; it += nw) {
        const int rstep = it < nmain / 4 ? 1 : 0;
        const int r0 = rstep ? it * 4 : nmain + (it - nmain / 4);
        int lane = lane_; asm volatile("" : "+v"(lane));
        float mu[4], rstd[4];
        float4 v[4][4];
        {
#pragma unroll
            for (int rr = 0; rr < 4; ++rr) {
                const float* pr = p.PRE + (size_t)(r0 + rr * rstep) * DM;
                float s = 0.f;
#pragma unroll
                for (int i = 0; i < 4; ++i) { v[rr][i] = *(const float4*)(pr + i * 256 + lane * 4); s += (v[rr][i].x + v[rr][i].y) + (v[rr][i].z + v[rr][i].w); }
                mu[rr] = s;
            }
#pragma unroll
            for (int rr = 0; rr < 4; ++rr) mu[rr] = wsum(mu[rr]) * (1.f / 1024.f);
#pragma unroll
            for (int rr = 0; rr < 4; ++rr) {
                float q = 0.f;
#pragma unroll
                for (int i = 0; i < 4; ++i) { const float a = v[rr][i].x - mu[rr], b = v[rr][i].y - mu[rr], c = v[rr][i].z - mu[rr], d = v[rr][i].w - mu[rr]; q += (a * a + b * b) + (c * c + d * d); }
                rstd[rr] = q;
            }
#pragma unroll
            for (int rr = 0; rr < 4; ++rr) rstd[rr] = __builtin_amdgcn_rsqf(wsum(rstd[rr]) * (1.f / 1024.f) + 1e-5f);
        }
        const float4* Pv = (const float4*)lds + 4096 + lane;
        const float4* Pm = Pv + (2 + 2 * mod_of_row(r0)) * 256;
        float lgt[4][16];
#pragma unroll
        for (int rr = 0; rr < 4; ++rr)
#pragma unroll
            for (int e = 0; e < 16; ++e) lgt[rr][e] = 0.f;
        float4 wq0, wq1, wq2, wq3;
        const float4* Lw = (const float4*)lds + lane;
        { wq0 = Lw[0]; wq1 = Lw[64]; wq2 = Lw[128]; wq3 = Lw[192]; }
#pragma unroll
        for (int i = 0; i < 4; ++i) {
            const int col = i * 256 + lane * 4;
            const float4 g4 = Pv[i * 64], b4v = Pv[256 + i * 64];
            const float4 sh = Pm[i * 64], sc = Pm[256 + i * 64];
            float hh[4][4];
#pragma unroll
            for (int rr = 0; rr < 4; ++rr) {
                const float4 vv = v[rr][i];
                float4 x1;
                x1.x = (vv.x - mu[rr]) * rstd[rr] * g4.x + b4v.x; x1.y = (vv.y - mu[rr]) * rstd[rr] * g4.y + b4v.y;
                x1.z = (vv.z - mu[rr]) * rstd[rr] * g4.z + b4v.z; x1.w = (vv.w - mu[rr]) * rstd[rr] * g4.w + b4v.w;
                *(float4*)(p.X1 + (size_t)(r0 + rr * rstep) * DM + col) = x1;
                hh[rr][0] = x1.x * sc.x + sh.x; hh[rr][1] = x1.y * sc.y + sh.y; hh[rr][2] = x1.z * sc.z + sh.z; hh[rr][3] = x1.w * sc.w + sh.w;
                uint2 o; o.x = pack2(hh[rr][0], hh[rr][1]); o.y = pack2(hh[rr][2], hh[rr][3]);
                *(uint2*)(p.H2 + (size_t)(r0 + rr * rstep) * DM + col) = o;
            }
#pragma unroll
            for (int c = 0; c < 4; ++c) {
                float4 n0 = wq0, n1 = wq1, n2 = wq2, n3 = wq3;
                if (i * 4 + c + 1 < 16) {
                    const float4* rp = Lw + (i * 4 + c + 1) * 256;
                    n0 = rp[0]; n1 = rp[64]; n2 = rp[128]; n3 = rp[192];
                }
                const float4 w0 = wq0, w1 = wq1, w2 = wq2, w3 = wq3;
#pragma unroll
                for (int rr = 0; rr < 4; ++rr) {
                    const float hv = hh[rr][c];
                    lgt[rr][0] += hv * w0.x; lgt[rr][1] += hv * w0.y; lgt[rr][2] += hv * w0.z; lgt[rr][3] += hv * w0.w;
                    lgt[rr][4] += hv * w1.x; lgt[rr][5] += hv * w1.y; lgt[rr][6] += hv * w1.z; lgt[rr][7] += hv * w1.w;
                    lgt[rr][8] += hv * w2.x; lgt[rr][9] += hv * w2.y; lgt[rr][10] += hv * w2.z; lgt[rr][11] += hv * w2.w;
                    lgt[rr][12] += hv * w3.x; lgt[rr][13] += hv * w3.y; lgt[rr][14] += hv * w3.z; lgt[rr][15] += hv * w3.w;
                }
                if (c & 1) {
#define LPIN(rr) asm volatile("" : "+v"(lgt[rr][0]), "+v"(lgt[rr][1]), "+v"(lgt[rr][2]), "+v"(lgt[rr][3]), "+v"(lgt[rr][4]), "+v"(lgt[rr][5]), "+v"(lgt[rr][6]), "+v"(lgt[rr][7]), \
                                   "+v"(lgt[rr][8]), "+v"(lgt[rr][9]), "+v"(lgt[rr][10]), "+v"(lgt[rr][11]), "+v"(lgt[rr][12]), "+v"(lgt[rr][13]), "+v"(lgt[rr][14]), "+v"(lgt[rr][15]) :: "memory")
                    LPIN(0); LPIN(1); LPIN(2); LPIN(3);
#undef LPIN
                }
                wq0 = n0; wq1 = n1; wq2 = n2; wq3 = n3;
            }
        }
        float a4[4][4], a1r[4];
#pragma unroll
        for (int rr = 0; rr < 4; ++rr) {
            float a8[8];
#pragma unroll
            for (int i = 0; i < 8; ++i) { const float lo = lgt[rr][i], hi = lgt[rr][i + 8]; const float snd = b3 ? lo : hi; const float kp = b3 ? hi : lo; a8[i] = kp + dx8(snd); }
#pragma unroll
            for (int i = 0; i < 4; ++i) { const float lo = a8[i], hi = a8[i + 4]; const float snd = b2 ? lo : hi; const float kp = b2 ? hi : lo; float t = kp + dx4(snd); t += dx2(t); t += dx1(t); a4[rr][i] = t; }
        }
        {
            float t[4][2];
#pragma unroll
            for (int rr = 0; rr < 4; ++rr)
#pragma unroll
                for (int i = 0; i < 2; ++i) { const float lo = a4[rr][i], hi = a4[rr][i + 2]; const float snd = b5 ? lo : hi; t[rr][i] = shx(snd, 32, lane); }
            asm volatile("" : "+v"(t[0][0]), "+v"(t[0][1]), "+v"(t[1][0]), "+v"(t[1][1]), "+v"(t[2][0]), "+v"(t[2][1]), "+v"(t[3][0]), "+v"(t[3][1]));
            float u[4];
#pragma unroll
            for (int rr = 0; rr < 4; ++rr) {
                const float q0 = a4[rr][0], q1 = a4[rr][1], q2 = a4[rr][2], q3 = a4[rr][3];
                const float k0 = (b5 ? q2 : q0) + t[rr][0], k1 = (b5 ? q3 : q1) + t[rr][1];
                a1r[rr] = b4 ? k1 : k0; u[rr] = shx(b4 ? k0 : k1, 16, lane);
            }
            asm volatile("" : "+v"(u[0]), "+v"(u[1]), "+v"(u[2]), "+v"(u[3]));
#pragma unroll
            for (int rr = 0; rr < 4; ++rr) a1r[rr] += u[rr];
        }
        float mx[4], ex[4], se[4];
        {
            float u[4];
#pragma unroll
            for (int rr = 0; rr < 4; ++rr) u[rr] = shx(a1r[rr], 32, lane);
            asm volatile("" : "+v"(u[0]), "+v"(u[1]), "+v"(u[2]), "+v"(u[3]));
#pragma unroll
            for (int rr = 0; rr < 4; ++rr) { mx[rr] = fmaxf(a1r[rr], u[rr]); u[rr] = shx(mx[rr], 16, lane); }
            asm volatile("" : "+v"(u[0]), "+v"(u[1]), "+v"(u[2]), "+v"(u[3]));
#pragma unroll
            for (int rr = 0; rr < 4; ++rr) { float m = fmaxf(mx[rr], u[rr]); m = fmaxf(m, dx8(m)); m = fmaxf(m, dx4(m)); ex[rr] = __expf(a1r[rr] - m); u[rr] = shx(ex[rr], 32, lane); }
            asm volatile("" : "+v"(u[0]), "+v"(u[1]), "+v"(u[2]), "+v"(u[3]));
#pragma unroll
            for (int rr = 0; rr < 4; ++rr) { se[rr] = ex[rr] + u[rr]; u[rr] = shx(se[rr], 16, lane); }
            asm volatile("" : "+v"(u[0]), "+v"(u[1]), "+v"(u[2]), "+v"(u[3]));
#pragma unroll
            for (int rr = 0; rr < 4; ++rr) { float q = se[rr] + u[rr]; q += dx8(q); q += dx4(q); se[rr] = q; }
        }
        if ((lane & 3) == 0) {
#pragma unroll
            for (int rr = 0; rr < 4; ++rr) { p.afft[(size_t)myidx * ROWS + r0 + rr * rstep] = ex[rr] / se[rr]; p.inv[(size_t)(r0 + rr * rstep) * 16 + myidx] = -1; }
        }
    }
}
template <int CH>
__device__ __forceinline__ void topk_list(const Ctx cx, PRef p, int e, int rowbase, int cap, int slotbase, unsigned* sh) {
    const int tid = cx.tid, lane = tid & 63, wave = tid >> 6;
    const float* src = p.afft + (size_t)e * ROWS + rowbase + tid * CH;
    unsigned key[CH];
    if (CH >= 4) {
#pragma unroll
        for (int j = 0; j < CH / 4; ++j) { const uint4 u = *(const uint4*)(src + 4 * j); key[4 * j] = u.x; key[4 * j + 1] = u.y; key[4 * j + 2] = u.z; key[4 * j + 3] = u.w; }
    } else {
#pragma unroll
        for (int j = 0; j < CH; ++j) key[j] = __float_as_uint(src[j]);
    }
    unsigned prefix = 0u;
    for (int bit = 30; bit >= 0; --bit) {
        const unsigned cand = prefix | (1u << bit);
        int c = 0;
#pragma unroll
        for (int j = 0; j < CH; ++j) c += (key[j] >= cand) ? 1 : 0;
#pragma unroll
        for (int o = 32; o > 0; o >>= 1) c += shxi(c, o, lane);
        const int slot = (30 - bit) & 1;
        if (lane == 0) sh[slot * 4 + wave] = (unsigned)c;
        __syncthreads();
        const int tot = (int)(sh[slot * 4] + sh[slot * 4 + 1] + sh[slot * 4 + 2] + sh[slot * 4 + 3]);
        if (tot >= cap) prefix = cand;
    }
    __syncthreads();
    const unsigned thr = prefix;
    int cg = 0, ce = 0;
#pragma unroll
    for (int j = 0; j < CH; ++j) { cg += key[j] > thr; ce += key[j] == thr; }
    unsigned pk = (unsigned)cg | ((unsigned)ce << 16);
    unsigned incl = pk;
#pragma unroll
    for (int o = 1; o < 64; o <<= 1) { const unsigned n = (unsigned)shidx((int)incl, (lane - o) & 63); if (lane >= o) incl += n; }
    if (lane == 63) sh[8 + wave] = incl;
    __syncthreads();
    unsigned wbase = 0u, total = 0u;
#pragma unroll
    for (int w = 0; w < 4; ++w) { const unsigned v = sh[8 + w]; if (w < wave) wbase += v; total += v; }
    const unsigned excl = wbase + incl - pk;
    const int tot_gt = (int)(total & 0xffffu);
    const int need_eq = cap - tot_gt;
    int eq_rank = (int)(excl >> 16);
    int gt_before = (int)(excl & 0xffffu);
#pragma unroll
    for (int j = 0; j < CH; ++j) {
        const bool isg = key[j] > thr, ise = key[j] == thr;
        const bool sel = isg || (ise && eq_rank < need_eq);
        if (sel) {
            const int slot = slotbase + gt_before + (eq_rank < need_eq ? eq_rank : need_eq);
            const int row = rowbase + tid * CH + j;
            p.idx[e * MPAD0 + slot] = row;
            p.gate[e * MPAD0 + slot] = __uint_as_float(key[j]);
            p.inv[(size_t)row * 16 + e] = slot;
        }
        gt_before += isg; eq_rank += ise;
    }
    __syncthreads();
}
__device__ __forceinline__ void ph_topk(const Ctx cx, PRef p, int layer, char* lds) {
    unsigned* sh = (unsigned*)lds;
    const int nlists = layer == 0 ? 64 : 32;
    for (int li = cx.bid; li < nlists; li += cx.nb) {
        const int s = li >> 4, e = li & 15;
        if (s < 2) topk_list<32>(cx, p, e, s * TLAT, 1024, s * 1024, sh);
        else {
            topk_list<1>(cx, p, e, ROWS_LAT + (s - 2) * LCTX, 32, 2048 + (s - 2) * 32, sh);
            if (s == 3 && cx.tid < 64) { p.idx[e * MPAD0 + 2112 + cx.tid] = -1; p.gate[e * MPAD0 + 2112 + cx.tid] = 0.f; }
        }
    }
}
__device__ __forceinline__ void ph_moe_up(const Ctx cx, PRef p, int layer, char* lds) {
    if (layer != 0) return;
    for (int tile = cx.bid; tile < 16 * 32; tile += cx.nb) {
        const int e = tile >> 5, nt = tile & 31, m0 = 2048, j0 = nt * 64;
        const bf16_t* ar[2]; const bf16_t* br[2];
        const bf16_t* We = p.CW + (size_t)(layer * 16 + e) * 3 * 2097152;
#pragma unroll
        for (int i = 0; i < 2; ++i) {
            const int r = G3_ROW(i);
            int src = p.idx[e * MPAD0 + m0 + r]; if (src < 0) src = 0;
            ar[i] = p.H2 + (size_t)src * DM + G3_CH8;
            const int j = j0 + (r >> 6) * 32 + ((r >> 4) & 1) * 16 + (r & 15);
            br[i] = We + (size_t)((r >> 5) & 1) * 2097152 + (size_t)j * 1024 + G3_CH8;
        }
        EpiSwiGLU epi; epi.out = p.HMID + (size_t)e * MPAD0 * 2048; epi.m0 = m0; epi.j0 = j0;
        gemm3_tile(cx, ar[0], ar[1], br[0], br[1], 1024, epi, lds);
    }
}
__device__ __forceinline__ void ph_moe_down(const Ctx cx, PRef p, int layer, char* lds) {
    if (layer != 0) return;
    for (int tile = cx.bid; tile < 16 * 8; tile += cx.nb) {
        const int e = tile >> 3, nt = tile & 7, m0 = 2048, n0 = nt * 128;
        const bf16_t* A = p.HMID + ((size_t)e * MPAD0 + m0) * 2048 + G3_CH8;
        const bf16_t* B = p.CW + ((size_t)(layer * 16 + e) * 3 + 2) * 2097152 + (size_t)n0 * 2048 + G3_CH8;
        EpiDown epi; epi.out = p.YE + (size_t)e * MPAD0 * DM; epi.gate = p.gate + e * MPAD0; epi.m0 = m0; epi.n0 = n0;
        gemm3_tile(cx, A + (size_t)G3_ROW(0) * 2048, A + (size_t)G3_ROW(1) * 2048,
                   B + (size_t)G3_ROW(0) * 2048, B + (size_t)G3_ROW(1) * 2048, 2048, epi, lds);
    }
}
__device__ __forceinline__ void ph_combine(const Ctx cx, PRef p, int layer, int nrows) {
    const int lane = cx.tid & 63, gw = (cx.bid * NTHR + cx.tid) >> 6, nw = (cx.nb * NTHR) >> 6;
    const float* lg = p.ln2_g + layer * DM; const float* lb = p.ln2_b + layer * DM;
    int inv_next = (gw < nrows && lane < 16) ? p.inv[(size_t)gw * 16 + lane] : -1;
    for (int row = gw; row < nrows; row += nw) {
        const float* mv = p.modv + (size_t)(layer * 3 + mod_of_row(row)) * 6144;
        float4 m[4];
#pragma unroll
        for (int i = 0; i < 4; ++i) m[i] = make_float4(0.f, 0.f, 0.f, 0.f);
        const int myinv = inv_next;
        float4 x1r[4], g5r[4];
#pragma unroll
        for (int i = 0; i < 4; ++i) { const int col = i * 256 + lane * 4; x1r[i] = *(const float4*)(p.X1 + (size_t)row * DM + col); g5r[i] = *(const float4*)(mv + 5 * 1024 + col); }
        inv_next = (row + nw < nrows && lane < 16) ? p.inv[(size_t)(row + nw) * 16 + lane] : -1;
        unsigned vm = (unsigned)(__builtin_amdgcn_ballot_w64(myinv >= 0) & 0xffffull);
        while (vm) {
            int ek[4]; float wk[4];
#pragma unroll
            for (int k = 0; k < 4; ++k) { if (vm) { ek[k] = __builtin_ctz(vm); vm &= vm - 1u; wk[k] = 1.f; } else { ek[k] = ek[0]; wk[k] = 0.f; } }
            uint2 y[4][4];
#pragma unroll
            for (int k = 0; k < 4; ++k) {
                const int sl = shidx(myinv, ek[k]);
                const bf16_t* yr = p.YE + ((size_t)ek[k] * MPAD0 + sl) * DM;
#pragma unroll
                for (int i = 0; i < 4; ++i) y[k][i] = *(const uint2*)(yr + i * 256 + lane * 4);
            }
#pragma unroll
            for (int k = 0; k < 4; ++k)
#pragma unroll
                for (int i = 0; i < 4; ++i) { m[i].x += wk[k] * bflo(y[k][i].x); m[i].y += wk[k] * bfhi(y[k][i].x); m[i].z += wk[k] * bflo(y[k][i].y); m[i].w += wk[k] * bfhi(y[k][i].y); }
        }
        float4 v[4]; float s = 0.f;
#pragma unroll
        for (int i = 0; i < 4; ++i) {
            const int col = i * 256 + lane * 4;
            const float4 x1 = x1r[i], g5 = g5r[i];
            v[i].x = ALPHA_F * x1.x + g5.x * m[i].x; v[i].y = ALPHA_F * x1.y + g5.y * m[i].y; v[i].z = ALPHA_F * x1.z + g5.z * m[i].z; v[i].w = ALPHA_F * x1.w + g5.w * m[i].w;
            s += (v[i].x + v[i].y) + (v[i].z + v[i].w);
        }
        const float mu = wsum(s) * (1.f / 1024.f);
        float q = 0.f;
#pragma unroll
        for (int i = 0; i < 4; ++i) { const float a = v[i].x - mu, b = v[i].y - mu, c = v[i].z - mu, d = v[i].w - mu; q += (a * a + b * b) + (c * c + d * d); }
        const float rstd = __builtin_amdgcn_rsqf(wsum(q) * (1.f / 1024.f) + 1e-5f);
        const float* mv1 = p.modv + (size_t)(3 + mod_of_row(row)) * 6144;
#pragma unroll
        for (int i = 0; i < 4; ++i) {
            const int col = i * 256 + lane * 4;
            const float4 g4 = *(const float4*)(lg + col), b4 = *(const float4*)(lb + col);
            float4 x2;
            x2.x = (v[i].x - mu) * rstd * g4.x + b4.x; x2.y = (v[i].y - mu) * rstd * g4.y + b4.y;
            x2.z = (v[i].z - mu) * rstd * g4.z + b4.z; x2.w = (v[i].w - mu) * rstd * g4.w + b4.w;
            if (layer == 0) {
                *(float4*)(p.X1 + (size_t)row * DM + col) = x2;
                const float4 sh = *(const float4*)(mv1 + col), sc = *(const float4*)(mv1 + 1024 + col);
                uint2 o; o.x = pack2(x2.x * (1.f + sc.x) + sh.x, x2.y * (1.f + sc.y) + sh.y); o.y = pack2(x2.z * (1.f + sc.z) + sh.z, x2.w * (1.f + sc.w) + sh.w);
                *(uint2*)(p.HB + (size_t)row * DM + col) = o;
            } else {
                *(float4*)(p.out + (size_t)row * DM + col) = x2;
            }
        }
    }
}
__device__ __forceinline__ void ph_qkv(const Ctx cx, PRef p, char* lds) {
    for (int tile = cx.bid; tile < 16; tile += cx.nb) {
        const int mt = 128 + (tile >> 2), n0 = (8 + (tile & 3)) * 128, m0 = mt * 128;
        const bf16_t* A = p.HB + (size_t)m0 * DM + G3_CH8;
        const bf16_t* B = p.wqkvT + (size_t)n0 * 1024 + G3_CH8;
        EpiQKV epi; epi.p = &p; epi.m0 = m0; epi.n0 = n0;
        gemm3_tile(cx, A + (size_t)G3_ROW(0) * DM, A + (size_t)G3_ROW(1) * DM,
                   B + (size_t)G3_ROW(0) * 1024, B + (size_t)G3_ROW(1) * 1024, 1024, epi, lds);
    }
}
#define AT_ROW 72
__device__ __forceinline__ void ph_attn(const Ctx cx, PRef p, char* lds) {
    const int tid = cx.tid, lane = tid & 63, wave = tid >> 6, qi = lane & 15, g = lane >> 4;
    bf16_t* Ks = (bf16_t*)lds;
    bf16_t* Vs = Ks + 64 * AT_ROW;
    const float LOG2E = 1.4426950408889634f;
    for (int item = cx.bid; item < 2 * 128 * 4; item += cx.nb) {
        const int hk = item & 3, qb = (item >> 2) & 127, b = item >> 9;
        const int hq = hk * 4 + wave, q0 = qb * 64;
        bf16x8 qf[4][2];
#pragma unroll
        for (int qs = 0; qs < 4; ++qs)
#pragma unroll
            for (int ks = 0; ks < 2; ++ks)
                qf[qs][ks] = *(const bf16x8*)(p.Q + (size_t)(b * TLAT + q0 + qs * 16 + qi) * DM + hq * 64 + ks * 32 + 8 * g);
        f32x4 o[4][4];
#pragma unroll
        for (int i = 0; i < 4; ++i)
#pragma unroll
            for (int j = 0; j < 4; ++j) o[i][j] = (f32x4){0.f, 0.f, 0.f, 0.f};
        const float sink = p.at_sink[hq] * LOG2E;
        float mrow[4], lrow[4];
#pragma unroll
        for (int qs = 0; qs < 4; ++qs) { mrow[qs] = sink; lrow[qs] = (g == 0) ? 1.f : 0.f; }
        uint4 kr0, kr1, vr0, vr1;
        kr0 = kr1 = vr0 = vr1 = make_uint4(0u, 0u, 0u, 0u);
#define AT_GEOM(tile_, isctx_, ts_, skip_) const bool isctx_ = (tile_) < 4; const int ts_ = isctx_ ? (tile_) * 64 : q0 - 128 + ((tile_) - 4) * 64; const bool skip_ = !isctx_ && (ts_ < 0 || ts_ >= TLAT)
#define AT_LOAD(tile_) do { AT_GEOM(tile_, ic_, tl_, sk_); if (!sk_) { \
            const bf16_t* kbase = ic_ ? p.KA + (size_t)(ROWS_LAT + b * LCTX + tl_) * 256 + hk * 64 : p.KA + (size_t)(b * TLAT + tl_) * 256 + hk * 64; \
            const bf16_t* vbase = ic_ ? p.VTC + (size_t)(b * 4 + hk) * 64 * LCTX + tl_ : p.VTL + (size_t)(b * 4 + hk) * 64 * TLAT + tl_; \
            const int ldv = ic_ ? LCTX : TLAT; \
            const int r0_ = tid >> 3, r1_ = (tid + 256) >> 3, c8_ = (tid & 7) * 8; \
            kr0 = *(const uint4*)(kbase + (size_t)r0_ * 256 + c8_); vr0 = *(const uint4*)(vbase + (size_t)r0_ * ldv + c8_); \
            kr1 = *(const uint4*)(kbase + (size_t)r1_ * 256 + c8_); vr1 = *(const uint4*)(vbase + (size_t)r1_ * ldv + c8_); } } while (0)
        AT_LOAD(0);
        for (int tile = 0; tile < 9; ++tile) {
            AT_GEOM(tile, isctx, ts, skip);
            __syncthreads();
            if (!skip) {
                const int r0_ = tid >> 3, r1_ = (tid + 256) >> 3, c8_ = (tid & 7) * 8;
                *(uint4*)(Ks + r0_ * AT_ROW + c8_) = kr0; *(uint4*)(Vs + r0_ * AT_ROW + c8_) = vr0;
                *(uint4*)(Ks + r1_ * AT_ROW + c8_) = kr1; *(uint4*)(Vs + r1_ * AT_ROW + c8_) = vr1;
            }
            if (tile + 1 < 9) AT_LOAD(tile + 1);
            __syncthreads();
            if (!skip)
#pragma unroll
            for (int qh = 0; qh < 2; ++qh) {
                f32x4 s[4][2];
#pragma unroll
                for (int kt = 0; kt < 4; ++kt) {
                    const bf16x8 k0 = *(const bf16x8*)(Ks + (kt * 16 + qi) * AT_ROW + 8 * g);
                    const bf16x8 k1 = *(const bf16x8*)(Ks + (kt * 16 + qi) * AT_ROW + 32 + 8 * g);
#pragma unroll
                    for (int q2 = 0; q2 < 2; ++q2) {
                        f32x4 a = (f32x4){0.f, 0.f, 0.f, 0.f};
                        a = __builtin_amdgcn_mfma_f32_16x16x32_bf16(k0, qf[2 * qh + q2][0], a, 0, 0, 0);
                        a = __builtin_amdgcn_mfma_f32_16x16x32_bf16(k1, qf[2 * qh + q2][1], a, 0, 0, 0);
                        s[kt][q2] = a;
                    }
                }
                __builtin_amdgcn_sched_barrier(0);
#pragma unroll
                for (int q2 = 0; q2 < 2; ++q2) {
                    const int qs = 2 * qh + q2;
                    const int qp = q0 + qs * 16 + qi;
                    float tmax = -1e30f;
#pragma unroll
                    for (int kt = 0; kt < 4; ++kt)
#pragma unroll
                        for (int r = 0; r < 4; ++r) {
                            float v = s[kt][q2][r] * LOG2E;
                            if (!isctx) { const int kp = ts + kt * 16 + 4 * g + r; const int dd = qp - kp; if (dd > 128 || dd < -128) v = -1e30f; }
                            s[kt][q2][r] = v; tmax = fmaxf(tmax, v);
                        }
                    tmax = fmaxf(tmax, shx(tmax, 16, lane)); tmax = fmaxf(tmax, shx(tmax, 32, lane));
                    const float mn = fmaxf(mrow[qs], tmax);
                    const float alpha = __builtin_amdgcn_exp2f(mrow[qs] - mn);
                    mrow[qs] = mn;
                    float ls = 0.f;
#pragma unroll
                    for (int kt = 0; kt < 4; ++kt)
#pragma unroll
                        for (int r = 0; r < 4; ++r) { const float pv = __builtin_amdgcn_exp2f(s[kt][q2][r] - mn); s[kt][q2][r] = pv; ls += pv; }
                    lrow[qs] = lrow[qs] * alpha + ls;
#pragma unroll
                    for (int dt = 0; dt < 4; ++dt) o[dt][qs] = o[dt][qs] * alpha;
                }
                __builtin_amdgcn_sched_barrier(0);
#pragma unroll
                for (int kk = 0; kk < 2; ++kk) {
                    bf16x8 pf[2];
#pragma unroll
                    for (int q2 = 0; q2 < 2; ++q2) {
                        uint4 u;
                        u.x = pack2(s[2 * kk][q2][0], s[2 * kk][q2][1]); u.y = pack2(s[2 * kk][q2][2], s[2 * kk][q2][3]);
                        u.z = pack2(s[2 * kk + 1][q2][0], s[2 * kk + 1][q2][1]); u.w = pack2(s[2 * kk + 1][q2][2], s[2 * kk + 1][q2][3]);
                        pf[q2] = *(bf16x8*)&u;
                    }
#pragma unroll
                    for (int dt = 0; dt < 4; ++dt) {
                        const bf16_t* vr = Vs + (dt * 16 + qi) * AT_ROW + 32 * kk + 4 * g;
                        uint4 u; const uint2 lo = *(const uint2*)(vr), hi = *(const uint2*)(vr + 16);
                        u.x = lo.x; u.y = lo.y; u.z = hi.x; u.w = hi.y;
                        const bf16x8 vf = *(bf16x8*)&u;
#pragma unroll
                        for (int q2 = 0; q2 < 2; ++q2) o[dt][2 * qh + q2] = __builtin_amdgcn_mfma_f32_16x16x32_bf16(vf, pf[q2], o[dt][2 * qh + q2], 0, 0, 0);
                    }
                }
            }
        }
#pragma unroll
        for (int qs = 0; qs < 4; ++qs) {
            float l = lrow[qs]; l += shx(l, 16, lane); l += shx(l, 32, lane);
            const float il = __builtin_amdgcn_rcpf(l);
            bf16_t* op = p.O + (size_t)(b * TLAT + q0 + qs * 16 + qi) * DM + hq * 64 + 4 * g;
#pragma unroll
            for (int dt = 0; dt < 4; ++dt) {
                uint2 u; u.x = pack2(o[dt][qs][0] * il, o[dt][qs][1] * il); u.y = pack2(o[dt][qs][2] * il, o[dt][qs][3] * il);
                *(uint2*)(op + dt * 16) = u;
            }
        }
    }
}

#define N_PHASES 23
#define VLDS (S1_LDS_BYTES)
__global__ void __launch_bounds__(2 * NTHR, 2) mk_forward(Params p_by_value) {
    __shared__ __attribute__((aligned(16))) char lds[2 * VLDS + 64];
    volatile unsigned* bst = (volatile unsigned*)(lds + 2 * VLDS);
    PPtr pp = (PPtr)__builtin_amdgcn_kernarg_segment_ptr();
    const int ph_lo = pp->ph_lo, ph_hi = pp->ph_hi;
    const int wave_s = __builtin_amdgcn_readfirstlane((int)threadIdx.x >> 6);
    const bool multi = ph_hi > ph_lo;
    if (multi) {
        if (threadIdx.x == 0) { bst[0] = 0u; bst[1] = 0u; }
        __syncthreads();
        (void)xcd_barrier_post(pp->bar, bst);
    }
    bool dup_done = false; (void)dup_done;
    for (int ph = ph_lo; ph <= ph_hi; ++ph) {
#ifdef ONLY_PH
        if (ph != ONLY_PH) continue;
#endif
        if (ph == 4 || ph == 8) continue;
        PPtr q = pp; asm volatile("" : "+s"(q));
        PRef p = *q;
#define LDSP (lds + (wave_s >> 2) * VLDS + fresh_zero())
#define MKPX(name) Ctx name; name.tid = wave_s * 64 + fresh_lane(); name.bid = blockIdx.x; name.nb = gridDim.x; asm volatile("" : "+v"(name.tid), "+s"(name.bid), "+s"(name.nb))
#define MKCX(name) Ctx name; name.tid = (wave_s & 3) * 64 + fresh_lane(); name.bid = blockIdx.x * 2 + (wave_s >> 2); name.nb = gridDim.x * 2; asm volatile("" : "+v"(name.tid), "+s"(name.bid), "+s"(name.nb)); int lz2_ = 0; asm volatile("" : "+v"(lz2_)); char* ldsy = lds + (wave_s >> 2) * VLDS + lz2_
        switch (ph) {
            case 0: { MKCX(cx);  ph_ada(cx, p, LDSP); } break;
            case 1: { MKCX(cx);  ph_pre0(cx, p); } break;
            case 2: { MKPX(px);  { ProbRKV pr; pr.p = q; pr.K = 1024; pr.c = px.bid; pr.G = px.nb; { int z8 = 0; asm volatile("" : "+v"(z8)); gemm8(px, lds + z8, pr); } MKCX(cy); ph_g1(cy, p, ldsy); } } break;
            case 3: { MKCX(cx);  ph_g2(cx, p, LDSP); } break;
            case 4: { MKCX(cx);  ph_prep(cx, p); } break;
            case 5: { MKCX(cx);  ph_s1(cx, p, LDSP); } break;
            case 6: { MKPX(px); MKCX(cx);  ph_s2(px, cx, p, LDSP, lds + fresh_zero()); } break;
            case 7: { MKCX(cx);  ph_s3o(cx, p); } break;
            case 9: case 17: {
                const bool l1 = ph == 17; MKPX(px);
                {
                    ProbOproj pr; pr.A = l1 ? p.O : p.G; pr.Wt = l1 ? p.atwoT : p.woT; pr.out = p.PRE; pr.xl = l1 ? p.X1 : p.x; pr.modl = l1 ? p.modv + 3 * 6144 : p.modv; pr.K = 1024; pr.c = px.bid; pr.G = px.nb;
                    { int z8 = 0; asm volatile("" : "+v"(z8)); gemm8(px, lds + z8, pr); }
                }
                if (!l1) { MKCX(cy); ph_oproj(cy, p, ldsy, p.G, p.woT, p.x, p.ctx, p.modv, 128, 4); }
            } break;
            case 10: case 18: { MKCX(cx); ph_ln_router(cx, p, ph == 18 ? 1 : 0, ph == 18 ? ROWS_LAT : ROWS, lds + fresh_zero()); } break;
            case 11: case 19: { MKCX(cx); ph_topk(cx, p, ph == 19 ? 1 : 0, LDSP); } break;
            case 12: case 20: { MKPX(px); { ProbUp pr; pr.p = q; pr.K = 1024; pr.c = px.bid; pr.G = px.nb; pr.layer = ph == 20 ? 1 : 0; { int z8 = 0; asm volatile("" : "+v"(z8)); gemm8(px, lds + z8, pr); } MKCX(cy); ph_moe_up(cy, p, ph == 20 ? 1 : 0, ldsy); } } break;
            case 13: case 21: { MKPX(px); { ProbDown pr; pr.p = q; pr.K = 2048; pr.c = px.bid; pr.G = px.nb; pr.layer = ph == 21 ? 1 : 0; { int z8 = 0; asm volatile("" : "+v"(z8)); gemm8(px, lds + z8, pr); } MKCX(cy); ph_moe_down(cy, p, ph == 21 ? 1 : 0, ldsy); } } break;
            case 14: case 22: { MKCX(cx); ph_combine(cx, p, ph == 22 ? 1 : 0, ph == 22 ? ROWS_LAT : ROWS); } break;
            case 15: { MKPX(px);  { ProbQKV pr; pr.p = q; pr.K = 1024; pr.c = px.bid; pr.G = px.nb; { int z8 = 0; asm volatile("" : "+v"(z8)); gemm8(px, lds + z8, pr); } MKCX(cy); ph_qkv(cy, p, ldsy); } } break;
            case 16: { MKCX(cx);  ph_attn(cx, p, LDSP); } break;
        }
#ifdef DUP_MASK
        if (((DUP_MASK >> ph) & 1u) && !dup_done) { dup_done = true; --ph; } else dup_done = false;
        if (ph + 1 <= ph_hi && (ph < ph_hi)) {
#else
        if (ph < ph_hi) {
#endif
            if (ph == ph_lo && q->bar == nullptr) cg::this_grid().sync();
            { XcdBarrier xb2; xb2.bar = q->bar; xb2.x = xb_xcc_id(); int lz3 = 0; asm volatile("" : "+v"(lz3)); xb2.st = (volatile unsigned*)(lds + 2 * VLDS + lz3); asm volatile("" : "+s"(xb2.x)); xcd_barrier(xb2); }
        }
    }
}

extern "C" void kernel_launch(void* const* d_in, const int* in_sizes, int n_in, void* d_out, int out_size, void* d_ws, size_t ws_size, hipStream_t stream) {
    Params p{};
    const float** f = (const float**)d_in;
    p.x = f[0]; p.c = f[1]; p.ctx = f[2]; p.c_ctx = f[3]; p.ada_w = f[4]; p.ada_b = f[5]; p.ln1_g = f[6]; p.ln1_b = f[7]; p.ln2_g = f[8]; p.ln2_b = f[9];
    p.rw_mu = f[10]; p.rw_wr = f[11]; p.rw_wk = f[12]; p.rw_wv = f[13]; p.rw_w0 = f[14]; p.rw_w1 = f[15]; p.rw_w2 = f[16]; p.rw_a0 = f[17]; p.rw_a1 = f[18]; p.rw_a2 = f[19];
    p.rw_g1 = f[20]; p.rw_g2 = f[21]; p.rw_kk = f[22]; p.rw_ka = f[23]; p.rw_rk = f[24]; p.rw_lnx_g = f[25]; p.rw_lnx_b = f[26]; p.rw_wo = f[27];
    p.at_wqkv = f[28]; p.at_wo = f[29]; p.at_sink = f[30]; p.router_w = f[31]; p.moe_w_gate = f[32]; p.moe_w_up = f[33]; p.moe_w_down = f[34];
    p.out = (float*)d_out;
    char* ws = (char*)d_ws; size_t off = 0;
    auto take = [&](size_t bytes) { char* r = ws + off; off += (bytes + 255) & ~(size_t)255; return r; };
    const size_t U = (size_t)ROWS * DM * 2;
    p.bar = (unsigned*)take(16384);
    p.modv = (float*)take(2 * 3 * 6144 * 4);
    p.modp = (float*)take((size_t)16 * 2 * 3 * 6144 * 4);
    p.rope = (float*)take(128 * 16 * 2 * 4);
    p.afft = (float*)take((size_t)16 * ROWS * 4);
    p.inv = (int*)take((size_t)ROWS * 16 * 4);
    p.idx = (int*)take(16 * MPAD0 * 4);
    p.gate = (float*)take(16 * MPAD0 * 4);
    p.wrT = (bf16_t*)take(2097152); p.wkT = (bf16_t*)take(2097152); p.wvT = (bf16_t*)take(2097152); p.woT = (bf16_t*)take(2097152);
    p.l1T = (bf16_t*)take(384 * 1024 * 2); p.g2T = (bf16_t*)take(1024 * 128 * 2); p.w2T = (bf16_t*)take(2 * 65536 * 2); p.a2T = (bf16_t*)take(2 * 65536 * 2);
    p.wqkvT = (bf16_t*)take(1536 * 1024 * 2); p.atwoT = (bf16_t*)take(2097152);
    char* base = take(30 * U);
    char* RA = base, *RB = base + 12 * U, *RC = base + 20 * U, *RD = base + 23 * U, *RE = base + 25 * U, *RF = base + 26 * U;
    p.XM = (bf16_t*)RA;
    p.W0 = (float*)RA; p.W1 = (float*)(RA + 2 * U); p.AD0 = (bf16_t*)(RA + 4 * U); p.AD1 = (bf16_t*)(RA + 5 * U); p.KK = (float*)(RA + 6 * U);
    p.CW = (bf16_t*)RA;
    p.CM = (bf16_t*)RB; p.CN = (bf16_t*)(RB + 2 * U); p.CR = (bf16_t*)(RB + 4 * U); p.CY = (bf16_t*)(RB + 6 * U);
    p.HMID = (bf16_t*)RB; p.YE = (bf16_t*)(RB + (size_t)16 * MPAD0 * 2048 * 2);
    p.R = (bf16_t*)RC; p.K = (bf16_t*)(RC + U); p.V = (bf16_t*)(RC + 2 * U);
    p.Q = (bf16_t*)RC; p.O = (bf16_t*)(RC + (size_t)ROWS_LAT * DM * 2); p.KA = (bf16_t*)(RC + (size_t)2 * ROWS_LAT * DM * 2);
    p.VTL = p.KA + (size_t)ROWS * 256; p.VTC = p.VTL + (size_t)2 * 4 * 64 * TLAT;
    p.LH = (bf16_t*)RD; p.CS = (bf16_t*)RD; p.H2 = (bf16_t*)RD; p.HB = (bf16_t*)(RD + U);
    p.G = (bf16_t*)RE;
    p.Y0 = (float*)RF; p.Y1 = (float*)(RF + 2 * U); p.PRE = (float*)RF; p.X1 = (float*)(RF + 2 * U);
    p.XXB = nullptr;
    if (off > ws_size) fprintf(stderr, "workspace too small: need %zu have %zu\n", off, ws_size);

    static int grid_blocks = 0;
    if (!grid_blocks) {
        int dev = 0, cus = 0, per_cu = 0;
        hipGetDevice(&dev);
        hipDeviceGetAttribute(&cus, hipDeviceAttributeMultiprocessorCount, dev);
        hipOccupancyMaxActiveBlocksPerMultiprocessor(&per_cu, mk_forward, 2 * NTHR, 0);
        if (per_cu > 1) per_cu = 1;
        if (per_cu < 1) per_cu = 1;
        grid_blocks = cus * per_cu;
    }
#if MK_SINGLE
    hipMemsetAsync(p.bar, 0, 16384, stream);
    p.ph_lo = 0; p.ph_hi = N_PHASES - 1;
    void* args[] = {&p};
    hipError_t e = hipLaunchCooperativeKernel((void*)mk_forward, dim3(grid_blocks), dim3(2 * NTHR), args, 0, stream);
    if (e != hipSuccess) fprintf(stderr, "cooperative launch failed: %s (grid %d)\n", hipGetErrorString(e), grid_blocks);
#else
    for (int ph = 0; ph < N_PHASES; ++ph) {
        p.ph_lo = ph; p.ph_hi = ph;
        hipLaunchKernelGGL(mk_forward, dim3(grid_blocks), dim3(2 * NTHR), 0, stream, p);
    }
#endif
}
```
